# Optimizing an MI355X kernel written in HIP

```python
import math
import jax, jax.numpy as jnp
from jax import lax
import numpy as np

D_MODEL = 2048
BATCH = 4
SEQ = 4096
DEPTH = 4
DEC_BATCH = 16
DEC_SEQ = 16
PAST_LEN = 1024

CHUNK = 64
N_MIXERS = 2
N_A = (DEPTH + 1) // 2
N_B = DEPTH // 2
PLE_DIM = 256
EPS = 1e-6
Q_BLOCK = 128

MLA_HEADS = 16
MLA_Q_LORA = 512
MLA_KV_LORA = 512
MLA_NOPE = 128
MLA_ROPE = 64
MLA_V = 128
MLA_THETA = 10000.0
MLA_SCALE = (MLA_NOPE + MLA_ROPE) ** -0.5

SWA_Q_HEADS = 32
SWA_KV_HEADS = 4
SWA_GROUP = SWA_Q_HEADS // SWA_KV_HEADS
SWA_HEAD_DIM = 64
SWA_ROT = SWA_HEAD_DIM // 4
SWA_SCALE = SWA_HEAD_DIM ** -0.5
WINDOW = 128
WINDOW_CHUNKS = WINDOW // CHUNK
BAND = (WINDOW_CHUNKS + 1) * CHUNK
ROPE_THETA = 500000.0

D_FF = ((8 * D_MODEL + 3 * 256 - 1) // (3 * 256)) * 256

kernel_name = 'hybrid_mla_swa_streaming_step'


def rmsnorm(x, g):
    xf = x.astype(jnp.float32)
    y = xf * lax.rsqrt(jnp.mean(xf * xf, axis=-1, keepdims=True) + EPS)
    return (y * g.astype(jnp.float32)).astype(x.dtype)


def rope(x, pos, theta):
    r = x.shape[-1]
    half = r // 2
    inv = jnp.power(jnp.float32(theta), -jnp.arange(0, r, 2, dtype=jnp.float32) / r)
    ang = pos.astype(jnp.float32)[:, None] * inv[None, :]
    shape = (ang.shape[0],) + (1,) * (x.ndim - 3) + (half,)
    cos = jnp.cos(ang).reshape(shape)
    sin = jnp.sin(ang).reshape(shape)
    xf = x.astype(jnp.float32)
    x1, x2 = xf[..., :half], xf[..., half:]
    return jnp.concatenate([x1 * cos - x2 * sin, x2 * cos + x1 * sin], axis=-1).astype(x.dtype)


def partial_rope(x, pos):
    return jnp.concatenate([rope(x[..., :SWA_ROT], pos, ROPE_THETA), x[..., SWA_ROT:]], axis=-1)


def mla_project(hn, pos, w, j):
    B, S, _ = hn.shape
    a = hn @ w['w_mla_in'][j]
    c_q, c_kv, k_r = jnp.split(a, [MLA_Q_LORA, MLA_Q_LORA + MLA_KV_LORA], axis=-1)
    q = (rmsnorm(c_q, w['g_mla_q_a'][j]) @ w['w_mla_q_up'][j]).reshape(B, S, MLA_HEADS, MLA_NOPE + MLA_ROPE)
    q_nope = rmsnorm(q[..., :MLA_NOPE], w['g_mla_q_nope'][j])
    q_rope = rope(rmsnorm(q[..., MLA_NOPE:], w['g_mla_q_rope'][j]), pos, MLA_THETA)
    c_kv = rmsnorm(c_kv, w['g_mla_kv_a'][j])
    k_rope = rope(rmsnorm(k_r, w['g_mla_k_rope'][j]), pos, MLA_THETA)
    return q_nope, q_rope, c_kv, k_rope


def mla_expand(c_kv, w, j):
    B, S, _ = c_kv.shape
    kv = (c_kv @ w['w_mla_kv_up'][j]).reshape(B, S, MLA_HEADS, MLA_NOPE + MLA_V)
    return rmsnorm(kv[..., :MLA_NOPE], w['g_mla_k_nope'][j]), kv[..., MLA_NOPE:]


def mla_attend(q_nope, q_rope, k_nope, k_rope, v, q_pos, k_pos):
    s = (jnp.einsum('bqhn,bkhn->bhqk', q_nope, k_nope)
         + jnp.einsum('bqhr,bkr->bhqk', q_rope, k_rope)).astype(jnp.float32) * MLA_SCALE
    vis = (k_pos // CHUNK)[None, :] <= (q_pos // CHUNK)[:, None]
    s = jnp.where(vis[None, None], s, -jnp.inf)
    p = jax.nn.softmax(s, axis=-1).astype(v.dtype)
    return jnp.einsum('bhqk,bkhv->bqhv', p, v)


def mla_mixer(hn, pos, w, j, cache):
    B, S, _ = hn.shape
    q_nope, q_rope, c_kv, k_rope = mla_project(hn, pos, w, j)
    if cache is None:
        k_nope, v = mla_expand(c_kv, w, j)
        nb = S // Q_BLOCK

        def blockify(t):
            return jnp.swapaxes(t.reshape((B, nb, Q_BLOCK) + t.shape[2:]), 0, 1)

        o = lax.map(lambda a: mla_attend(a[0], a[1], k_nope, k_rope, v, a[2], pos),
                    (blockify(q_nope), blockify(q_rope), pos.reshape(nb, Q_BLOCK)))
        o = jnp.swapaxes(o, 0, 1).reshape(B, S, MLA_HEADS * MLA_V)
    else:
        lat_c, kr_c = cache
        lat_all = jnp.concatenate([lat_c, c_kv], axis=1)
        kr_all = jnp.concatenate([kr_c, k_rope], axis=1)
        k_nope, v = mla_expand(lat_all, w, j)
        k_pos = jnp.arange(lat_all.shape[1], dtype=jnp.int32)
        o = mla_attend(q_nope, q_rope, k_nope, kr_all, v, pos, k_pos).reshape(B, S, MLA_HEADS * MLA_V)
    return o @ w['w_mla_out'][j], c_kv, k_rope


def swa_project(hn, pos, w, j):
    B, S, _ = hn.shape
    qkv = hn @ w['w_swa_qkv'][j]
    nq = SWA_Q_HEADS * SWA_HEAD_DIM
    nk = SWA_KV_HEADS * SWA_HEAD_DIM
    q, k, v = jnp.split(qkv, [nq, nq + nk], axis=-1)
    q = partial_rope(rmsnorm(q.reshape(B, S, SWA_Q_HEADS, SWA_HEAD_DIM), w['g_swa_q'][j]), pos)
    q = q.reshape(B, S, SWA_KV_HEADS, SWA_GROUP, SWA_HEAD_DIM)
    k = partial_rope(rmsnorm(k.reshape(B, S, SWA_KV_HEADS, SWA_HEAD_DIM), w['g_swa_k'][j]), pos)
    v = v.reshape(B, S, SWA_KV_HEADS, SWA_HEAD_DIM)
    return q, k, v


def swa_attend(q, k, v, sinks, valid):
    s = jnp.einsum('bcqkgd,bcjkd->bckgqj', q, k).astype(jnp.float32) * SWA_SCALE
    s = jnp.where(valid[None, :, None, None, None, :], s, -jnp.inf)
    sk = sinks.astype(jnp.float32).reshape(SWA_KV_HEADS, SWA_GROUP)[None, None, :, :, None, None]
    m = jnp.maximum(jnp.max(s, axis=-1, keepdims=True), sk)
    e = jnp.exp(s - m)
    p = e / (jnp.sum(e, axis=-1, keepdims=True) + jnp.exp(sk - m))
    return jnp.einsum('bckgqj,bcjkd->bcqkgd', p.astype(v.dtype), v)


def swa_mixer(hn, pos, w, j, cache):
    B, S, _ = hn.shape
    q, k, v = swa_project(hn, pos, w, j)
    sinks = w['swa_sinks'][j]
    if cache is None:
        C = S // CHUNK
        qc = q.reshape(B, C, CHUNK, SWA_KV_HEADS, SWA_GROUP, SWA_HEAD_DIM)
        pad = ((0, 0), (WINDOW, 0), (0, 0), (0, 0))

        def band(t):
            tc = jnp.pad(t, pad).reshape(B, C + WINDOW_CHUNKS, CHUNK, SWA_KV_HEADS, SWA_HEAD_DIM)
            return jnp.concatenate([tc[:, o_:o_ + C] for o_ in range(WINDOW_CHUNKS + 1)], axis=2)

        key_pos = jnp.arange(C)[:, None] * CHUNK - WINDOW + jnp.arange(BAND)[None, :]
        o = swa_attend(qc, band(k), band(v), sinks, key_pos >= 0)
        keep = min(WINDOW, S)
        new_k, new_v = k[:, S - keep:], v[:, S - keep:]
    else:
        ck, cv = cache
        k_all = jnp.concatenate([ck, k], axis=1)
        v_all = jnp.concatenate([cv, v], axis=1)
        valid = jnp.ones((1, k_all.shape[1]), dtype=bool)
        o = swa_attend(q[:, None], k_all[:, None], v_all[:, None], sinks, valid)
        keep = ck.shape[1]
        new_k, new_v = k_all[:, -keep:], v_all[:, -keep:]
    o = o.reshape(B, S, SWA_Q_HEADS * SWA_HEAD_DIM)
    return o @ w['w_swa_out'][j], new_k, new_v


def run_trunk(x, p, pos, caches, w):
    h = x
    lats, krs, sks, svs = [], [], [], []
    for i in range(DEPTH):
        j = i // N_MIXERS
        hn = rmsnorm(h, w['g_attn_norm'][i])
        if i % N_MIXERS == 0:
            c = None if caches is None else (caches[0][j], caches[1][j])
            mix, lat, kr = mla_mixer(hn, pos, w, j, c)
            lats.append(lat)
            krs.append(kr)
        else:
            c = None if caches is None else (caches[2][j], caches[3][j])
            mix, sk, sv = swa_mixer(hn, pos, w, j, c)
            sks.append(sk)
            svs.append(sv)
        h = h + mix
        hn = rmsnorm(h, w['g_ffn_norm'][i])
        h = h + (jax.nn.silu(hn @ w['w_ffn_gate'][i]) * (hn @ w['w_ffn_up'][i])) @ w['w_ffn_down'][i]
        gate = jax.nn.sigmoid(rmsnorm(h, w['g_ple_norm'][i]) @ w['w_ple_gate'][i])
        h = h + gate * (p[i] @ w['w_ple_proj'][i])
    y = rmsnorm(h, w['g_final'])
    return y, jnp.stack(lats), jnp.stack(krs), jnp.stack(sks), jnp.stack(svs)


def setup_inputs(seed: int = 0) -> dict:
    key = jax.random.key(seed)
    ks = iter(jax.random.split(key, 48))

    def nrm(shape, scale=1.0):
        return scale * jax.random.normal(next(ks), shape, jnp.float32)

    def lin(shape):
        return nrm(shape, shape[-2] ** -0.5)

    def gain(shape):
        return 1.0 + nrm(shape, 0.02)

    keep = min(WINDOW, PAST_LEN)
    return {
        'x_prompt': nrm((BATCH, SEQ, D_MODEL)),
        'x_sample': nrm((DEC_BATCH, DEC_SEQ, D_MODEL)),
        'p_prompt': nrm((DEPTH, BATCH, SEQ, PLE_DIM)),
        'p_sample': nrm((DEPTH, DEC_BATCH, DEC_SEQ, PLE_DIM)),
        'cache_mla_latent': nrm((N_A, DEC_BATCH, PAST_LEN, MLA_KV_LORA)),
        'cache_mla_krope': nrm((N_A, DEC_BATCH, PAST_LEN, MLA_ROPE)),
        'state_swa_k': nrm((N_B, DEC_BATCH, keep, SWA_KV_HEADS, SWA_HEAD_DIM)),
        'state_swa_v': nrm((N_B, DEC_BATCH, keep, SWA_KV_HEADS, SWA_HEAD_DIM)),
        'g_attn_norm': gain((DEPTH, D_MODEL)),
        'w_mla_in': lin((N_A, D_MODEL, MLA_Q_LORA + MLA_KV_LORA + MLA_ROPE)),
        'g_mla_q_a': gain((N_A, MLA_Q_LORA)),
        'w_mla_q_up': lin((N_A, MLA_Q_LORA, MLA_HEADS * (MLA_NOPE + MLA_ROPE))),
        'g_mla_kv_a': gain((N_A, MLA_KV_LORA)),
        'w_mla_kv_up': lin((N_A, MLA_KV_LORA, MLA_HEADS * (MLA_NOPE + MLA_V))),
        'g_mla_q_nope': gain((N_A, MLA_NOPE)),
        'g_mla_q_rope': gain((N_A, MLA_ROPE)),
        'g_mla_k_nope': gain((N_A, MLA_NOPE)),
        'g_mla_k_rope': gain((N_A, MLA_ROPE)),
        'w_mla_out': lin((N_A, MLA_HEADS * MLA_V, D_MODEL)),
        'w_swa_qkv': lin((N_B, D_MODEL, (SWA_Q_HEADS + 2 * SWA_KV_HEADS) * SWA_HEAD_DIM)),
        'g_swa_q': gain((N_B, SWA_HEAD_DIM)),
        'g_swa_k': gain((N_B, SWA_HEAD_DIM)),
        'swa_sinks': nrm((N_B, SWA_Q_HEADS), 0.5),
        'w_swa_out': lin((N_B, SWA_Q_HEADS * SWA_HEAD_DIM, D_MODEL)),
        'g_ffn_norm': gain((DEPTH, D_MODEL)),
        'w_ffn_gate': lin((DEPTH, D_MODEL, D_FF)),
        'w_ffn_up': lin((DEPTH, D_MODEL, D_FF)),
        'w_ffn_down': lin((DEPTH, D_FF, D_MODEL)),
        'g_ple_norm': gain((DEPTH, D_MODEL)),
        'w_ple_gate': lin((DEPTH, D_MODEL, D_MODEL)),
        'w_ple_proj': lin((DEPTH, PLE_DIM, D_MODEL)),
        'g_final': gain((D_MODEL,)),
    }


def reference(x_prompt, x_sample, p_prompt, p_sample, cache_mla_latent, cache_mla_krope,
              state_swa_k, state_swa_v, g_attn_norm, w_mla_in, g_mla_q_a, w_mla_q_up,
              g_mla_kv_a, w_mla_kv_up, g_mla_q_nope, g_mla_q_rope, g_mla_k_nope, g_mla_k_rope,
              w_mla_out, w_swa_qkv, g_swa_q, g_swa_k, swa_sinks, w_swa_out, g_ffn_norm,
              w_ffn_gate, w_ffn_up, w_ffn_down, g_ple_norm, w_ple_gate, w_ple_proj, g_final):
    w = dict(g_attn_norm=g_attn_norm, w_mla_in=w_mla_in, g_mla_q_a=g_mla_q_a, w_mla_q_up=w_mla_q_up,
             g_mla_kv_a=g_mla_kv_a, w_mla_kv_up=w_mla_kv_up, g_mla_q_nope=g_mla_q_nope,
             g_mla_q_rope=g_mla_q_rope, g_mla_k_nope=g_mla_k_nope, g_mla_k_rope=g_mla_k_rope,
             w_mla_out=w_mla_out, w_swa_qkv=w_swa_qkv, g_swa_q=g_swa_q, g_swa_k=g_swa_k,
             swa_sinks=swa_sinks, w_swa_out=w_swa_out, g_ffn_norm=g_ffn_norm, w_ffn_gate=w_ffn_gate,
             w_ffn_up=w_ffn_up, w_ffn_down=w_ffn_down, g_ple_norm=g_ple_norm, w_ple_gate=w_ple_gate,
             w_ple_proj=w_ple_proj, g_final=g_final)
    S = x_prompt.shape[1]
    T = x_sample.shape[1]
    past = cache_mla_latent.shape[2]
    pos_p = jnp.arange(S, dtype=jnp.int32)
    pos_s = past + jnp.arange(T, dtype=jnp.int32)
    y_prompt, lat_p, kr_p, sk_p, sv_p = run_trunk(x_prompt, p_prompt, pos_p, None, w)
    y_sample, lat_s, kr_s, sk_s, sv_s = run_trunk(
        x_sample, p_sample, pos_s, (cache_mla_latent, cache_mla_krope, state_swa_k, state_swa_v), w)
    return (y_prompt, y_sample, lat_p, kr_p, sk_p, sv_p, lat_s, kr_s, sk_s, sv_s)
```

```cpp
#include <hip/hip_runtime.h>
#include <cstdint>
#include <cstdio>

#define LAS __attribute__((address_space(3)))
typedef unsigned short bf16_t;
typedef short bf16x8 __attribute__((ext_vector_type(8)));
typedef short s16x4 __attribute__((ext_vector_type(4)));
typedef float f32x4 __attribute__((ext_vector_type(4)));
typedef float f32x16 __attribute__((ext_vector_type(16)));
typedef unsigned u32x4 __attribute__((ext_vector_type(4)));
typedef unsigned u32x2 __attribute__((ext_vector_type(2)));

constexpr int DM = 2048, SEQ = 4096, NPR = 4 * SEQ  , NSR = 256  , MR = NPR + NSR  ;
constexpr int PAST = 1024, DSEQ = 16, DBATCH = 16;
constexpr int KVPB = PAST + DSEQ;
constexpr int NKVR = NPR + DBATCH * KVPB;
constexpr int SWPB = 128 + DSEQ;
constexpr int NSKR = NPR + DBATCH * SWPB;
constexpr int DFF = 5632, PLE = 256;
constexpr int NIN_MLA = 1088, NQUP = 3072, NKVUP = 4096, NQKV = 2560;
constexpr float EPS = 1e-6f;
constexpr float LOG2E = 1.4426950408889634f;

constexpr size_t O_Y = 0;
constexpr size_t O_LATP = (size_t)MR * DM;
constexpr size_t O_KRP = O_LATP + (size_t)2 * NPR * 512;
constexpr size_t O_SKP = O_KRP + (size_t)2 * NPR * 64;
constexpr size_t O_SVP = O_SKP + (size_t)2 * 4 * 128 * 256;
constexpr size_t O_LATS = O_SVP + (size_t)2 * 4 * 128 * 256;
constexpr size_t O_KRS = O_LATS + (size_t)2 * NSR * 512;
constexpr size_t O_SKS = O_KRS + (size_t)2 * NSR * 64;
constexpr size_t O_SVS = O_SKS + (size_t)2 * 16 * 128 * 256;
constexpr size_t O_END = O_SVS + (size_t)2 * 16 * 128 * 256;
static_assert(O_END == 55869440, "output size");

constexpr size_t MiB = 1u << 20;
constexpr size_t WS_CTL = 0, WS_TABM = 1 * MiB, WS_TABS = 2 * MiB, WS_W = 3 * MiB;
constexpr size_t WE_MLA = 10092544, WE_SWA0 = 2 * WE_MLA, WE_SWA = 9437184, WE_L0 = WE_SWA0 + 2 * WE_SWA, WE_L = 39321600, WE_END = WE_L0 + 4 * WE_L;
static_assert(WE_END == 196345856, "weights");
constexpr size_t WO_IN = 0, WO_QUP = 2228224, WO_KVUP = 3801088, WO_MOUT = 5898240;
constexpr size_t WO_QKV = 0, WO_SOUT = 5242880;
constexpr size_t WO_G = 0, WO_U = 11534336, WO_D = 23068672, WO_PG = 34603008, WO_PP = 38797312;
constexpr size_t WS_HN = 378 * MiB, WS_O = 443 * MiB, WS_R = 508 * MiB;
static_assert(WS_W + WE_END * 2 <= WS_HN, "W fits");
constexpr size_t WS_Q = WS_R, WS_A32 = WS_R, WS_CQ = WS_R + 98 * MiB, WS_LAT = WS_R + 115 * MiB, WS_KR = WS_R + 148 * MiB, WS_KV = WS_R + 153 * MiB;
constexpr size_t WS_QKV32 = WS_R, WS_SQ = WS_R + 163 * MiB, WS_SK = WS_R + 228 * MiB, WS_SV = WS_R + 238 * MiB;
constexpr size_t WS_ACT = WS_R;
constexpr size_t WS_PB = WS_R, WS_T32 = WS_R + 9 * MiB;
constexpr size_t WS_END = WS_KV + (size_t)NKVR * 4096 * 2;
static_assert(WS_END <= 1000 * MiB, "ws budget");

struct Params {
    const float* in[32];
    float* out;
    unsigned char* ws;
};

__device__ __forceinline__ float bf2f(bf16_t b) { return __uint_as_float(((unsigned)b) << 16); }
__device__ __forceinline__ unsigned f2bf(float f) { unsigned u = __float_as_uint(f); return (u + 0x7fffu + ((u >> 16) & 1u)) >> 16; }
__device__ __forceinline__ unsigned pk2(float lo, float hi) { return f2bf(lo) | (f2bf(hi) << 16); }
__device__ __forceinline__ float wave_sum(float v) {
#pragma unroll
    for (int o = 1; o < 64; o <<= 1) v += __shfl_xor(v, o);
    return v;
}
__device__ __forceinline__ int crow(int r, int hi) { return (r & 3) + 8 * (r >> 2) + 4 * hi; }
__device__ __forceinline__ int pos_of_row(int m) { return m < NPR ? (m & (SEQ - 1)) : PAST + ((m - NPR) & (DSEQ - 1)); }
__device__ __forceinline__ int latrow_of(int m) { return m < NPR ? m : NPR + ((m - NPR) >> 4) * KVPB + PAST + ((m - NPR) & 15); }
__device__ __forceinline__ int skrow_of(int m) { return m < NPR ? m : NPR + ((m - NPR) >> 4) * SWPB + 128 + ((m - NPR) & 15); }

__device__ __forceinline__ void ph_tables(const Params& p) {
    float* tm = (float*)(p.ws + WS_TABM); float* ts = (float*)(p.ws + WS_TABS);
    const int gt = blockIdx.x * blockDim.x + threadIdx.x, ngt = gridDim.x * blockDim.x;
    for (int idx = gt; idx < 4096 * 32; idx += ngt) {
        const int pos = idx >> 5, i = idx & 31;
        const float inv = powf(10000.0f, -(float)i / 32.0f);
        const float ang = (float)pos * inv;
        tm[idx * 2] = cosf(ang); tm[idx * 2 + 1] = sinf(ang);
    }
    for (int idx = gt; idx < 4096 * 8; idx += ngt) {
        const int pos = idx >> 3, i = idx & 7;
        const float inv = powf(500000.0f, -(float)i / 8.0f);
        const float ang = (float)pos * inv;
        ts[idx * 2] = cosf(ang); ts[idx * 2 + 1] = sinf(ang);
    }
}

struct WDesc { const float* src; bf16_t* dst; int K, N; };
__device__ __forceinline__ WDesc wdesc(const Params& p, int idx) {
    bf16_t* W = (bf16_t*)(p.ws + WS_W); WDesc d;
    if (idx < 8) { const int j = idx >> 2, k = idx & 3; bf16_t* b = W + (size_t)j * WE_MLA;
        if (k == 0) { d.src = p.in[9] + (size_t)j * 2048 * NIN_MLA; d.dst = b + WO_IN; d.K = 2048; d.N = NIN_MLA; }
        else if (k == 1) { d.src = p.in[11] + (size_t)j * 512 * NQUP; d.dst = b + WO_QUP; d.K = 512; d.N = NQUP; }
        else if (k == 2) { d.src = p.in[13] + (size_t)j * 512 * NKVUP; d.dst = b + WO_KVUP; d.K = 512; d.N = NKVUP; }
        else { d.src = p.in[18] + (size_t)j * 2048 * 2048; d.dst = b + WO_MOUT; d.K = 2048; d.N = 2048; }
    } else if (idx < 12) { const int j = (idx - 8) >> 1, k = (idx - 8) & 1; bf16_t* b = W + WE_SWA0 + (size_t)j * WE_SWA;
        if (k == 0) { d.src = p.in[19] + (size_t)j * 2048 * NQKV; d.dst = b + WO_QKV; d.K = 2048; d.N = NQKV; }
        else { d.src = p.in[23] + (size_t)j * 2048 * 2048; d.dst = b + WO_SOUT; d.K = 2048; d.N = 2048; }
    } else { const int i = (idx - 12) / 5, k = (idx - 12) % 5; bf16_t* b = W + WE_L0 + (size_t)i * WE_L;
        if (k == 0) { d.src = p.in[25] + (size_t)i * 2048 * DFF; d.dst = b + WO_G; d.K = 2048; d.N = DFF; }
        else if (k == 1) { d.src = p.in[26] + (size_t)i * 2048 * DFF; d.dst = b + WO_U; d.K = 2048; d.N = DFF; }
        else if (k == 2) { d.src = p.in[27] + (size_t)i * DFF * 2048; d.dst = b + WO_D; d.K = DFF; d.N = 2048; }
        else if (k == 3) { d.src = p.in[29] + (size_t)i * 2048 * 2048; d.dst = b + WO_PG; d.K = 2048; d.N = 2048; }
        else { d.src = p.in[30] + (size_t)i * PLE * 2048; d.dst = b + WO_PP; d.K = PLE; d.N = 2048; }
    }
    return d;
}
__device__ __forceinline__ void ph_convert_w(const Params& p, float* tile  ) {
    const int tid = threadIdx.x;
    for (int w = 0; w < 32; ++w) {
        const WDesc d = wdesc(p, w);
        const int tn = d.N / 64, tk = d.K / 64, nt = tn * tk;
        for (int t = blockIdx.x; t < nt; t += gridDim.x) {
            const int k0 = (t / tn) * 64, n0 = (t % tn) * 64;
            __syncthreads();
#pragma unroll
            for (int i = 0; i < 8; ++i) { const int kk = (tid >> 6) + 8 * i, n = tid & 63; tile[kk * 65 + n] = d.src[(size_t)(k0 + kk) * d.N + n0 + n]; }
            __syncthreads();
            { const int n = tid >> 3, k8 = (tid & 7) * 8; const float* s = tile + k8 * 65 + n;
              u32x4 o; o.x = pk2(s[0], s[65]); o.y = pk2(s[2 * 65], s[3 * 65]); o.z = pk2(s[4 * 65], s[5 * 65]); o.w = pk2(s[6 * 65], s[7 * 65]);
              *(u32x4*)(d.dst + (size_t)(n0 + n) * d.K + k0 + k8) = o; }
        }
    }
}

__device__ __forceinline__ void ph_init_h(const Params& p) {
    f32x4* h = (f32x4*)p.out; const f32x4* xp = (const f32x4*)p.in[0]; const f32x4* xs = (const f32x4*)p.in[1];
    const size_t np4 = (size_t)NPR * DM / 4, ns4 = (size_t)NSR * DM / 4;
    const size_t gt = (size_t)blockIdx.x * blockDim.x + threadIdx.x, ngt = (size_t)gridDim.x * blockDim.x;
    for (size_t i = gt; i < np4; i += ngt) h[i] = xp[i];
    for (size_t i = gt; i < ns4; i += ngt) h[np4 + i] = xs[i];
}

template <bool FINAL>
__device__ __forceinline__ void ph_rmsnorm_h(const Params& p, const float* g) {
    float* h = p.out; bf16_t* hn = (bf16_t*)(p.ws + WS_HN);
    const int lane = threadIdx.x & 63, gw = blockIdx.x * (blockDim.x >> 6) + (threadIdx.x >> 6), ngw = gridDim.x * (blockDim.x >> 6);
    for (int m = gw; m < MR; m += ngw) {
        f32x4* hr = (f32x4*)(h + (size_t)m * DM); f32x4 v[8]; float ss = 0.f;
#pragma unroll
        for (int j = 0; j < 8; ++j) { v[j] = hr[j * 64 + lane]; ss += v[j].x * v[j].x + v[j].y * v[j].y + v[j].z * v[j].z + v[j].w * v[j].w; }
        const float rstd = rsqrtf(wave_sum(ss) * (1.0f / DM) + EPS);
#pragma unroll
        for (int j = 0; j < 8; ++j) { const f32x4 gg = ((const f32x4*)g)[j * 64 + lane]; const f32x4 y = v[j] * rstd * gg;
            if (FINAL) hr[j * 64 + lane] = y;
            else { u32x2 o; o.x = pk2(y.x, y.y); o.y = pk2(y.z, y.w); *(u32x2*)(hn + (size_t)m * DM + (j * 64 + lane) * 4) = o; } }
    }
}

template <bool DUAL, class Epi>
__device__ __forceinline__ void naive_gemm(const bf16_t* A, int lda, const bf16_t* B0, const bf16_t* B1, int M, int N, int K, const Epi& epi) {
    const int tid = threadIdx.x, wid = tid >> 6, lane = tid & 63, r32 = lane & 31, hi = lane >> 5;
    const int tilesN = N / 64, ntiles = (M / 256) * tilesN;
    for (int t = blockIdx.x; t < ntiles; t += gridDim.x) {
        const int tm = t / tilesN, tn = t % tilesN;
        const int row0 = tm * 256 + wid * 32, col0 = tn * 64;
        const bf16_t* ap = A + (size_t)(row0 + r32) * lda + hi * 8;
        const bf16_t* bp0 = B0 + (size_t)(col0 + r32) * K + hi * 8;
        const bf16_t* bp1 = DUAL ? B1 + (size_t)(col0 + r32) * K + hi * 8 : bp0;
        f32x16 a00 = {}, a01 = {}, a10 = {}, a11 = {};
#pragma unroll 4
        for (int k = 0; k < K; k += 16) {
            const bf16x8 a = *(const bf16x8*)(ap + k);
            const bf16x8 b0 = *(const bf16x8*)(bp0 + k), b1 = *(const bf16x8*)(bp0 + (size_t)32 * K + k);
            a00 = __builtin_amdgcn_mfma_f32_32x32x16_bf16(a, b0, a00, 0, 0, 0);
            a01 = __builtin_amdgcn_mfma_f32_32x32x16_bf16(a, b1, a01, 0, 0, 0);
            if (DUAL) { const bf16x8 c0 = *(const bf16x8*)(bp1 + k), c1 = *(const bf16x8*)(bp1 + (size_t)32 * K + k);
                a10 = __builtin_amdgcn_mfma_f32_32x32x16_bf16(a, c0, a10, 0, 0, 0);
                a11 = __builtin_amdgcn_mfma_f32_32x32x16_bf16(a, c1, a11, 0, 0, 0); }
        }
#pragma unroll
        for (int r = 0; r < 16; ++r) { const int row = row0 + crow(r, hi);
            epi(row, col0 + r32, a00[r], a10[r]); epi(row, col0 + 32 + r32, a01[r], a11[r]); }
    }
}
struct EpiF32 { float* C; int ldc; __device__ __forceinline__ void operator()(int r, int c, float v, float) const { C[(size_t)r * ldc + c] = v; } };
struct EpiBf16 { bf16_t* C; int ldc; __device__ __forceinline__ void operator()(int r, int c, float v, float) const { C[(size_t)r * ldc + c] = (bf16_t)f2bf(v); } };
struct EpiResid { float* h; __device__ __forceinline__ void operator()(int r, int c, float v, float) const { h[(size_t)r * DM + c] += v; } };
struct EpiSwiglu { bf16_t* act; __device__ __forceinline__ void operator()(int r, int c, float g, float u) const { act[(size_t)r * DFF + c] = (bf16_t)f2bf(g / (1.0f + __expf(-g)) * u); } };
struct EpiPle { float* h; const float* t; __device__ __forceinline__ void operator()(int r, int c, float v, float) const { const size_t o = (size_t)r * DM + c; h[o] += t[o] / (1.0f + __expf(-v)); } };

__device__ __forceinline__ void ph_mla_norms(const Params& p, int j) {
    const float* a32 = (const float*)(p.ws + WS_A32); bf16_t* CQ = (bf16_t*)(p.ws + WS_CQ); bf16_t* LAT = (bf16_t*)(p.ws + WS_LAT); bf16_t* KR = (bf16_t*)(p.ws + WS_KR);
    const float* tm = (const float*)(p.ws + WS_TABM);
    const float* gq = p.in[10] + j * 512; const float* gkv = p.in[12] + j * 512; const float* gkr = p.in[17] + j * 64;
    const int lane = threadIdx.x & 63, gw = blockIdx.x * (blockDim.x >> 6) + (threadIdx.x >> 6), ngw = gridDim.x * (blockDim.x >> 6);
    for (int m = gw; m < MR; m += ngw) {
        const float* ar = a32 + (size_t)m * NIN_MLA;
        { f32x4 v0 = ((const f32x4*)ar)[lane], v1 = ((const f32x4*)ar)[64 + lane];
          const float ss = v0.x * v0.x + v0.y * v0.y + v0.z * v0.z + v0.w * v0.w + v1.x * v1.x + v1.y * v1.y + v1.z * v1.z + v1.w * v1.w;
          const float rstd = rsqrtf(wave_sum(ss) * (1.0f / 512) + EPS);
          const f32x4 y0 = v0 * rstd * ((const f32x4*)gq)[lane], y1 = v1 * rstd * ((const f32x4*)gq)[64 + lane];
          u32x2 o0, o1; o0.x = pk2(y0.x, y0.y); o0.y = pk2(y0.z, y0.w); o1.x = pk2(y1.x, y1.y); o1.y = pk2(y1.z, y1.w);
          *(u32x2*)(CQ + (size_t)m * 512 + lane * 4) = o0; *(u32x2*)(CQ + (size_t)m * 512 + 256 + lane * 4) = o1; }
        { f32x4 v0 = ((const f32x4*)(ar + 512))[lane], v1 = ((const f32x4*)(ar + 512))[64 + lane];
          const float ss = v0.x * v0.x + v0.y * v0.y + v0.z * v0.z + v0.w * v0.w + v1.x * v1.x + v1.y * v1.y + v1.z * v1.z + v1.w * v1.w;
          const float rstd = rsqrtf(wave_sum(ss) * (1.0f / 512) + EPS);
          const f32x4 y0 = v0 * rstd * ((const f32x4*)gkv)[lane], y1 = v1 * rstd * ((const f32x4*)gkv)[64 + lane];
          float* o32 = (m < NPR) ? p.out + O_LATP + ((size_t)j * NPR + m) * 512 : p.out + O_LATS + ((size_t)j * NSR + (m - NPR)) * 512;
          ((f32x4*)o32)[lane] = y0; ((f32x4*)o32)[64 + lane] = y1;
          u32x2 o0, o1; o0.x = pk2(y0.x, y0.y); o0.y = pk2(y0.z, y0.w); o1.x = pk2(y1.x, y1.y); o1.y = pk2(y1.z, y1.w);
          bf16_t* lr = LAT + (size_t)latrow_of(m) * 512;
          *(u32x2*)(lr + lane * 4) = o0; *(u32x2*)(lr + 256 + lane * 4) = o1; }
        { const float x = ar[1024 + lane]; const float rstd = rsqrtf(wave_sum(x * x) * (1.0f / 64) + EPS);
          const float y = x * rstd * gkr[lane]; const float pr = __shfl_xor(y, 32);
          const int pos = pos_of_row(m), i = lane & 31; const float c = tm[(pos * 32 + i) * 2], s = tm[(pos * 32 + i) * 2 + 1];
          const float o = lane < 32 ? y * c - pr * s : y * c + pr * s;
          float* o32 = (m < NPR) ? p.out + O_KRP + ((size_t)j * NPR + m) * 64 : p.out + O_KRS + ((size_t)j * NSR + (m - NPR)) * 64;
          o32[lane] = o; KR[(size_t)latrow_of(m) * 64 + lane] = (bf16_t)f2bf(o); }
    }
    const float* cl = p.in[4] + (size_t)j * DBATCH * PAST * 512; const float* ck = p.in[5] + (size_t)j * DBATCH * PAST * 64;
    for (int r = gw; r < DBATCH * PAST; r += ngw) {
        const int b = r >> 10, t = r & 1023; const size_t dr = (size_t)NPR + b * KVPB + t;
        const f32x4 v0 = ((const f32x4*)(cl + (size_t)r * 512))[lane], v1 = ((const f32x4*)(cl + (size_t)r * 512))[64 + lane];
        u32x2 o0, o1; o0.x = pk2(v0.x, v0.y); o0.y = pk2(v0.z, v0.w); o1.x = pk2(v1.x, v1.y); o1.y = pk2(v1.z, v1.w);
        *(u32x2*)(LAT + dr * 512 + lane * 4) = o0; *(u32x2*)(LAT + dr * 512 + 256 + lane * 4) = o1;
        KR[dr * 64 + lane] = (bf16_t)f2bf(ck[(size_t)r * 64 + lane]);
    }
}

__device__ __forceinline__ void ph_mla_headnorm(const Params& p, int j) {
    bf16_t* Q = (bf16_t*)(p.ws + WS_Q); bf16_t* KV = (bf16_t*)(p.ws + WS_KV); const float* tm = (const float*)(p.ws + WS_TABM);
    const float* gqn = p.in[14] + j * 128; const float* gqr = p.in[15] + j * 64; const float* gkn = p.in[16] + j * 128;
    const int lane = threadIdx.x & 63, gw = blockIdx.x * (blockDim.x >> 6) + (threadIdx.x >> 6), ngw = gridDim.x * (blockDim.x >> 6);
    for (int it = gw; it < MR * 16; it += ngw) {
        const int m = it >> 4, h = it & 15; bf16_t* q = Q + (size_t)m * NQUP + h * 192;
        { const unsigned w = *(const unsigned*)(q + 2 * lane); const float x0 = __uint_as_float(w << 16), x1 = __uint_as_float(w & 0xffff0000u);
          const float rstd = rsqrtf(wave_sum(x0 * x0 + x1 * x1) * (1.0f / 128) + EPS);
          *(unsigned*)(q + 2 * lane) = pk2(x0 * rstd * gqn[2 * lane], x1 * rstd * gqn[2 * lane + 1]); }
        { const float x = bf2f(q[128 + lane]); const float rstd = rsqrtf(wave_sum(x * x) * (1.0f / 64) + EPS);
          const float y = x * rstd * gqr[lane]; const float pr = __shfl_xor(y, 32);
          const int pos = pos_of_row(m), i = lane & 31; const float c = tm[(pos * 32 + i) * 2], s = tm[(pos * 32 + i) * 2 + 1];
          q[128 + lane] = (bf16_t)f2bf(lane < 32 ? y * c - pr * s : y * c + pr * s); }
    }
    for (int it = gw; it < NKVR * 16; it += ngw) {
        const int r = it >> 4, h = it & 15; bf16_t* k = KV + (size_t)r * NKVUP + h * 256;
        const unsigned w = *(const unsigned*)(k + 2 * lane); const float x0 = __uint_as_float(w << 16), x1 = __uint_as_float(w & 0xffff0000u);
        const float rstd = rsqrtf(wave_sum(x0 * x0 + x1 * x1) * (1.0f / 128) + EPS);
        *(unsigned*)(k + 2 * lane) = pk2(x0 * rstd * gkn[2 * lane], x1 * rstd * gkn[2 * lane + 1]);
    }
}

#define SBAR() __builtin_amdgcn_sched_barrier(0)
__device__ __forceinline__ unsigned cvtpk(float lo, float hi) { unsigned r; asm volatile("v_cvt_pk_bf16_f32 %0, %1, %2" : "=v"(r) : "v"(lo), "v"(hi)); return r; }
#define PK4(P, BASE, OUT) do { unsigned a0_ = cvtpk(P[BASE + 0], P[BASE + 1]), a1_ = cvtpk(P[BASE + 2], P[BASE + 3]);   \
    unsigned b0_ = cvtpk(P[BASE + 4], P[BASE + 5]), b1_ = cvtpk(P[BASE + 6], P[BASE + 7]);                              \
    auto r0_ = __builtin_amdgcn_permlane32_swap(a0_, b0_, false, false); auto r1_ = __builtin_amdgcn_permlane32_swap(a1_, b1_, false, false); \
    u32x4 w_ = {r0_[0], r1_[0], r0_[1], r1_[1]}; OUT = *reinterpret_cast<bf16x8*>(&w_); } while (0)
__device__ __forceinline__ float half_swap_max(float v) { auto rr = __builtin_amdgcn_permlane32_swap(__float_as_uint(v), __float_as_uint(v), false, false); return fmaxf(__uint_as_float(rr[0]), __uint_as_float(rr[1])); }
__device__ __forceinline__ float half_swap_sum(float v) { auto rr = __builtin_amdgcn_permlane32_swap(__float_as_uint(v), __float_as_uint(v), false, false); return __uint_as_float(rr[0]) + __uint_as_float(rr[1]); }
template <int NC> __device__ __forceinline__ int v_st(int k, int c) { const int kk = (k & ~0xC) | ((k & 4) << 1) | ((k & 8) >> 1); return ((kk >> 3) * (NC / 32) + (c >> 5)) * 512 + ((kk & 7) * 32 + (c & 31)) * 2; }
__device__ __forceinline__ int v_rd_base(int lane) { return ((lane & 3) << 3) | (((lane >> 2) & 3) << 6) | (((lane >> 4) & 1) << 5) | (((lane >> 5) & 1) << 8); }
template <int NC> constexpr int v_rd_off(int d0, int ks, int half) { return d0 * 512 + ks * (NC / 32) * 1024 + half * (NC / 32) * 512; }
template <int OFF> __device__ __forceinline__ s16x4 tr_read(int vb) { s16x4 r; asm volatile("ds_read_b64_tr_b16 %0, %1 offset:%2" : "=&v"(r) : "v"(vb), "i"(OFF) : "memory"); return r; }
#define PKV(L, H) (bf16x8){L[0], L[1], L[2], L[3], H[0], H[1], H[2], H[3]}
template <int NC, int D0> __device__ __forceinline__ void pv_one(f32x16& od, int vb, bf16x8 pa0, bf16x8 pa1, bf16x8 pa2, bf16x8 pa3) {
    const s16x4 l0 = tr_read<v_rd_off<NC>(D0, 0, 0)>(vb), h0 = tr_read<v_rd_off<NC>(D0, 0, 1)>(vb), l1 = tr_read<v_rd_off<NC>(D0, 1, 0)>(vb), h1 = tr_read<v_rd_off<NC>(D0, 1, 1)>(vb);
    const s16x4 l2 = tr_read<v_rd_off<NC>(D0, 2, 0)>(vb), h2 = tr_read<v_rd_off<NC>(D0, 2, 1)>(vb), l3 = tr_read<v_rd_off<NC>(D0, 3, 0)>(vb), h3 = tr_read<v_rd_off<NC>(D0, 3, 1)>(vb);
    asm volatile("s_waitcnt lgkmcnt(0)" ::: "memory"); SBAR();
    od = __builtin_amdgcn_mfma_f32_32x32x16_bf16(pa0, PKV(l0, h0), od, 0, 0, 0);
    od = __builtin_amdgcn_mfma_f32_32x32x16_bf16(pa1, PKV(l1, h1), od, 0, 0, 0);
    od = __builtin_amdgcn_mfma_f32_32x32x16_bf16(pa2, PKV(l2, h2), od, 0, 0, 0);
    od = __builtin_amdgcn_mfma_f32_32x32x16_bf16(pa3, PKV(l3, h3), od, 0, 0, 0);
}
#define KSWZ256(row, colB) ((row) * 256 + ((colB) ^ (((row) & 7) << 4)))
#define KSWZ128(row, colB) ((row) * 128 + ((colB) ^ (((row) & 7) << 4)))

constexpr int MLA_V = 0, MLA_K = 32768, MLA_KR = 65536, MLA_WS = 81920, MLA_LDS = 83968;
constexpr float MLA_C = 0.07216878364870322f * LOG2E;
__device__ __forceinline__ void mla_attn_unit(const bf16_t* Qh, int nq, const bf16_t* KVh, const bf16_t* KRb, int nkeys, int NT, int my_nt, bf16_t* Oh, char* lds) {
    const int tid = threadIdx.x, wid = tid >> 6, lane = tid & 63, r32 = lane & 31, hi = lane >> 5;
    char* V_lds = lds + MLA_V; char* K_lds = lds + MLA_K; char* KR_lds = lds + MLA_KR;
    float* wsf = (float*)(lds + MLA_WS) + wid * 64;
    bf16x8 qr[12];
    { int qrow = wid * 32 + r32; if (qrow > nq - 1) qrow = nq - 1; const bf16_t* qp = Qh + (size_t)qrow * NQUP + hi * 8;
#pragma unroll
      for (int d0 = 0; d0 < 12; ++d0) qr[d0] = *(const bf16x8*)(qp + d0 * 16); }
    const int sr = tid >> 4, sc = (tid & 15) * 8, vst0 = v_st<128>(sr, sc), vst1 = v_st<128>(32 + sr, sc);
    const int krr = tid >> 3, krc = (tid & 7) * 8;
    const int vb0 = (int)(uintptr_t)V_lds + v_rd_base(lane);
    bf16x8 sv0, sv1, sk0, sk1, skr;
#define MLA_SLOAD(t) do { int ra = (t) * 64 + sr, rb = ra + 32, rc = (t) * 64 + krr; if (ra > nkeys - 1) ra = nkeys - 1; if (rb > nkeys - 1) rb = nkeys - 1; if (rc > nkeys - 1) rc = nkeys - 1; \
        sk0 = *(const bf16x8*)(KVh + (size_t)ra * NKVUP + sc); sk1 = *(const bf16x8*)(KVh + (size_t)rb * NKVUP + sc); \
        sv0 = *(const bf16x8*)(KVh + (size_t)ra * NKVUP + 128 + sc); sv1 = *(const bf16x8*)(KVh + (size_t)rb * NKVUP + 128 + sc); \
        skr = *(const bf16x8*)(KRb + (size_t)rc * 64 + krc); } while (0)
#define MLA_SWRITE(b) do { *(bf16x8*)(V_lds + (b) * 16384 + vst0) = sv0; *(bf16x8*)(V_lds + (b) * 16384 + vst1) = sv1; \
        *(bf16x8*)(K_lds + (b) * 16384 + KSWZ256(sr, sc * 2)) = sk0; *(bf16x8*)(K_lds + (b) * 16384 + KSWZ256(32 + sr, sc * 2)) = sk1; \
        *(bf16x8*)(KR_lds + (b) * 8192 + KSWZ128(krr, krc * 2)) = skr; } while (0)
    float m_reg = -1e30f, l_reg = 0.f; f32x16 o[4] = {};
    MLA_SLOAD(0); asm volatile("s_waitcnt vmcnt(0)" ::: "memory"); MLA_SWRITE(0); __syncthreads();
    for (int j = 0; j < NT; ++j) {
        const int b = j & 1;
        if (j < my_nt) {
            f32x16 p0 = {}, p1 = {};
            const char* Kb = K_lds + b * 16384; const char* KRp = KR_lds + b * 8192;
#pragma unroll
            for (int d0 = 0; d0 < 8; ++d0) { const int cb = (d0 * 16 + hi * 8) * 2;
                const bf16x8 k0 = *(const bf16x8*)(Kb + KSWZ256(r32, cb)), k1 = *(const bf16x8*)(Kb + KSWZ256(32 + r32, cb));
                p0 = __builtin_amdgcn_mfma_f32_32x32x16_bf16(k0, qr[d0], p0, 0, 0, 0);
                p1 = __builtin_amdgcn_mfma_f32_32x32x16_bf16(k1, qr[d0], p1, 0, 0, 0); if (d0 & 1) SBAR(); }
#pragma unroll
            for (int d0 = 0; d0 < 4; ++d0) { const int cb = (d0 * 16 + hi * 8) * 2;
                const bf16x8 k0 = *(const bf16x8*)(KRp + KSWZ128(r32, cb)), k1 = *(const bf16x8*)(KRp + KSWZ128(32 + r32, cb));
                p0 = __builtin_amdgcn_mfma_f32_32x32x16_bf16(k0, qr[8 + d0], p0, 0, 0, 0);
                p1 = __builtin_amdgcn_mfma_f32_32x32x16_bf16(k1, qr[8 + d0], p1, 0, 0, 0); if (d0 & 1) SBAR(); }
            if (j * 64 + 64 > nkeys) {
#pragma unroll
                for (int r = 0; r < 16; ++r) { const int kk = j * 64 + crow(r, hi); if (kk >= nkeys) p0[r] = -1e30f; if (kk + 32 >= nkeys) p1[r] = -1e30f; }
            }
            float pmax = p0[0];
#pragma unroll
            for (int r = 1; r < 16; ++r) pmax = fmaxf(pmax, p0[r]);
#pragma unroll
            for (int r = 0; r < 16; ++r) pmax = fmaxf(pmax, p1[r]);
            pmax = half_swap_max(pmax);
            const float mn = fmaxf(m_reg, pmax); const float alpha = __builtin_amdgcn_exp2f((m_reg - mn) * MLA_C); m_reg = mn;
            const float mnC = -mn * MLA_C; float ps = 0.f;
#pragma unroll
            for (int r = 0; r < 16; ++r) { p0[r] = __builtin_amdgcn_exp2f(fmaf(p0[r], MLA_C, mnC)); p1[r] = __builtin_amdgcn_exp2f(fmaf(p1[r], MLA_C, mnC)); ps += p0[r] + p1[r]; }
            ps = half_swap_sum(ps);
            l_reg = l_reg * alpha + ps;
            bf16x8 pa0, pa1, pa2, pa3;
            PK4(p0, 0, pa0); PK4(p0, 8, pa1); PK4(p1, 0, pa2); PK4(p1, 8, pa3);
            if (hi == 0) wsf[r32] = alpha; asm volatile("s_waitcnt lgkmcnt(0)" ::: "memory");
#pragma unroll
            for (int r = 0; r < 16; ++r) { const float a = wsf[crow(r, hi)];
#pragma unroll
                for (int d = 0; d < 4; ++d) o[d][r] *= a; }
            asm volatile("s_waitcnt lgkmcnt(0)" ::: "memory");
            const int vb = vb0 + b * 16384;
            pv_one<128, 0>(o[0], vb, pa0, pa1, pa2, pa3); pv_one<128, 1>(o[1], vb, pa0, pa1, pa2, pa3);
            pv_one<128, 2>(o[2], vb, pa0, pa1, pa2, pa3); pv_one<128, 3>(o[3], vb, pa0, pa1, pa2, pa3);
        }
        if (j + 1 < NT) { MLA_SLOAD(j + 1); asm volatile("s_waitcnt vmcnt(0)" ::: "memory"); MLA_SWRITE(b ^ 1); }
        __syncthreads();
    }
    if (hi == 0) wsf[32 + r32] = l_reg; asm volatile("s_waitcnt lgkmcnt(0)" ::: "memory");
#pragma unroll
    for (int r = 0; r < 16; ++r) { const int orow = wid * 32 + crow(r, hi); const float rl = 1.0f / wsf[32 + crow(r, hi)];
        if (orow < nq) {
#pragma unroll
            for (int d = 0; d < 4; ++d) Oh[(size_t)orow * DM + d * 32 + r32] = (bf16_t)f2bf(o[d][r] * rl); } }
    __syncthreads();
#undef MLA_SLOAD
#undef MLA_SWRITE
}
__device__ __forceinline__ void ph_mla_attn(const Params& p, char* lds) {
    const bf16_t* Q = (const bf16_t*)(p.ws + WS_Q); const bf16_t* KV = (const bf16_t*)(p.ws + WS_KV); const bf16_t* KR = (const bf16_t*)(p.ws + WS_KR); bf16_t* O = (bf16_t*)(p.ws + WS_O);
    const int wid = threadIdx.x >> 6;
    for (int pi = blockIdx.x; pi < 512; pi += gridDim.x) {
        const int bh = pi >> 3, s = pi & 7, b = bh >> 4, h = bh & 15;
        for (int e = 0; e < 2; ++e) { const int qb = e ? 15 - s : s; const size_t row0 = (size_t)b * SEQ + qb * 256;
            mla_attn_unit(Q + row0 * NQUP + h * 192, 256, KV + (size_t)b * SEQ * NKVUP + h * 256, KR + (size_t)b * SEQ * 64, SEQ, 4 * qb + 4, 4 * qb + (wid >> 1) + 1, O + row0 * DM + h * 128, lds); }
    }
    for (int u = blockIdx.x; u < DBATCH * 16; u += gridDim.x) {
        const int b = u >> 4, h = u & 15; const size_t row0 = (size_t)NPR + b * 16, kr0 = (size_t)NPR + b * KVPB;
        mla_attn_unit(Q + row0 * NQUP + h * 192, 16, KV + kr0 * NKVUP + h * 256, KR + kr0 * 64, KVPB, 17, wid == 0 ? 17 : 0, O + row0 * DM + h * 128, lds);
    }
}

__device__ __forceinline__ void ph_swa_prep(const Params& p, int j) {
    const float* qkv = (const float*)(p.ws + WS_QKV32); bf16_t* SQ = (bf16_t*)(p.ws + WS_SQ); bf16_t* SK = (bf16_t*)(p.ws + WS_SK); bf16_t* SV = (bf16_t*)(p.ws + WS_SV);
    const float* ts = (const float*)(p.ws + WS_TABS); const float* gq = p.in[20] + j * 64; const float* gk = p.in[21] + j * 64;
    const int lane = threadIdx.x & 63, gw = blockIdx.x * (blockDim.x >> 6) + (threadIdx.x >> 6), ngw = gridDim.x * (blockDim.x >> 6);
    for (int it = gw; it < MR * 40; it += ngw) {
        const int m = it / 40, s = it % 40; const float x = qkv[(size_t)m * NQKV + s * 64 + lane];
        float y = x;
        if (s < 36) {
            const float rstd = rsqrtf(wave_sum(x * x) * (1.0f / 64) + EPS); y = x * rstd * (s < 32 ? gq[lane] : gk[lane]);
            const float pr = __shfl_xor(y, 8); const int pos = pos_of_row(m), i = lane & 7;
            const float c = ts[(pos * 8 + i) * 2], sn = ts[(pos * 8 + i) * 2 + 1];
            if (lane < 8) y = y * c - pr * sn; else if (lane < 16) y = y * c + pr * sn;
        }
        if (s < 32) SQ[(size_t)m * DM + s * 64 + lane] = (bf16_t)f2bf(y);
        else {
            const int g = (s - 32) & 3; const bool isk = s < 36; bf16_t* dst = isk ? SK : SV;
            dst[(size_t)skrow_of(m) * 256 + g * 64 + lane] = (bf16_t)f2bf(y);
            if (m < NPR) { const int b = m >> 12, t = m & 4095;
                if (t >= SEQ - 128) p.out[(isk ? O_SKP : O_SVP) + (((size_t)j * 4 + b) * 128 + (t - (SEQ - 128))) * 256 + g * 64 + lane] = y; }
            else { const int b = (m - NPR) >> 4, t = (m - NPR) & 15;
                p.out[(isk ? O_SKS : O_SVS) + (((size_t)j * 16 + b) * 128 + 112 + t) * 256 + g * 64 + lane] = y; }
        }
    }
    const float* sk = p.in[6] + (size_t)j * DBATCH * 128 * 256; const float* sv = p.in[7] + (size_t)j * DBATCH * 128 * 256;
    for (int r = gw; r < DBATCH * 128; r += ngw) {
        const int b = r >> 7, i = r & 127; const size_t dr = (size_t)NPR + b * SWPB + i;
        const f32x4 kx = ((const f32x4*)(sk + (size_t)r * 256))[lane], vx = ((const f32x4*)(sv + (size_t)r * 256))[lane];
        u32x2 ko, vo; ko.x = pk2(kx.x, kx.y); ko.y = pk2(kx.z, kx.w); vo.x = pk2(vx.x, vx.y); vo.y = pk2(vx.z, vx.w);
        *(u32x2*)(SK + dr * 256 + lane * 4) = ko; *(u32x2*)(SV + dr * 256 + lane * 4) = vo;
        if (i >= 16) { ((f32x4*)(p.out + O_SKS + (((size_t)j * 16 + b) * 128 + (i - 16)) * 256))[lane] = kx;
                       ((f32x4*)(p.out + O_SVS + (((size_t)j * 16 + b) * 128 + (i - 16)) * 256))[lane] = vx; }
    }
}

constexpr int SWA_K = 0, SWA_V = 24576, SWA_LDS = 49152;
__device__ __forceinline__ void swa_attn_unit(const bf16_t* Qb, int nq, const bf16_t* Kb, const bf16_t* Vb, int nkeys, const float* sinks8, bf16_t* Ob, char* lds) {
    const int tid = threadIdx.x, wid = tid >> 6, lane = tid & 63, r32 = lane & 31, hi = lane >> 5;
    char* K_lds = lds + SWA_K; char* V_lds = lds + SWA_V;
#pragma unroll
    for (int i = 0; i < 3; ++i) { const int idx = tid + i * 512, row = idx >> 3, ch = idx & 7; const bool valid = row < nkeys; const int rr = valid ? row : 0;
        bf16x8 kx = *(const bf16x8*)(Kb + (size_t)rr * 256 + ch * 8), vx = *(const bf16x8*)(Vb + (size_t)rr * 256 + ch * 8);
        if (!valid) { kx = (bf16x8){0, 0, 0, 0, 0, 0, 0, 0}; vx = kx; }
        *(bf16x8*)(K_lds + KSWZ128(row, ch * 16)) = kx;
        *(bf16x8*)(V_lds + (row >> 6) * 8192 + v_st<64>(row & 63, ch * 8)) = vx; }
    __syncthreads();
    const float sink = sinks8[wid]; const int vb0 = (int)(uintptr_t)V_lds + v_rd_base(lane);
    constexpr float SC = 0.125f * LOG2E;
    for (int q2 = 0; q2 * 32 < nq; ++q2) {
        bf16x8 qr[4];
        { int qrow = q2 * 32 + r32; if (qrow > nq - 1) qrow = nq - 1; const bf16_t* qp = Qb + (size_t)qrow * DM + wid * 64 + hi * 8;
#pragma unroll
          for (int d0 = 0; d0 < 4; ++d0) qr[d0] = *(const bf16x8*)(qp + d0 * 16); }
        f32x16 s[6]; float mx = -1e30f;
#pragma unroll
        for (int kb = 0; kb < 6; ++kb) {
            s[kb] = (f32x16){};
            if (kb * 32 < nkeys) {
#pragma unroll
                for (int d0 = 0; d0 < 4; ++d0) { const bf16x8 kf = *(const bf16x8*)(K_lds + KSWZ128(kb * 32 + r32, (d0 * 16 + hi * 8) * 2));
                    s[kb] = __builtin_amdgcn_mfma_f32_32x32x16_bf16(kf, qr[d0], s[kb], 0, 0, 0); }
            }
#pragma unroll
            for (int r = 0; r < 16; ++r) { if (kb * 32 + crow(r, hi) >= nkeys) s[kb][r] = -1e30f; mx = fmaxf(mx, s[kb][r]); }
        }
        mx = half_swap_max(mx);
        const float m = fmaxf(mx * 0.125f, sink); const float mC = -m * LOG2E; float sum = 0.f;
#pragma unroll
        for (int kb = 0; kb < 6; ++kb)
#pragma unroll
            for (int r = 0; r < 16; ++r) { s[kb][r] = __builtin_amdgcn_exp2f(fmaf(s[kb][r], SC, mC)); sum += s[kb][r]; }
        sum = half_swap_sum(sum);
        const float inv = 1.0f / (sum + __builtin_amdgcn_exp2f((sink - m) * LOG2E));
        f32x16 o0 = {}, o1 = {};
#pragma unroll
        for (int kb = 0; kb < 6; ++kb) {
            if (kb * 32 < nkeys) {
#pragma unroll
                for (int r = 0; r < 16; ++r) s[kb][r] *= inv;
                bf16x8 pa, pb; PK4(s[kb], 0, pa); PK4(s[kb], 8, pb);
                const int vb = vb0 + (kb >> 1) * 8192 + (kb & 1) * 2 * 2048;
                const s16x4 l0 = tr_read<0>(vb), h0 = tr_read<1024>(vb), l1 = tr_read<2048>(vb), h1 = tr_read<3072>(vb);
                const s16x4 m0 = tr_read<512>(vb), n0 = tr_read<1536>(vb), m1 = tr_read<2560>(vb), n1 = tr_read<3584>(vb);
                asm volatile("s_waitcnt lgkmcnt(0)" ::: "memory"); SBAR();
                o0 = __builtin_amdgcn_mfma_f32_32x32x16_bf16(pa, PKV(l0, h0), o0, 0, 0, 0);
                o0 = __builtin_amdgcn_mfma_f32_32x32x16_bf16(pb, PKV(l1, h1), o0, 0, 0, 0);
                o1 = __builtin_amdgcn_mfma_f32_32x32x16_bf16(pa, PKV(m0, n0), o1, 0, 0, 0);
                o1 = __builtin_amdgcn_mfma_f32_32x32x16_bf16(pb, PKV(m1, n1), o1, 0, 0, 0);
            }
        }
#pragma unroll
        for (int r = 0; r < 16; ++r) { const int orow = q2 * 32 + crow(r, hi);
            if (orow < nq) { Ob[(size_t)orow * DM + wid * 64 + r32] = (bf16_t)f2bf(o0[r]); Ob[(size_t)orow * DM + wid * 64 + 32 + r32] = (bf16_t)f2bf(o1[r]); } }
    }
    __syncthreads();
}
__device__ __forceinline__ void ph_swa_attn(const Params& p, int j, char* lds) {
    const bf16_t* SQ = (const bf16_t*)(p.ws + WS_SQ); const bf16_t* SK = (const bf16_t*)(p.ws + WS_SK); const bf16_t* SV = (const bf16_t*)(p.ws + WS_SV); bf16_t* O = (bf16_t*)(p.ws + WS_O);
    const float* sinks = p.in[22] + j * 32;
    for (int u = blockIdx.x; u < 4 * 4 * 64; u += gridDim.x) {
        const int c = u & 63, g = (u >> 6) & 3, b = u >> 8; const int c0 = c >= 2 ? c - 2 : 0, nk = (c - c0 + 1) * 64;
        const size_t qrow0 = (size_t)b * SEQ + c * 64, krow0 = (size_t)b * SEQ + c0 * 64;
        swa_attn_unit(SQ + qrow0 * DM + g * 512, 64, SK + krow0 * 256 + g * 64, SV + krow0 * 256 + g * 64, nk, sinks + g * 8, O + qrow0 * DM + g * 512, lds);
    }
    for (int u = blockIdx.x; u < DBATCH * 4; u += gridDim.x) {
        const int g = u & 3, b = u >> 2; const size_t qrow0 = (size_t)NPR + b * 16, krow0 = (size_t)NPR + b * SWPB;
        swa_attn_unit(SQ + qrow0 * DM + g * 512, 16, SK + krow0 * 256 + g * 64, SV + krow0 * 256 + g * 64, SWPB, sinks + g * 8, O + qrow0 * DM + g * 512, lds);
    }
}

__device__ __forceinline__ void ph_ple_prep(const Params& p, int i) {
    bf16_t* PB = (bf16_t*)(p.ws + WS_PB);
    const f32x4* pp = (const f32x4*)(p.in[2] + (size_t)i * NPR * PLE); const f32x4* ps = (const f32x4*)(p.in[3] + (size_t)i * NSR * PLE);
    const size_t np4 = (size_t)NPR * PLE / 4, ns4 = (size_t)NSR * PLE / 4;
    const size_t gt = (size_t)blockIdx.x * blockDim.x + threadIdx.x, ngt = (size_t)gridDim.x * blockDim.x;
    for (size_t k = gt; k < np4 + ns4; k += ngt) { const f32x4 v = k < np4 ? pp[k] : ps[k - np4]; u32x2 o; o.x = pk2(v.x, v.y); o.y = pk2(v.z, v.w); *(u32x2*)(PB + k * 4) = o; }
}

enum { PH_TABLES, PH_CONVW, PH_INITH, PH_NORM_ATTN, PH_MLA_IN, PH_MLA_NORMS, PH_MLA_QUP, PH_MLA_KVUP, PH_MLA_HEADNORM, PH_MLA_ATTN, PH_MLA_OUT,
       PH_SWA_QKV, PH_SWA_PREP, PH_SWA_ATTN, PH_SWA_OUT, PH_NORM_FFN, PH_FFN_UP, PH_FFN_DOWN, PH_NORM_PLE, PH_PLE_PREP, PH_PLE_PROJ, PH_PLE_GATE, PH_FINAL };

template <int PH> __global__ void __launch_bounds__(512) k_stage(Params p, int i) {
    extern __shared__ __attribute__((aligned(16))) char lds[];
    const int j = i >> 1;
    bf16_t* W = (bf16_t*)(p.ws + WS_W); bf16_t* HN = (bf16_t*)(p.ws + WS_HN); bf16_t* O = (bf16_t*)(p.ws + WS_O);
    const bf16_t* Wm = W + (size_t)j * WE_MLA; const bf16_t* Wsw = W + WE_SWA0 + (size_t)j * WE_SWA; const bf16_t* Wl = W + WE_L0 + (size_t)i * WE_L;
    if constexpr (PH == PH_TABLES) ph_tables(p);
    if constexpr (PH == PH_CONVW) ph_convert_w(p, (float*)lds);
    if constexpr (PH == PH_INITH) ph_init_h(p);
    if constexpr (PH == PH_NORM_ATTN) ph_rmsnorm_h<false>(p, p.in[8] + i * DM);
    if constexpr (PH == PH_NORM_FFN) ph_rmsnorm_h<false>(p, p.in[24] + i * DM);
    if constexpr (PH == PH_NORM_PLE) ph_rmsnorm_h<false>(p, p.in[28] + i * DM);
    if constexpr (PH == PH_FINAL) ph_rmsnorm_h<true>(p, p.in[31]);
    if constexpr (PH == PH_MLA_IN) naive_gemm<false>(HN, DM, Wm + WO_IN, nullptr, MR, NIN_MLA, DM, EpiF32{(float*)(p.ws + WS_A32), NIN_MLA});
    if constexpr (PH == PH_MLA_NORMS) ph_mla_norms(p, j);
    if constexpr (PH == PH_MLA_QUP) naive_gemm<false>((const bf16_t*)(p.ws + WS_CQ), 512, Wm + WO_QUP, nullptr, MR, NQUP, 512, EpiBf16{(bf16_t*)(p.ws + WS_Q), NQUP});
    if constexpr (PH == PH_MLA_KVUP) naive_gemm<false>((const bf16_t*)(p.ws + WS_LAT), 512, Wm + WO_KVUP, nullptr, NKVR, NKVUP, 512, EpiBf16{(bf16_t*)(p.ws + WS_KV), NKVUP});
    if constexpr (PH == PH_MLA_HEADNORM) ph_mla_headnorm(p, j);
    if constexpr (PH == PH_MLA_ATTN) ph_mla_attn(p, lds);
    if constexpr (PH == PH_MLA_OUT) naive_gemm<false>(O, DM, Wm + WO_MOUT, nullptr, MR, DM, DM, EpiResid{p.out});
    if constexpr (PH == PH_SWA_QKV) naive_gemm<false>(HN, DM, Wsw + WO_QKV, nullptr, MR, NQKV, DM, EpiF32{(float*)(p.ws + WS_QKV32), NQKV});
    if constexpr (PH == PH_SWA_PREP) ph_swa_prep(p, j);
    if constexpr (PH == PH_SWA_ATTN) ph_swa_attn(p, j, lds);
    if constexpr (PH == PH_SWA_OUT) naive_gemm<false>(O, DM, Wsw + WO_SOUT, nullptr, MR, DM, DM, EpiResid{p.out});
    if constexpr (PH == PH_FFN_UP) naive_gemm<true>(HN, DM, Wl + WO_G, Wl + WO_U, MR, DFF, DM, EpiSwiglu{(bf16_t*)(p.ws + WS_ACT)});
    if constexpr (PH == PH_FFN_DOWN) naive_gemm<false>((const bf16_t*)(p.ws + WS_ACT), DFF, Wl + WO_D, nullptr, MR, DM, DFF, EpiResid{p.out});
    if constexpr (PH == PH_PLE_PREP) ph_ple_prep(p, i);
    if constexpr (PH == PH_PLE_PROJ) naive_gemm<false>((const bf16_t*)(p.ws + WS_PB), PLE, Wl + WO_PP, nullptr, MR, DM, PLE, EpiF32{(float*)(p.ws + WS_T32), DM});
    if constexpr (PH == PH_PLE_GATE) naive_gemm<false>(HN, DM, Wl + WO_PG, nullptr, MR, DM, DM, EpiPle{p.out, (const float*)(p.ws + WS_T32)});
}

__global__ void k_report(float* out, float v) { if (threadIdx.x == 0 && blockIdx.x == 0) out[0] = v; }

template <int PH> static void launch_stage(const Params& p, int i, int grid, size_t lds_bytes, hipStream_t s) {
    static bool attr = false;
    if (!attr) { (void)hipFuncSetAttribute((const void*)k_stage<PH>, hipFuncAttributeMaxDynamicSharedMemorySize, (int)lds_bytes); attr = true; }
    hipLaunchKernelGGL((k_stage<PH>), dim3(grid), dim3(512), lds_bytes, s, p, i);
}

extern "C" void kernel_launch(void* const* d_in, const int* in_sizes, int n_in, void* d_out, int out_size, void* d_ws, size_t ws_size, hipStream_t stream) {
    if (n_in != 32 || (size_t)out_size != O_END || ws_size < WS_END) {
        fprintf(stderr, "kernel_launch: unexpected sizes n_in %d out %d ws %zu (need %zu)\n", n_in, out_size, ws_size, (size_t)WS_END);
        hipLaunchKernelGGL(k_report, dim3(1), dim3(64), 0, stream, (float*)d_out, (float)(ws_size >> 20));
        return;
    }
    Params p{};
    for (int k = 0; k < 32; ++k) p.in[k] = (const float*)d_in[k];
    p.out = (float*)d_out; p.ws = (unsigned char*)d_ws;
    const int G = 1024;
    launch_stage<PH_TABLES>(p, 0, 256, 0, stream);
    launch_stage<PH_CONVW>(p, 0, G, 64 * 65 * 4, stream);
    launch_stage<PH_INITH>(p, 0, G, 0, stream);
    for (int i = 0; i < 4; ++i) {
        launch_stage<PH_NORM_ATTN>(p, i, G, 0, stream);
        if ((i & 1) == 0) {
            launch_stage<PH_MLA_IN>(p, i, G, 0, stream);
            launch_stage<PH_MLA_NORMS>(p, i, G, 0, stream);
            launch_stage<PH_MLA_QUP>(p, i, G, 0, stream);
            launch_stage<PH_MLA_KVUP>(p, i, G, 0, stream);
            launch_stage<PH_MLA_HEADNORM>(p, i, G, 0, stream);
            launch_stage<PH_MLA_ATTN>(p, i, 256, MLA_LDS, stream);
            launch_stage<PH_MLA_OUT>(p, i, G, 0, stream);
        } else {
            launch_stage<PH_SWA_QKV>(p, i, G, 0, stream);
            launch_stage<PH_SWA_PREP>(p, i, G, 0, stream);
            launch_stage<PH_SWA_ATTN>(p, i, 512, SWA_LDS, stream);
            launch_stage<PH_SWA_OUT>(p, i, G, 0, stream);
        }
        launch_stage<PH_NORM_FFN>(p, i, G, 0, stream);
        launch_stage<PH_FFN_UP>(p, i, G, 0, stream);
        launch_stage<PH_FFN_DOWN>(p, i, G, 0, stream);
        launch_stage<PH_NORM_PLE>(p, i, G, 0, stream);
        launch_stage<PH_PLE_PREP>(p, i, G, 0, stream);
        launch_stage<PH_PLE_PROJ>(p, i, G, 0, stream);
        launch_stage<PH_PLE_GATE>(p, i, G, 0, stream);
    }
    launch_stage<PH_FINAL>(p, 0, G, 0, stream);
}
```

```cpp
#include <hip/hip_runtime.h>
#include <cstdint>
#include <cstdio>

#define LAS __attribute__((address_space(3)))
typedef unsigned short bf16_t;
typedef short bf16x8 __attribute__((ext_vector_type(8)));
typedef short s16x4 __attribute__((ext_vector_type(4)));
typedef float f32x4 __attribute__((ext_vector_type(4)));
typedef float f32x16 __attribute__((ext_vector_type(16)));
typedef unsigned u32x4 __attribute__((ext_vector_type(4)));
typedef unsigned u32x2 __attribute__((ext_vector_type(2)));

constexpr int DM = 2048, SEQ = 4096, NPR = 4 * SEQ  , NSR = 256  , MR = NPR + NSR  ;
constexpr int PAST = 1024, DSEQ = 16, DBATCH = 16;
constexpr int KVPB = PAST + DSEQ;
constexpr int NKVR = NPR + DBATCH * KVPB;
constexpr int SWPB = 128 + DSEQ;
constexpr int NSKR = NPR + DBATCH * SWPB;
constexpr int DFF = 5632, PLE = 256;
constexpr int NIN_MLA = 1088, NQUP = 3072, NKVUP = 4096, NQKV = 2560;
constexpr float EPS = 1e-6f;
constexpr float LOG2E = 1.4426950408889634f;

constexpr size_t O_Y = 0;
constexpr size_t O_LATP = (size_t)MR * DM;
constexpr size_t O_KRP = O_LATP + (size_t)2 * NPR * 512;
constexpr size_t O_SKP = O_KRP + (size_t)2 * NPR * 64;
constexpr size_t O_SVP = O_SKP + (size_t)2 * 4 * 128 * 256;
constexpr size_t O_LATS = O_SVP + (size_t)2 * 4 * 128 * 256;
constexpr size_t O_KRS = O_LATS + (size_t)2 * NSR * 512;
constexpr size_t O_SKS = O_KRS + (size_t)2 * NSR * 64;
constexpr size_t O_SVS = O_SKS + (size_t)2 * 16 * 128 * 256;
constexpr size_t O_END = O_SVS + (size_t)2 * 16 * 128 * 256;
static_assert(O_END == 55869440, "output size");

constexpr size_t MiB = 1u << 20;
constexpr size_t WS_CTL = 0, WS_TABM = 1 * MiB, WS_TABS = 2 * MiB, WS_W = 3 * MiB;
constexpr size_t WE_MLA = 10092544, WE_SWA0 = 2 * WE_MLA, WE_SWA = 9437184, WE_L0 = WE_SWA0 + 2 * WE_SWA, WE_L = 39321600, WE_END = WE_L0 + 4 * WE_L;
static_assert(WE_END == 196345856, "weights");
constexpr size_t WO_IN = 0, WO_QUP = 2228224, WO_KVUP = 3801088, WO_MOUT = 5898240;
constexpr size_t WO_QKV = 0, WO_SOUT = 5242880;
constexpr size_t WO_G = 0, WO_U = 11534336, WO_D = 23068672, WO_PG = 34603008, WO_PP = 38797312;
constexpr size_t WS_HN = 378 * MiB, WS_O = 443 * MiB, WS_R = 508 * MiB;
static_assert(WS_W + WE_END * 2 <= WS_HN, "W fits");
constexpr size_t WS_Q = WS_R, WS_A32 = WS_R, WS_CQ = WS_R + 98 * MiB, WS_LAT = WS_R + 115 * MiB, WS_KR = WS_R + 148 * MiB, WS_KV = WS_R + 153 * MiB;
constexpr size_t WS_QKV32 = WS_R, WS_SQ = WS_R + 163 * MiB, WS_SK = WS_R + 228 * MiB, WS_SV = WS_R + 238 * MiB;
constexpr size_t WS_ACT = WS_R;
constexpr size_t WS_PB = WS_R, WS_T32 = WS_R + 9 * MiB;
constexpr size_t WS_END = WS_KV + (size_t)NKVR * 4096 * 2;
static_assert(WS_END <= 1000 * MiB, "ws budget");

struct Params {
    const float* in[32];
    float* out;
    unsigned char* ws;
};
__device__ __forceinline__ int opaque_i(int k) { asm volatile("" : "+v"(k)); return __builtin_amdgcn_readfirstlane(k); }
__device__ __forceinline__ const float* inp(const Params& p, int k) { return p.in[opaque_i(k)]; }
__device__ __forceinline__ unsigned char* wsp(const Params& p) { return p.ws + (size_t)(unsigned)opaque_i(0); }
__device__ __forceinline__ float* outp(const Params& p) { return p.out + (size_t)(unsigned)opaque_i(0); }

__device__ __forceinline__ float bf2f(bf16_t b) { return __uint_as_float(((unsigned)b) << 16); }
__device__ __forceinline__ unsigned f2bf(float f) { unsigned u = __float_as_uint(f); return (u + 0x7fffu + ((u >> 16) & 1u)) >> 16; }
__device__ __forceinline__ unsigned pk2(float lo, float hi) { return f2bf(lo) | (f2bf(hi) << 16); }
__device__ __forceinline__ float wave_sum(float v) {
#pragma unroll
    for (int o = 1; o < 64; o <<= 1) v += __shfl_xor(v, o);
    return v;
}
__device__ __forceinline__ int crow(int r, int hi) { return (r & 3) + 8 * (r >> 2) + 4 * hi; }
__device__ __forceinline__ int pos_of_row(int m) { return m < NPR ? (m & (SEQ - 1)) : PAST + ((m - NPR) & (DSEQ - 1)); }
__device__ __forceinline__ int latrow_of(int m) { return m < NPR ? m : NPR + ((m - NPR) >> 4) * KVPB + PAST + ((m - NPR) & 15); }
__device__ __forceinline__ int skrow_of(int m) { return m < NPR ? m : NPR + ((m - NPR) >> 4) * SWPB + 128 + ((m - NPR) & 15); }

__device__ __forceinline__ void ph_tables(const Params& p) {
    float* tm = (float*)(wsp(p) + WS_TABM); float* ts = (float*)(wsp(p) + WS_TABS);
    const int gt = blockIdx.x * blockDim.x + threadIdx.x, ngt = gridDim.x * blockDim.x;
    for (int idx = gt; idx < 4096 * 32; idx += ngt) {
        const int pos = idx >> 5, i = idx & 31;
        const float inv = powf(10000.0f, -(float)i / 32.0f);
        const float ang = (float)pos * inv;
        tm[idx * 2] = cosf(ang); tm[idx * 2 + 1] = sinf(ang);
    }
    for (int idx = gt; idx < 4096 * 8; idx += ngt) {
        const int pos = idx >> 3, i = idx & 7;
        const float inv = powf(500000.0f, -(float)i / 8.0f);
        const float ang = (float)pos * inv;
        ts[idx * 2] = cosf(ang); ts[idx * 2 + 1] = sinf(ang);
    }
}

struct WDesc { const float* src; bf16_t* dst; int K, N; };
__device__ __forceinline__ WDesc wdesc(const Params& p, int idx) {
    bf16_t* W = (bf16_t*)(wsp(p) + WS_W); WDesc d;
    if (idx < 8) { const int j = idx >> 2, k = idx & 3; bf16_t* b = W + (size_t)j * WE_MLA;
        if (k == 0) { d.src = inp(p, 9) + (size_t)j * 2048 * NIN_MLA; d.dst = b + WO_IN; d.K = 2048; d.N = NIN_MLA; }
        else if (k == 1) { d.src = inp(p, 11) + (size_t)j * 512 * NQUP; d.dst = b + WO_QUP; d.K = 512; d.N = NQUP; }
        else if (k == 2) { d.src = inp(p, 13) + (size_t)j * 512 * NKVUP; d.dst = b + WO_KVUP; d.K = 512; d.N = NKVUP; }
        else { d.src = inp(p, 18) + (size_t)j * 2048 * 2048; d.dst = b + WO_MOUT; d.K = 2048; d.N = 2048; }
    } else if (idx < 12) { const int j = (idx - 8) >> 1, k = (idx - 8) & 1; bf16_t* b = W + WE_SWA0 + (size_t)j * WE_SWA;
        if (k == 0) { d.src = inp(p, 19) + (size_t)j * 2048 * NQKV; d.dst = b + WO_QKV; d.K = 2048; d.N = NQKV; }
        else { d.src = inp(p, 23) + (size_t)j * 2048 * 2048; d.dst = b + WO_SOUT; d.K = 2048; d.N = 2048; }
    } else { const int i = (idx - 12) / 5, k = (idx - 12) % 5; bf16_t* b = W + WE_L0 + (size_t)i * WE_L;
        if (k == 0) { d.src = inp(p, 25) + (size_t)i * 2048 * DFF; d.dst = b + WO_G; d.K = 2048; d.N = DFF; }
        else if (k == 1) { d.src = inp(p, 26) + (size_t)i * 2048 * DFF; d.dst = b + WO_U; d.K = 2048; d.N = DFF; }
        else if (k == 2) { d.src = inp(p, 27) + (size_t)i * DFF * 2048; d.dst = b + WO_D; d.K = DFF; d.N = 2048; }
        else if (k == 3) { d.src = inp(p, 29) + (size_t)i * 2048 * 2048; d.dst = b + WO_PG; d.K = 2048; d.N = 2048; }
        else { d.src = inp(p, 30) + (size_t)i * PLE * 2048; d.dst = b + WO_PP; d.K = PLE; d.N = 2048; }
    }
    return d;
}
__device__ __forceinline__ void ph_convert_w(const Params& p, float* tile  ) {
    const int tid = threadIdx.x;
    for (int w = 0; w < 32; ++w) {
        const WDesc d = wdesc(p, w);
        const int tn = d.N / 64, tk = d.K / 64, nt = tn * tk;
        for (int t = blockIdx.x; t < nt; t += gridDim.x) {
            const int k0 = (t / tn) * 64, n0 = (t % tn) * 64;
            __syncthreads();
#pragma unroll
            for (int i = 0; i < 8; ++i) { const int kk = (tid >> 6) + 8 * i, n = tid & 63; tile[kk * 65 + n] = d.src[(size_t)(k0 + kk) * d.N + n0 + n]; }
            __syncthreads();
            { const int n = tid >> 3, k8 = (tid & 7) * 8; const float* s = tile + k8 * 65 + n;
              u32x4 o; o.x = pk2(s[0], s[65]); o.y = pk2(s[2 * 65], s[3 * 65]); o.z = pk2(s[4 * 65], s[5 * 65]); o.w = pk2(s[6 * 65], s[7 * 65]);
              *(u32x4*)(d.dst + (size_t)(n0 + n) * d.K + k0 + k8) = o; }
        }
    }
}

__device__ __forceinline__ void ph_init_h(const Params& p) {
    f32x4* h = (f32x4*)outp(p); const f32x4* xp = (const f32x4*)inp(p, 0); const f32x4* xs = (const f32x4*)inp(p, 1);
    const size_t np4 = (size_t)NPR * DM / 4, ns4 = (size_t)NSR * DM / 4;
    const size_t gt = (size_t)blockIdx.x * blockDim.x + threadIdx.x, ngt = (size_t)gridDim.x * blockDim.x;
    for (size_t i = gt; i < np4; i += ngt) h[i] = xp[i];
    for (size_t i = gt; i < ns4; i += ngt) h[np4 + i] = xs[i];
}

template <bool FINAL>
__device__ __forceinline__ void ph_rmsnorm_h(const Params& p, const float* g) {
    float* h = outp(p); bf16_t* hn = (bf16_t*)(wsp(p) + WS_HN);
    const int lane = threadIdx.x & 63, gw = blockIdx.x * (blockDim.x >> 6) + (threadIdx.x >> 6), ngw = gridDim.x * (blockDim.x >> 6);
    for (int m = gw; m < MR; m += ngw) {
        f32x4* hr = (f32x4*)(h + (size_t)m * DM); f32x4 v[8]; float ss = 0.f;
#pragma unroll
        for (int j = 0; j < 8; ++j) { v[j] = hr[j * 64 + lane]; ss += v[j].x * v[j].x + v[j].y * v[j].y + v[j].z * v[j].z + v[j].w * v[j].w; }
        const float rstd = rsqrtf(wave_sum(ss) * (1.0f / DM) + EPS);
#pragma unroll
        for (int j = 0; j < 8; ++j) { const f32x4 gg = ((const f32x4*)g)[j * 64 + lane]; const f32x4 y = v[j] * rstd * gg;
            if (FINAL) hr[j * 64 + lane] = y;
            else { u32x2 o; o.x = pk2(y.x, y.y); o.y = pk2(y.z, y.w); *(u32x2*)(hn + (size_t)m * DM + (j * 64 + lane) * 4) = o; } }
    }
}

template <bool DUAL, class Epi>
__device__ __forceinline__ void naive_gemm(const bf16_t* A, int lda, const bf16_t* B0, const bf16_t* B1, int M, int N, int K, const Epi& epi) {
    const int tid = threadIdx.x, wid = tid >> 6, lane = tid & 63, r32 = lane & 31, hi = lane >> 5;
    const int tilesN = N / 64, ntiles = (M / 256) * tilesN;
    for (int t = blockIdx.x; t < ntiles; t += gridDim.x) {
        const int tm = t / tilesN, tn = t % tilesN;
        const int row0 = tm * 256 + wid * 32, col0 = tn * 64;
        const bf16_t* ap = A + (size_t)(row0 + r32) * lda + hi * 8;
        const bf16_t* bp0 = B0 + (size_t)(col0 + r32) * K + hi * 8;
        const bf16_t* bp1 = DUAL ? B1 + (size_t)(col0 + r32) * K + hi * 8 : bp0;
        f32x16 a00 = {}, a01 = {}, a10 = {}, a11 = {};
#pragma unroll 4
        for (int k = 0; k < K; k += 16) {
            const bf16x8 a = *(const bf16x8*)(ap + k);
            const bf16x8 b0 = *(const bf16x8*)(bp0 + k), b1 = *(const bf16x8*)(bp0 + (size_t)32 * K + k);
            a00 = __builtin_amdgcn_mfma_f32_32x32x16_bf16(a, b0, a00, 0, 0, 0);
            a01 = __builtin_amdgcn_mfma_f32_32x32x16_bf16(a, b1, a01, 0, 0, 0);
            if (DUAL) { const bf16x8 c0 = *(const bf16x8*)(bp1 + k), c1 = *(const bf16x8*)(bp1 + (size_t)32 * K + k);
                a10 = __builtin_amdgcn_mfma_f32_32x32x16_bf16(a, c0, a10, 0, 0, 0);
                a11 = __builtin_amdgcn_mfma_f32_32x32x16_bf16(a, c1, a11, 0, 0, 0); }
        }
#pragma unroll
        for (int r = 0; r < 16; ++r) { const int row = row0 + crow(r, hi);
            epi(row, col0 + r32, a00[r], a10[r]); epi(row, col0 + 32 + r32, a01[r], a11[r]); }
    }
}
struct EpiF32 { float* C; int ldc; __device__ __forceinline__ void operator()(int r, int c, float v, float) const { C[(size_t)r * ldc + c] = v; } };
struct EpiBf16 { bf16_t* C; int ldc; __device__ __forceinline__ void operator()(int r, int c, float v, float) const { C[(size_t)r * ldc + c] = (bf16_t)f2bf(v); } };
struct EpiResid { float* h; __device__ __forceinline__ void operator()(int r, int c, float v, float) const { h[(size_t)r * DM + c] += v; } };
struct EpiSwiglu { bf16_t* act; __device__ __forceinline__ void operator()(int r, int c, float g, float u) const { act[(size_t)r * DFF + c] = (bf16_t)f2bf(g / (1.0f + __expf(-g)) * u); } };
struct EpiPle { float* h; const float* t; __device__ __forceinline__ void operator()(int r, int c, float v, float) const { const size_t o = (size_t)r * DM + c; h[o] += t[o] / (1.0f + __expf(-v)); } };

__device__ __forceinline__ void ph_mla_norms(const Params& p, int j) {
    const float* a32 = (const float*)(wsp(p) + WS_A32); bf16_t* CQ = (bf16_t*)(wsp(p) + WS_CQ); bf16_t* LAT = (bf16_t*)(wsp(p) + WS_LAT); bf16_t* KR = (bf16_t*)(wsp(p) + WS_KR);
    const float* tm = (const float*)(wsp(p) + WS_TABM);
    const float* gq = inp(p, 10) + j * 512; const float* gkv = inp(p, 12) + j * 512; const float* gkr = inp(p, 17) + j * 64;
    const int lane = threadIdx.x & 63, gw = blockIdx.x * (blockDim.x >> 6) + (threadIdx.x >> 6), ngw = gridDim.x * (blockDim.x >> 6);
    for (int m = gw; m < MR; m += ngw) {
        const float* ar = a32 + (size_t)m * NIN_MLA;
        { f32x4 v0 = ((const f32x4*)ar)[lane], v1 = ((const f32x4*)ar)[64 + lane];
          const float ss = v0.x * v0.x + v0.y * v0.y + v0.z * v0.z + v0.w * v0.w + v1.x * v1.x + v1.y * v1.y + v1.z * v1.z + v1.w * v1.w;
          const float rstd = rsqrtf(wave_sum(ss) * (1.0f / 512) + EPS);
          const f32x4 y0 = v0 * rstd * ((const f32x4*)gq)[lane], y1 = v1 * rstd * ((const f32x4*)gq)[64 + lane];
          u32x2 o0, o1; o0.x = pk2(y0.x, y0.y); o0.y = pk2(y0.z, y0.w); o1.x = pk2(y1.x, y1.y); o1.y = pk2(y1.z, y1.w);
          *(u32x2*)(CQ + (size_t)m * 512 + lane * 4) = o0; *(u32x2*)(CQ + (size_t)m * 512 + 256 + lane * 4) = o1; }
        { f32x4 v0 = ((const f32x4*)(ar + 512))[lane], v1 = ((const f32x4*)(ar + 512))[64 + lane];
          const float ss = v0.x * v0.x + v0.y * v0.y + v0.z * v0.z + v0.w * v0.w + v1.x * v1.x + v1.y * v1.y + v1.z * v1.z + v1.w * v1.w;
          const float rstd = rsqrtf(wave_sum(ss) * (1.0f / 512) + EPS);
          const f32x4 y0 = v0 * rstd * ((const f32x4*)gkv)[lane], y1 = v1 * rstd * ((const f32x4*)gkv)[64 + lane];
          float* o32 = (m < NPR) ? outp(p) + O_LATP + ((size_t)j * NPR + m) * 512 : outp(p) + O_LATS + ((size_t)j * NSR + (m - NPR)) * 512;
          ((f32x4*)o32)[lane] = y0; ((f32x4*)o32)[64 + lane] = y1;
          u32x2 o0, o1; o0.x = pk2(y0.x, y0.y); o0.y = pk2(y0.z, y0.w); o1.x = pk2(y1.x, y1.y); o1.y = pk2(y1.z, y1.w);
          bf16_t* lr = LAT + (size_t)latrow_of(m) * 512;
          *(u32x2*)(lr + lane * 4) = o0; *(u32x2*)(lr + 256 + lane * 4) = o1; }
        { const float x = ar[1024 + lane]; const float rstd = rsqrtf(wave_sum(x * x) * (1.0f / 64) + EPS);
          const float y = x * rstd * gkr[lane]; const float pr = __shfl_xor(y, 32);
          const int pos = pos_of_row(m), i = lane & 31; const float c = tm[(pos * 32 + i) * 2], s = tm[(pos * 32 + i) * 2 + 1];
          const float o = lane < 32 ? y * c - pr * s : y * c + pr * s;
          float* o32 = (m < NPR) ? outp(p) + O_KRP + ((size_t)j * NPR + m) * 64 : outp(p) + O_KRS + ((size_t)j * NSR + (m - NPR)) * 64;
          o32[lane] = o; KR[(size_t)latrow_of(m) * 64 + lane] = (bf16_t)f2bf(o); }
    }
    const float* cl = inp(p, 4) + (size_t)j * DBATCH * PAST * 512; const float* ck = inp(p, 5) + (size_t)j * DBATCH * PAST * 64;
    for (int r = gw; r < DBATCH * PAST; r += ngw) {
        const int b = r >> 10, t = r & 1023; const size_t dr = (size_t)NPR + b * KVPB + t;
        const f32x4 v0 = ((const f32x4*)(cl + (size_t)r * 512))[lane], v1 = ((const f32x4*)(cl + (size_t)r * 512))[64 + lane];
        u32x2 o0, o1; o0.x = pk2(v0.x, v0.y); o0.y = pk2(v0.z, v0.w); o1.x = pk2(v1.x, v1.y); o1.y = pk2(v1.z, v1.w);
        *(u32x2*)(LAT + dr * 512 + lane * 4) = o0; *(u32x2*)(LAT + dr * 512 + 256 + lane * 4) = o1;
        KR[dr * 64 + lane] = (bf16_t)f2bf(ck[(size_t)r * 64 + lane]);
    }
}

__device__ __forceinline__ void ph_mla_headnorm(const Params& p, int j) {
    bf16_t* Q = (bf16_t*)(wsp(p) + WS_Q); bf16_t* KV = (bf16_t*)(wsp(p) + WS_KV); const float* tm = (const float*)(wsp(p) + WS_TABM);
    const float* gqn = inp(p, 14) + j * 128; const float* gqr = inp(p, 15) + j * 64; const float* gkn = inp(p, 16) + j * 128;
    const int lane = threadIdx.x & 63, gw = blockIdx.x * (blockDim.x >> 6) + (threadIdx.x >> 6), ngw = gridDim.x * (blockDim.x >> 6);
    for (int it = gw; it < MR * 16; it += ngw) {
        const int m = it >> 4, h = it & 15; bf16_t* q = Q + (size_t)m * NQUP + h * 192;
        { const unsigned w = *(const unsigned*)(q + 2 * lane); const float x0 = __uint_as_float(w << 16), x1 = __uint_as_float(w & 0xffff0000u);
          const float rstd = rsqrtf(wave_sum(x0 * x0 + x1 * x1) * (1.0f / 128) + EPS);
          *(unsigned*)(q + 2 * lane) = pk2(x0 * rstd * gqn[2 * lane], x1 * rstd * gqn[2 * lane + 1]); }
        { const float x = bf2f(q[128 + lane]); const float rstd = rsqrtf(wave_sum(x * x) * (1.0f / 64) + EPS);
          const float y = x * rstd * gqr[lane]; const float pr = __shfl_xor(y, 32);
          const int pos = pos_of_row(m), i = lane & 31; const float c = tm[(pos * 32 + i) * 2], s = tm[(pos * 32 + i) * 2 + 1];
          q[128 + lane] = (bf16_t)f2bf(lane < 32 ? y * c - pr * s : y * c + pr * s); }
    }
    for (int it = gw; it < NKVR * 16; it += ngw) {
        const int r = it >> 4, h = it & 15; bf16_t* k = KV + (size_t)r * NKVUP + h * 256;
        const unsigned w = *(const unsigned*)(k + 2 * lane); const float x0 = __uint_as_float(w << 16), x1 = __uint_as_float(w & 0xffff0000u);
        const float rstd = rsqrtf(wave_sum(x0 * x0 + x1 * x1) * (1.0f / 128) + EPS);
        *(unsigned*)(k + 2 * lane) = pk2(x0 * rstd * gkn[2 * lane], x1 * rstd * gkn[2 * lane + 1]);
    }
}

#define SBAR() __builtin_amdgcn_sched_barrier(0)
__device__ __forceinline__ unsigned cvtpk(float lo, float hi) { unsigned r; asm volatile("v_cvt_pk_bf16_f32 %0, %1, %2" : "=v"(r) : "v"(lo), "v"(hi)); return r; }
#define PK4(P, BASE, OUT) do { unsigned a0_ = cvtpk(P[BASE + 0], P[BASE + 1]), a1_ = cvtpk(P[BASE + 2], P[BASE + 3]);   \
    unsigned b0_ = cvtpk(P[BASE + 4], P[BASE + 5]), b1_ = cvtpk(P[BASE + 6], P[BASE + 7]);                              \
    auto r0_ = __builtin_amdgcn_permlane32_swap(a0_, b0_, false, false); auto r1_ = __builtin_amdgcn_permlane32_swap(a1_, b1_, false, false); \
    u32x4 w_ = {r0_[0], r1_[0], r0_[1], r1_[1]}; OUT = *reinterpret_cast<bf16x8*>(&w_); } while (0)
__device__ __forceinline__ float half_swap_max(float v) { auto rr = __builtin_amdgcn_permlane32_swap(__float_as_uint(v), __float_as_uint(v), false, false); return fmaxf(__uint_as_float(rr[0]), __uint_as_float(rr[1])); }
__device__ __forceinline__ float half_swap_sum(float v) { auto rr = __builtin_amdgcn_permlane32_swap(__float_as_uint(v), __float_as_uint(v), false, false); return __uint_as_float(rr[0]) + __uint_as_float(rr[1]); }
template <int NC> __device__ __forceinline__ int v_st(int k, int c) { const int kk = (k & ~0xC) | ((k & 4) << 1) | ((k & 8) >> 1); return ((kk >> 3) * (NC / 32) + (c >> 5)) * 512 + ((kk & 7) * 32 + (c & 31)) * 2; }
__device__ __forceinline__ int v_rd_base(int lane) { return ((lane & 3) << 3) | (((lane >> 2) & 3) << 6) | (((lane >> 4) & 1) << 5) | (((lane >> 5) & 1) << 8); }
template <int NC> constexpr int v_rd_off(int d0, int ks, int half) { return d0 * 512 + ks * (NC / 32) * 1024 + half * (NC / 32) * 512; }
template <int OFF> __device__ __forceinline__ s16x4 tr_read(int vb) { s16x4 r; asm volatile("ds_read_b64_tr_b16 %0, %1 offset:%2" : "=&v"(r) : "v"(vb), "i"(OFF) : "memory"); return r; }
#define PKV(L, H) (bf16x8){L[0], L[1], L[2], L[3], H[0], H[1], H[2], H[3]}
template <int NC, int D0> __device__ __forceinline__ void pv_one(f32x16& od, int vb, bf16x8 pa0, bf16x8 pa1, bf16x8 pa2, bf16x8 pa3) {
    const s16x4 l0 = tr_read<v_rd_off<NC>(D0, 0, 0)>(vb), h0 = tr_read<v_rd_off<NC>(D0, 0, 1)>(vb), l1 = tr_read<v_rd_off<NC>(D0, 1, 0)>(vb), h1 = tr_read<v_rd_off<NC>(D0, 1, 1)>(vb);
    const s16x4 l2 = tr_read<v_rd_off<NC>(D0, 2, 0)>(vb), h2 = tr_read<v_rd_off<NC>(D0, 2, 1)>(vb), l3 = tr_read<v_rd_off<NC>(D0, 3, 0)>(vb), h3 = tr_read<v_rd_off<NC>(D0, 3, 1)>(vb);
    asm volatile("s_waitcnt lgkmcnt(0)" ::: "memory"); SBAR();
    od = __builtin_amdgcn_mfma_f32_32x32x16_bf16(pa0, PKV(l0, h0), od, 0, 0, 0);
    od = __builtin_amdgcn_mfma_f32_32x32x16_bf16(pa1, PKV(l1, h1), od, 0, 0, 0);
    od = __builtin_amdgcn_mfma_f32_32x32x16_bf16(pa2, PKV(l2, h2), od, 0, 0, 0);
    od = __builtin_amdgcn_mfma_f32_32x32x16_bf16(pa3, PKV(l3, h3), od, 0, 0, 0);
}
#define KSWZ256(row, colB) ((row) * 256 + ((colB) ^ (((row) & 7) << 4)))
#define KSWZ128(row, colB) ((row) * 128 + ((colB) ^ (((row) & 7) << 4)))

constexpr int MLA_V = 0, MLA_K = 32768, MLA_KR = 65536, MLA_WS = 81920, MLA_LDS = 83968;
constexpr float MLA_C = 0.07216878364870322f * LOG2E;
__device__ __forceinline__ void mla_attn_unit(const bf16_t* Qh, int nq, const bf16_t* KVh, const bf16_t* KRb, int nkeys, int NT, int my_nt, bf16_t* Oh, char* lds) {
    int tid = threadIdx.x; asm volatile("" : "+v"(tid));
    const int wid = __builtin_amdgcn_readfirstlane(tid >> 6), lane = tid & 63, r32 = lane & 31, hi = lane >> 5;
    LAS char* L = (LAS char*)lds;
    LAS float* wsf = (LAS float*)(L + MLA_WS) + wid * 64;
    bf16x8 qr[12];
    { int qrow = wid * 32 + r32; if (qrow > nq - 1) qrow = nq - 1; const bf16_t* qp = Qh + (size_t)qrow * NQUP + hi * 8;
#pragma unroll
      for (int d0 = 0; d0 < 12; ++d0) qr[d0] = *(const bf16x8*)(qp + d0 * 16); }
    int kq[4];
#pragma unroll
    for (int q = 0; q < 4; ++q) kq[q] = ((q * 32 + hi * 16) ^ ((r32 & 7) << 4));
    const int krow256 = r32 * 256, krow128 = r32 * 128;
    const int sr = tid >> 4, sc = (tid & 15) * 8, vst0 = v_st<128>(sr, sc), vst1 = v_st<128>(32 + sr, sc);
    const int kst0 = KSWZ256(sr, sc * 2), kst1 = KSWZ256(32 + sr, sc * 2);
    const int krr = tid >> 3, krc = (tid & 7) * 8, krst = KSWZ128(krr, krc * 2);
    const int vb0 = (int)(uintptr_t)(lds + MLA_V) + v_rd_base(lane);
#define MLA_STAGE(t, b) do { int ra = (t) * 64 + sr, rb = ra + 32, rc = (t) * 64 + krr; if (ra > nkeys - 1) ra = nkeys - 1; if (rb > nkeys - 1) rb = nkeys - 1; if (rc > nkeys - 1) rc = nkeys - 1; \
        const bf16x8 sk0 = *(const bf16x8*)(KVh + (size_t)ra * NKVUP + sc), sk1 = *(const bf16x8*)(KVh + (size_t)rb * NKVUP + sc); \
        const bf16x8 sv0 = *(const bf16x8*)(KVh + (size_t)ra * NKVUP + 128 + sc), sv1 = *(const bf16x8*)(KVh + (size_t)rb * NKVUP + 128 + sc); \
        const bf16x8 skr = *(const bf16x8*)(KRb + (size_t)rc * 64 + krc); \
        *(LAS bf16x8*)(L + MLA_V + (b) * 16384 + vst0) = sv0; *(LAS bf16x8*)(L + MLA_V + (b) * 16384 + vst1) = sv1; \
        *(LAS bf16x8*)(L + MLA_K + (b) * 16384 + kst0) = sk0; *(LAS bf16x8*)(L + MLA_K + (b) * 16384 + kst1) = sk1; \
        *(LAS bf16x8*)(L + MLA_KR + (b) * 8192 + krst) = skr; } while (0)
    float m_reg = -1e30f, l_reg = 0.f; f32x16 o[4] = {};
    MLA_STAGE(0, 0); __syncthreads();
    for (int j = 0; j < NT; ++j) {
        const int b = j & 1;
        if (j < my_nt) {
            f32x16 p0 = {}, p1 = {};
            const LAS char* Kb = L + MLA_K + b * 16384 + krow256; const LAS char* KRp = L + MLA_KR + b * 8192 + krow128;
#pragma unroll
            for (int d0 = 0; d0 < 8; ++d0) {
                const bf16x8 k0 = *(const LAS bf16x8*)(Kb + kq[d0 & 3] + (d0 >> 2) * 128), k1 = *(const LAS bf16x8*)(Kb + kq[d0 & 3] + (d0 >> 2) * 128 + 8192);
                p0 = __builtin_amdgcn_mfma_f32_32x32x16_bf16(k0, qr[d0], p0, 0, 0, 0);
                p1 = __builtin_amdgcn_mfma_f32_32x32x16_bf16(k1, qr[d0], p1, 0, 0, 0); if (d0 & 1) SBAR(); }
#pragma unroll
            for (int d0 = 0; d0 < 4; ++d0) {
                const bf16x8 k0 = *(const LAS bf16x8*)(KRp + kq[d0]), k1 = *(const LAS bf16x8*)(KRp + kq[d0] + 4096);
                p0 = __builtin_amdgcn_mfma_f32_32x32x16_bf16(k0, qr[8 + d0], p0, 0, 0, 0);
                p1 = __builtin_amdgcn_mfma_f32_32x32x16_bf16(k1, qr[8 + d0], p1, 0, 0, 0); if (d0 & 1) SBAR(); }
            if (j * 64 + 64 > nkeys) {
#pragma unroll
                for (int r = 0; r < 16; ++r) { const int kk = j * 64 + crow(r, hi); if (kk >= nkeys) p0[r] = -1e30f; if (kk + 32 >= nkeys) p1[r] = -1e30f; }
            }
            float pmax = p0[0];
#pragma unroll
            for (int r = 1; r < 16; ++r) pmax = fmaxf(pmax, p0[r]);
#pragma unroll
            for (int r = 0; r < 16; ++r) pmax = fmaxf(pmax, p1[r]);
            pmax = half_swap_max(pmax);
            const float mn = fmaxf(m_reg, pmax); const float alpha = __builtin_amdgcn_exp2f((m_reg - mn) * MLA_C); m_reg = mn;
            const float mnC = -mn * MLA_C; float ps = 0.f;
#pragma unroll
            for (int r = 0; r < 16; ++r) { p0[r] = __builtin_amdgcn_exp2f(fmaf(p0[r], MLA_C, mnC)); p1[r] = __builtin_amdgcn_exp2f(fmaf(p1[r], MLA_C, mnC)); ps += p0[r] + p1[r]; }
            ps = half_swap_sum(ps);
            l_reg = l_reg * alpha + ps;
            bf16x8 pa0, pa1, pa2, pa3;
            PK4(p0, 0, pa0); PK4(p0, 8, pa1); PK4(p1, 0, pa2); PK4(p1, 8, pa3);
            if (hi == 0) wsf[r32] = alpha; asm volatile("s_waitcnt lgkmcnt(0)" ::: "memory");
#pragma unroll
            for (int r = 0; r < 16; ++r) { const float a = wsf[crow(r, hi)];
#pragma unroll
                for (int d = 0; d < 4; ++d) o[d][r] *= a; }
            asm volatile("s_waitcnt lgkmcnt(0)" ::: "memory");
            const int vb = vb0 + b * 16384;
            pv_one<128, 0>(o[0], vb, pa0, pa1, pa2, pa3); pv_one<128, 1>(o[1], vb, pa0, pa1, pa2, pa3);
            pv_one<128, 2>(o[2], vb, pa0, pa1, pa2, pa3); pv_one<128, 3>(o[3], vb, pa0, pa1, pa2, pa3);
        }
        if (j + 1 < NT) MLA_STAGE(j + 1, b ^ 1);
        __syncthreads();
    }
    if (hi == 0) wsf[32 + r32] = l_reg; asm volatile("s_waitcnt lgkmcnt(0)" ::: "memory");
#pragma unroll
    for (int r = 0; r < 16; ++r) { const int orow = wid * 32 + crow(r, hi); const float rl = 1.0f / wsf[32 + crow(r, hi)];
        if (orow < nq) {
#pragma unroll
            for (int d = 0; d < 4; ++d) Oh[orow * DM + d * 32 + r32] = (bf16_t)f2bf(o[d][r] * rl); } }
    __syncthreads();
#undef MLA_STAGE
}
__device__ __forceinline__ void ph_mla_attn(const Params& p, char* lds) {
    const bf16_t* Q = (const bf16_t*)(wsp(p) + WS_Q); const bf16_t* KV = (const bf16_t*)(wsp(p) + WS_KV); const bf16_t* KR = (const bf16_t*)(wsp(p) + WS_KR); bf16_t* O = (bf16_t*)(wsp(p) + WS_O);
    const int wid = threadIdx.x >> 6, G = gridDim.x;
    const int npr = (512 + G - 1) / G, nsr = (DBATCH * 16 + G - 1) / G;
    for (int sl = 0; sl < 2 * npr + nsr; ++sl) {
        size_t row0, kr0; int h, nq, nkeys, NT, my_nt;
        if (sl < 2 * npr) {
            const int pi = blockIdx.x + (sl >> 1) * G; if (pi >= 512) continue;
            const int bh = pi >> 3, s = pi & 7, b = bh >> 4, qb = (sl & 1) ? 15 - s : s; h = bh & 15;
            row0 = (size_t)b * SEQ + qb * 256; kr0 = (size_t)b * SEQ; nq = 256; nkeys = SEQ; NT = 4 * qb + 4; my_nt = 4 * qb + (wid >> 1) + 1;
        } else {
            const int u = blockIdx.x + (sl - 2 * npr) * G; if (u >= DBATCH * 16) continue;
            const int b = u >> 4; h = u & 15;
            row0 = (size_t)NPR + b * 16; kr0 = (size_t)NPR + b * KVPB; nq = 16; nkeys = KVPB; NT = 17; my_nt = wid == 0 ? 17 : 0;
        }
        mla_attn_unit(Q + row0 * NQUP + h * 192, nq, KV + kr0 * NKVUP + h * 256, KR + kr0 * 64, nkeys, NT, my_nt, O + row0 * DM + h * 128, lds);
    }
}

__device__ __forceinline__ void ph_swa_prep(const Params& p, int j) {
    const float* qkv = (const float*)(wsp(p) + WS_QKV32); bf16_t* SQ = (bf16_t*)(wsp(p) + WS_SQ); bf16_t* SK = (bf16_t*)(wsp(p) + WS_SK); bf16_t* SV = (bf16_t*)(wsp(p) + WS_SV);
    const float* ts = (const float*)(wsp(p) + WS_TABS); const float* gq = inp(p, 20) + j * 64; const float* gk = inp(p, 21) + j * 64;
    const int lane = threadIdx.x & 63, gw = blockIdx.x * (blockDim.x >> 6) + (threadIdx.x >> 6), ngw = gridDim.x * (blockDim.x >> 6);
    for (int it = gw; it < MR * 40; it += ngw) {
        const int m = it / 40, s = it % 40; const float x = qkv[(size_t)m * NQKV + s * 64 + lane];
        float y = x;
        if (s < 36) {
            const float rstd = rsqrtf(wave_sum(x * x) * (1.0f / 64) + EPS); y = x * rstd * (s < 32 ? gq[lane] : gk[lane]);
            const float pr = __shfl_xor(y, 8); const int pos = pos_of_row(m), i = lane & 7;
            const float c = ts[(pos * 8 + i) * 2], sn = ts[(pos * 8 + i) * 2 + 1];
            if (lane < 8) y = y * c - pr * sn; else if (lane < 16) y = y * c + pr * sn;
        }
        if (s < 32) SQ[(size_t)m * DM + s * 64 + lane] = (bf16_t)f2bf(y);
        else {
            const int g = (s - 32) & 3; const bool isk = s < 36; bf16_t* dst = isk ? SK : SV;
            dst[(size_t)skrow_of(m) * 256 + g * 64 + lane] = (bf16_t)f2bf(y);
            if (m < NPR) { const int b = m >> 12, t = m & 4095;
                if (t >= SEQ - 128) outp(p)[(isk ? O_SKP : O_SVP) + (((size_t)j * 4 + b) * 128 + (t - (SEQ - 128))) * 256 + g * 64 + lane] = y; }
            else { const int b = (m - NPR) >> 4, t = (m - NPR) & 15;
                outp(p)[(isk ? O_SKS : O_SVS) + (((size_t)j * 16 + b) * 128 + 112 + t) * 256 + g * 64 + lane] = y; }
        }
    }
    const float* sk = inp(p, 6) + (size_t)j * DBATCH * 128 * 256; const float* sv = inp(p, 7) + (size_t)j * DBATCH * 128 * 256;
    for (int r = gw; r < DBATCH * 128; r += ngw) {
        const int b = r >> 7, i = r & 127; const size_t dr = (size_t)NPR + b * SWPB + i;
        const f32x4 kx = ((const f32x4*)(sk + (size_t)r * 256))[lane], vx = ((const f32x4*)(sv + (size_t)r * 256))[lane];
        u32x2 ko, vo; ko.x = pk2(kx.x, kx.y); ko.y = pk2(kx.z, kx.w); vo.x = pk2(vx.x, vx.y); vo.y = pk2(vx.z, vx.w);
        *(u32x2*)(SK + dr * 256 + lane * 4) = ko; *(u32x2*)(SV + dr * 256 + lane * 4) = vo;
        if (i >= 16) { ((f32x4*)(outp(p) + O_SKS + (((size_t)j * 16 + b) * 128 + (i - 16)) * 256))[lane] = kx;
                       ((f32x4*)(outp(p) + O_SVS + (((size_t)j * 16 + b) * 128 + (i - 16)) * 256))[lane] = vx; }
    }
}

constexpr int SWA_K = 0, SWA_V = 24576, SWA_WS = 49152, SWA_LDS = 51200;
__device__ __forceinline__ void swa_attn_unit(const bf16_t* Qb, int nq, const bf16_t* Kb, const bf16_t* Vb, int nkeys, const float* sinks8, bf16_t* Ob, char* lds) {
    int tid = threadIdx.x; asm volatile("" : "+v"(tid));
    const int wid = __builtin_amdgcn_readfirstlane(tid >> 6), lane = tid & 63, r32 = lane & 31, hi = lane >> 5;
    LAS char* L = (LAS char*)lds; LAS float* wsf = (LAS float*)(L + SWA_WS) + wid * 64;
#pragma unroll
    for (int i = 0; i < 3; ++i) { const int idx = tid + i * 512, row = idx >> 3, ch = idx & 7; const bool valid = row < nkeys; const int rr = valid ? row : 0;
        bf16x8 kx = *(const bf16x8*)(Kb + (size_t)rr * 256 + ch * 8), vx = *(const bf16x8*)(Vb + (size_t)rr * 256 + ch * 8);
        if (!valid) { kx = (bf16x8){0, 0, 0, 0, 0, 0, 0, 0}; vx = kx; }
        *(LAS bf16x8*)(L + SWA_K + KSWZ128(row, ch * 16)) = kx;
        *(LAS bf16x8*)(L + SWA_V + (row >> 6) * 8192 + v_st<64>(row & 63, ch * 8)) = vx; }
    __syncthreads();
    const float sink2 = sinks8[wid] * LOG2E; const int vb0 = (int)(uintptr_t)(lds + SWA_V) + v_rd_base(lane);
    constexpr float SC = 0.125f * LOG2E;
    int kq[4];
#pragma unroll
    for (int q = 0; q < 4; ++q) kq[q] = r32 * 128 + ((q * 32 + hi * 16) ^ ((r32 & 7) << 4));
    const int ntile = (nkeys + 63) >> 6;
    for (int q2 = 0; q2 * 32 < nq; ++q2) {
        bf16x8 qr[4];
        { int qrow = q2 * 32 + r32; if (qrow > nq - 1) qrow = nq - 1; const bf16_t* qp = Qb + (size_t)qrow * DM + wid * 64 + hi * 8;
#pragma unroll
          for (int d0 = 0; d0 < 4; ++d0) qr[d0] = *(const bf16x8*)(qp + d0 * 16); }
        float m_reg = sink2, l_reg = 1.0f; f32x16 o0 = {}, o1 = {};
        for (int t = 0; t < ntile; ++t) {
            f32x16 p0 = {}, p1 = {};
            const LAS char* Kt = L + SWA_K + t * 8192;
#pragma unroll
            for (int d0 = 0; d0 < 4; ++d0) { const bf16x8 k0 = *(const LAS bf16x8*)(Kt + kq[d0]), k1 = *(const LAS bf16x8*)(Kt + kq[d0] + 4096);
                p0 = __builtin_amdgcn_mfma_f32_32x32x16_bf16(k0, qr[d0], p0, 0, 0, 0);
                p1 = __builtin_amdgcn_mfma_f32_32x32x16_bf16(k1, qr[d0], p1, 0, 0, 0); }
            if (t * 64 + 64 > nkeys) {
#pragma unroll
                for (int r = 0; r < 16; ++r) { const int kk = t * 64 + crow(r, hi); if (kk >= nkeys) p0[r] = -1e30f; if (kk + 32 >= nkeys) p1[r] = -1e30f; }
            }
            float pmax = p0[0];
#pragma unroll
            for (int r = 1; r < 16; ++r) pmax = fmaxf(pmax, p0[r]);
#pragma unroll
            for (int r = 0; r < 16; ++r) pmax = fmaxf(pmax, p1[r]);
            pmax = half_swap_max(pmax) * SC;
            const float mn = fmaxf(m_reg, pmax); const float alpha = __builtin_amdgcn_exp2f(m_reg - mn); m_reg = mn;
            float ps = 0.f;
#pragma unroll
            for (int r = 0; r < 16; ++r) { p0[r] = __builtin_amdgcn_exp2f(fmaf(p0[r], SC, -mn)); p1[r] = __builtin_amdgcn_exp2f(fmaf(p1[r], SC, -mn)); ps += p0[r] + p1[r]; }
            ps = half_swap_sum(ps);
            l_reg = l_reg * alpha + ps;
            bf16x8 pa0, pa1, pa2, pa3;
            PK4(p0, 0, pa0); PK4(p0, 8, pa1); PK4(p1, 0, pa2); PK4(p1, 8, pa3);
            if (hi == 0) wsf[r32] = alpha; asm volatile("s_waitcnt lgkmcnt(0)" ::: "memory");
#pragma unroll
            for (int r = 0; r < 16; ++r) { const float a = wsf[crow(r, hi)]; o0[r] *= a; o1[r] *= a; }
            asm volatile("s_waitcnt lgkmcnt(0)" ::: "memory");
            const int vb = vb0 + t * 8192;
            pv_one<64, 0>(o0, vb, pa0, pa1, pa2, pa3); pv_one<64, 1>(o1, vb, pa0, pa1, pa2, pa3);
        }
        if (hi == 0) wsf[32 + r32] = l_reg; asm volatile("s_waitcnt lgkmcnt(0)" ::: "memory");
#pragma unroll
        for (int r = 0; r < 16; ++r) { const int orow = q2 * 32 + crow(r, hi); const float rl = 1.0f / wsf[32 + crow(r, hi)];
            if (orow < nq) { Ob[orow * DM + wid * 64 + r32] = (bf16_t)f2bf(o0[r] * rl); Ob[orow * DM + wid * 64 + 32 + r32] = (bf16_t)f2bf(o1[r] * rl); } }
        asm volatile("s_waitcnt lgkmcnt(0)" ::: "memory");
    }
    __syncthreads();
}
__device__ __forceinline__ void ph_swa_attn(const Params& p, int j, char* lds) {
    const bf16_t* SQ = (const bf16_t*)(wsp(p) + WS_SQ); const bf16_t* SK = (const bf16_t*)(wsp(p) + WS_SK); const bf16_t* SV = (const bf16_t*)(wsp(p) + WS_SV); bf16_t* O = (bf16_t*)(wsp(p) + WS_O);
    const float* sinks = inp(p, 22) + j * 32;
    for (int u = blockIdx.x; u < 1024 + DBATCH * 4; u += gridDim.x) {
        size_t qrow0, krow0; int g, nq, nk;
        if (u < 1024) { const int c = u & 63, b = u >> 8; g = (u >> 6) & 3; const int c0 = c >= 2 ? c - 2 : 0; nk = (c - c0 + 1) * 64; nq = 64;
            qrow0 = (size_t)b * SEQ + c * 64; krow0 = (size_t)b * SEQ + c0 * 64; }
        else { const int v = u - 1024, b = v >> 2; g = v & 3; nq = 16; nk = SWPB; qrow0 = (size_t)NPR + b * 16; krow0 = (size_t)NPR + b * SWPB; }
        swa_attn_unit(SQ + qrow0 * DM + g * 512, nq, SK + krow0 * 256 + g * 64, SV + krow0 * 256 + g * 64, nk, sinks + g * 8, O + qrow0 * DM + g * 512, lds);
    }
}

__device__ __forceinline__ void ph_ple_prep(const Params& p, int i) {
    bf16_t* PB = (bf16_t*)(wsp(p) + WS_PB);
    const f32x4* pp = (const f32x4*)(inp(p, 2) + (size_t)i * NPR * PLE); const f32x4* ps = (const f32x4*)(inp(p, 3) + (size_t)i * NSR * PLE);
    const size_t np4 = (size_t)NPR * PLE / 4, ns4 = (size_t)NSR * PLE / 4;
    const size_t gt = (size_t)blockIdx.x * blockDim.x + threadIdx.x, ngt = (size_t)gridDim.x * blockDim.x;
    for (size_t k = gt; k < np4 + ns4; k += ngt) { const f32x4 v = k < np4 ? pp[k] : ps[k - np4]; u32x2 o; o.x = pk2(v.x, v.y); o.y = pk2(v.z, v.w); *(u32x2*)(PB + k * 4) = o; }
}

#define XB_TMO      128
#define XB_XCNT(j)  (256  + 64 * (j))
#define XB_XSUB(j)  (1280 + 64 * (j))
#define XB_XGEN(j)  (2304 + 64 * (j))
#define XB_TOP      3328
#define XB_TOPGEN   3392
#define XCD_BAR_WORDS 3456
#define XB_SPIN_CAP (1u << 18)

__device__ __forceinline__ unsigned xb_ld(unsigned* p)              { return __hip_atomic_load(p, __ATOMIC_RELAXED, __HIP_MEMORY_SCOPE_AGENT); }
__device__ __forceinline__ unsigned xb_add(unsigned* p, unsigned v) { return __hip_atomic_fetch_add(p, v, __ATOMIC_RELAXED, __HIP_MEMORY_SCOPE_AGENT); }
__device__ __forceinline__ unsigned xb_xcc_id() { return (unsigned)__builtin_amdgcn_s_getreg((3 << 11) | 20) & 0xFu; }
#define XB_SPIN(cond, bar) do { unsigned _sp = 0; while (cond) { __builtin_amdgcn_s_sleep(1); \
    if ((++_sp & 255u) == 0u) { if (xb_ld(&(bar)[XB_TMO])) break; if (_sp > XB_SPIN_CAP) { atomicAdd(&(bar)[XB_TMO], 1u); break; } } } } while (0)

struct XcdBarrier {
    unsigned* bar; unsigned x;
    volatile LAS unsigned* st;
};

__device__ __forceinline__ XcdBarrier xcd_barrier_post(unsigned* bar, volatile LAS unsigned* st) {
    XcdBarrier b; b.bar = bar; b.x = xb_xcc_id(); b.st = st;
    if (threadIdx.x == 0) (void)xb_add(&bar[XB_XCNT(b.x)], 1u);
    return b;
}
__device__ __forceinline__ void xcd_barrier_complete(unsigned* bar, unsigned x, unsigned& nloc, unsigned& nx) {
    const unsigned G = gridDim.x * gridDim.y * gridDim.z;
    unsigned sum, cnt, mine, sp = 0u;
    for (;;) {
        sum = 0u; cnt = 0u; mine = 0u;
#pragma unroll
        for (unsigned j = 0; j < 16; ++j) { const unsigned c = xb_ld(&bar[XB_XCNT(j)]); sum += c; cnt += (c > 0u) ? 1u : 0u; mine = (j == x) ? c : mine; }
        if (sum == G) break;
        __builtin_amdgcn_s_sleep(1);
        if ((++sp & 255u) == 0u) { if (xb_ld(&bar[XB_TMO])) break; if (sp > XB_SPIN_CAP) { atomicAdd(&bar[XB_TMO], 1u); break; } }
    }
    nloc = mine > 0u ? mine : 1u; nx = cnt > 0u ? cnt : 1u;
}

__device__ __forceinline__ void xcd_barrier(const XcdBarrier& b) {
    asm volatile("s_waitcnt vmcnt(0)" ::: "memory");
    __syncthreads();
    if (threadIdx.x == 0) {
        unsigned* bar = b.bar;
        __builtin_amdgcn_s_waitcnt(0);
        unsigned nloc = b.st[0], nx = b.st[1];
        if (nloc == 0u) { xcd_barrier_complete(bar, b.x, nloc, nx); b.st[0] = nloc; b.st[1] = nx; }
        const unsigned old = xb_add(&bar[XB_XSUB(b.x)], 1u);
        const unsigned gen = old / nloc;
        if (old + 1u == (gen + 1u) * nloc) {
            __builtin_amdgcn_fence(__ATOMIC_RELEASE, "agent");
            asm volatile("s_waitcnt vmcnt(0)" ::: "memory");
            const unsigned og = xb_add(&bar[XB_TOP], 1u);
            const unsigned tg = og / nx;
            if (og + 1u == (tg + 1u) * nx) xb_add(&bar[XB_TOPGEN], 1u);
            else XB_SPIN(xb_ld(&bar[XB_TOPGEN]) == tg, bar);
            __builtin_amdgcn_fence(__ATOMIC_ACQUIRE, "agent");
            xb_add(&bar[XB_XGEN(b.x)], 1u);
            asm volatile("s_waitcnt vmcnt(0)" ::: "memory");
        } else {
            XB_SPIN(xb_ld(&bar[XB_XGEN(b.x)]) == gen, bar);
            __builtin_amdgcn_fence(__ATOMIC_ACQUIRE, "agent");
            asm volatile("s_waitcnt vmcnt(0)" ::: "memory");
        }
    }
    __syncthreads();
}

enum { PH_TABLES, PH_CONVW, PH_INITH, PH_NORM_ATTN, PH_MLA_IN, PH_MLA_NORMS, PH_MLA_QUP, PH_MLA_KVUP, PH_MLA_HEADNORM, PH_MLA_ATTN, PH_MLA_OUT,
       PH_SWA_QKV, PH_SWA_PREP, PH_SWA_ATTN, PH_SWA_OUT, PH_NORM_FFN, PH_FFN_UP, PH_FFN_DOWN, PH_NORM_PLE, PH_PLE_PREP, PH_PLE_PROJ, PH_PLE_GATE, PH_FINAL };

template <int PH> __global__ void __launch_bounds__(512) k_stage(Params p, int i) {
    extern __shared__ __attribute__((aligned(16))) char lds[];
    const int j = i >> 1;
    bf16_t* W = (bf16_t*)(wsp(p) + WS_W); bf16_t* HN = (bf16_t*)(wsp(p) + WS_HN); bf16_t* O = (bf16_t*)(wsp(p) + WS_O);
    const bf16_t* Wm = W + (size_t)j * WE_MLA; const bf16_t* Wsw = W + WE_SWA0 + (size_t)j * WE_SWA; const bf16_t* Wl = W + WE_L0 + (size_t)i * WE_L;
    if constexpr (PH == PH_TABLES) ph_tables(p);
    if constexpr (PH == PH_CONVW) ph_convert_w(p, (float*)lds);
    if constexpr (PH == PH_INITH) ph_init_h(p);
    if constexpr (PH == PH_NORM_ATTN) ph_rmsnorm_h<false>(p, inp(p, 8) + i * DM);
    if constexpr (PH == PH_NORM_FFN) ph_rmsnorm_h<false>(p, inp(p, 24) + i * DM);
    if constexpr (PH == PH_NORM_PLE) ph_rmsnorm_h<false>(p, inp(p, 28) + i * DM);
    if constexpr (PH == PH_FINAL) ph_rmsnorm_h<true>(p, inp(p, 31));
    if constexpr (PH == PH_MLA_IN) naive_gemm<false>(HN, DM, Wm + WO_IN, nullptr, MR, NIN_MLA, DM, EpiF32{(float*)(wsp(p) + WS_A32), NIN_MLA});
    if constexpr (PH == PH_MLA_NORMS) ph_mla_norms(p, j);
    if constexpr (PH == PH_MLA_QUP) naive_gemm<false>((const bf16_t*)(wsp(p) + WS_CQ), 512, Wm + WO_QUP, nullptr, MR, NQUP, 512, EpiBf16{(bf16_t*)(wsp(p) + WS_Q), NQUP});
    if constexpr (PH == PH_MLA_KVUP) naive_gemm<false>((const bf16_t*)(wsp(p) + WS_LAT), 512, Wm + WO_KVUP, nullptr, NKVR, NKVUP, 512, EpiBf16{(bf16_t*)(wsp(p) + WS_KV), NKVUP});
    if constexpr (PH == PH_MLA_HEADNORM) ph_mla_headnorm(p, j);
    if constexpr (PH == PH_MLA_ATTN) ph_mla_attn(p, lds);
    if constexpr (PH == PH_MLA_OUT) naive_gemm<false>(O, DM, Wm + WO_MOUT, nullptr, MR, DM, DM, EpiResid{outp(p)});
    if constexpr (PH == PH_SWA_QKV) naive_gemm<false>(HN, DM, Wsw + WO_QKV, nullptr, MR, NQKV, DM, EpiF32{(float*)(wsp(p) + WS_QKV32), NQKV});
    if constexpr (PH == PH_SWA_PREP) ph_swa_prep(p, j);
    if constexpr (PH == PH_SWA_ATTN) ph_swa_attn(p, j, lds);
    if constexpr (PH == PH_SWA_OUT) naive_gemm<false>(O, DM, Wsw + WO_SOUT, nullptr, MR, DM, DM, EpiResid{outp(p)});
    if constexpr (PH == PH_FFN_UP) naive_gemm<true>(HN, DM, Wl + WO_G, Wl + WO_U, MR, DFF, DM, EpiSwiglu{(bf16_t*)(wsp(p) + WS_ACT)});
    if constexpr (PH == PH_FFN_DOWN) naive_gemm<false>((const bf16_t*)(wsp(p) + WS_ACT), DFF, Wl + WO_D, nullptr, MR, DM, DFF, EpiResid{outp(p)});
    if constexpr (PH == PH_PLE_PREP) ph_ple_prep(p, i);
    if constexpr (PH == PH_PLE_PROJ) naive_gemm<false>((const bf16_t*)(wsp(p) + WS_PB), PLE, Wl + WO_PP, nullptr, MR, DM, PLE, EpiF32{(float*)(wsp(p) + WS_T32), DM});
    if constexpr (PH == PH_PLE_GATE) naive_gemm<false>(HN, DM, Wl + WO_PG, nullptr, MR, DM, DM, EpiPle{outp(p), (const float*)(wsp(p) + WS_T32)});
}

constexpr int LDS_BYTES = 147456;
constexpr int LDS_MISC = 131072 + 320;
constexpr int CW_BAR = 4096;
__global__ void __launch_bounds__(512, 2) mega_fwd(Params p) {
    extern __shared__ __attribute__((aligned(16))) char lds[];
    volatile LAS unsigned* MISC = (volatile LAS unsigned*)((LAS char*)lds + LDS_MISC);
    for (int u = threadIdx.x; u < (LDS_BYTES - 131072) / 4; u += 512) ((LAS unsigned*)((LAS char*)lds + 131072))[u] = 0u;
    __syncthreads();
    XcdBarrier bar = xcd_barrier_post((unsigned*)(wsp(p) + WS_CTL) + CW_BAR, MISC + 8);
#define GRID_BAR() xcd_barrier(bar)
    bf16_t* W = (bf16_t*)(wsp(p) + WS_W); bf16_t* HN = (bf16_t*)(wsp(p) + WS_HN); bf16_t* O = (bf16_t*)(wsp(p) + WS_O);
    ph_tables(p); ph_convert_w(p, (float*)lds); ph_init_h(p);
    GRID_BAR();
    for (int i = 0; i < 4; ++i) {
        const int j = i >> 1;
        const bf16_t* Wm = W + (size_t)j * WE_MLA; const bf16_t* Wsw = W + WE_SWA0 + (size_t)j * WE_SWA; const bf16_t* Wl = W + WE_L0 + (size_t)i * WE_L;
        ph_rmsnorm_h<false>(p, inp(p, 8) + i * DM);
        GRID_BAR();
        if ((i & 1) == 0) {
            naive_gemm<false>(HN, DM, Wm + WO_IN, nullptr, MR, NIN_MLA, DM, EpiF32{(float*)(wsp(p) + WS_A32), NIN_MLA});
            GRID_BAR();
            ph_mla_norms(p, j);
            GRID_BAR();
            naive_gemm<false>((const bf16_t*)(wsp(p) + WS_CQ), 512, Wm + WO_QUP, nullptr, MR, NQUP, 512, EpiBf16{(bf16_t*)(wsp(p) + WS_Q), NQUP});
            naive_gemm<false>((const bf16_t*)(wsp(p) + WS_LAT), 512, Wm + WO_KVUP, nullptr, NKVR, NKVUP, 512, EpiBf16{(bf16_t*)(wsp(p) + WS_KV), NKVUP});
            GRID_BAR();
            ph_mla_headnorm(p, j);
            GRID_BAR();
            ph_mla_attn(p, lds);
            GRID_BAR();
            naive_gemm<false>(O, DM, Wm + WO_MOUT, nullptr, MR, DM, DM, EpiResid{outp(p)});
            GRID_BAR();
        } else {
            naive_gemm<false>(HN, DM, Wsw + WO_QKV, nullptr, MR, NQKV, DM, EpiF32{(float*)(wsp(p) + WS_QKV32), NQKV});
            GRID_BAR();
            ph_swa_prep(p, j);
            GRID_BAR();
            ph_swa_attn(p, j, lds);
            GRID_BAR();
            naive_gemm<false>(O, DM, Wsw + WO_SOUT, nullptr, MR, DM, DM, EpiResid{outp(p)});
            GRID_BAR();
        }
        ph_rmsnorm_h<false>(p, inp(p, 24) + i * DM);
        GRID_BAR();
        naive_gemm<true>(HN, DM, Wl + WO_G, Wl + WO_U, MR, DFF, DM, EpiSwiglu{(bf16_t*)(wsp(p) + WS_ACT)});
        GRID_BAR();
        naive_gemm<false>((const bf16_t*)(wsp(p) + WS_ACT), DFF, Wl + WO_D, nullptr, MR, DM, DFF, EpiResid{outp(p)});
        GRID_BAR();
        ph_rmsnorm_h<false>(p, inp(p, 28) + i * DM); ph_ple_prep(p, i);
        GRID_BAR();
        naive_gemm<false>((const bf16_t*)(wsp(p) + WS_PB), PLE, Wl + WO_PP, nullptr, MR, DM, PLE, EpiF32{(float*)(wsp(p) + WS_T32), DM});
        GRID_BAR();
        naive_gemm<false>(HN, DM, Wl + WO_PG, nullptr, MR, DM, DM, EpiPle{outp(p), (const float*)(wsp(p) + WS_T32)});
        GRID_BAR();
    }
    ph_rmsnorm_h<true>(p, inp(p, 31));
#undef GRID_BAR
}

__global__ void k_report(float* out, float v) { if (threadIdx.x == 0 && blockIdx.x == 0) out[0] = v; }

template <int PH> static void launch_stage(const Params& p, int i, int grid, size_t lds_bytes, hipStream_t s) {
    static bool attr = false;
    if (!attr) { (void)hipFuncSetAttribute((const void*)k_stage<PH>, hipFuncAttributeMaxDynamicSharedMemorySize, (int)lds_bytes); attr = true; }
    hipLaunchKernelGGL((k_stage<PH>), dim3(grid), dim3(512), lds_bytes, s, p, i);
}

extern "C" void kernel_launch(void* const* d_in, const int* in_sizes, int n_in, void* d_out, int out_size, void* d_ws, size_t ws_size, hipStream_t stream) {
    if (n_in != 32 || (size_t)out_size != O_END || ws_size < WS_END) {
        fprintf(stderr, "kernel_launch: unexpected sizes n_in %d out %d ws %zu (need %zu)\n", n_in, out_size, ws_size, (size_t)WS_END);
        hipLaunchKernelGGL(k_report, dim3(1), dim3(64), 0, stream, (float*)d_out, (float)(ws_size >> 20));
        return;
    }
    Params p{};
    for (int k = 0; k < 32; ++k) p.in[k] = (const float*)d_in[k];
    p.out = (float*)d_out; p.ws = (unsigned char*)d_ws;
#if !defined(MK_MULTI)
    static int grid = 0;
    if (grid == 0) {
        int dev = 0, cus = 0, per_cu = 0;
        if (hipGetDevice(&dev) != hipSuccess || hipDeviceGetAttribute(&cus, hipDeviceAttributeMultiprocessorCount, dev) != hipSuccess) { fprintf(stderr, "kernel_launch: device query failed\n"); grid = -1; return; }
        if (hipFuncSetAttribute((const void*)mega_fwd, hipFuncAttributeMaxDynamicSharedMemorySize, LDS_BYTES) != hipSuccess) { fprintf(stderr, "kernel_launch: hipFuncSetAttribute failed\n"); grid = -1; return; }
        if (hipOccupancyMaxActiveBlocksPerMultiprocessor(&per_cu, (const void*)mega_fwd, 512, LDS_BYTES) != hipSuccess || per_cu < 1) fprintf(stderr, "kernel_launch: occupancy query says %d\n", per_cu);
        (void)hipGetLastError();
        grid = cus;
    }
    if (grid < 0) return;
    (void)hipMemsetAsync((char*)d_ws + WS_CTL, 0, 1 * MiB, stream);
    hipLaunchKernelGGL(mega_fwd, dim3(grid), dim3(512), LDS_BYTES, stream, p);
    return;
#endif
    const int G = 1024;
    launch_stage<PH_TABLES>(p, 0, 256, 0, stream);
    launch_stage<PH_CONVW>(p, 0, G, 64 * 65 * 4, stream);
    launch_stage<PH_INITH>(p, 0, G, 0, stream);
    for (int i = 0; i < 4; ++i) {
        launch_stage<PH_NORM_ATTN>(p, i, G, 0, stream);
        if ((i & 1) == 0) {
            launch_stage<PH_MLA_IN>(p, i, G, 0, stream);
            launch_stage<PH_MLA_NORMS>(p, i, G, 0, stream);
            launch_stage<PH_MLA_QUP>(p, i, G, 0, stream);
            launch_stage<PH_MLA_KVUP>(p, i, G, 0, stream);
            launch_stage<PH_MLA_HEADNORM>(p, i, G, 0, stream);
            launch_stage<PH_MLA_ATTN>(p, i, 256, MLA_LDS, stream);
            launch_stage<PH_MLA_OUT>(p, i, G, 0, stream);
        } else {
            launch_stage<PH_SWA_QKV>(p, i, G, 0, stream);
            launch_stage<PH_SWA_PREP>(p, i, G, 0, stream);
            launch_stage<PH_SWA_ATTN>(p, i, 512, SWA_LDS, stream);
            launch_stage<PH_SWA_OUT>(p, i, G, 0, stream);
        }
        launch_stage<PH_NORM_FFN>(p, i, G, 0, stream);
        launch_stage<PH_FFN_UP>(p, i, G, 0, stream);
        launch_stage<PH_FFN_DOWN>(p, i, G, 0, stream);
        launch_stage<PH_NORM_PLE>(p, i, G, 0, stream);
        launch_stage<PH_PLE_PREP>(p, i, G, 0, stream);
        launch_stage<PH_PLE_PROJ>(p, i, G, 0, stream);
        launch_stage<PH_PLE_GATE>(p, i, G, 0, stream);
    }
    launch_stage<PH_FINAL>(p, 0, G, 0, stream);
}
```

```cpp
#include <hip/hip_runtime.h>
#include <cstdint>
#include <cstdio>

#define LAS __attribute__((address_space(3)))
typedef unsigned short bf16_t;
typedef short bf16x8 __attribute__((ext_vector_type(8)));
typedef short s16x4 __attribute__((ext_vector_type(4)));
typedef float f32x4 __attribute__((ext_vector_type(4)));
typedef float f32x16 __attribute__((ext_vector_type(16)));
typedef unsigned u32x4 __attribute__((ext_vector_type(4)));
typedef unsigned u32x2 __attribute__((ext_vector_type(2)));

__device__ __forceinline__ int ltid() { int t = threadIdx.x; asm volatile("" : "+v"(t)); return t; }

constexpr int DM = 2048, SEQ = 4096, NPR = 4 * SEQ  , NSR = 256  , MR = NPR + NSR  ;
constexpr int PAST = 1024, DSEQ = 16, DBATCH = 16;
constexpr int KVPB = PAST + DSEQ;
constexpr int NKVR = NPR + DBATCH * KVPB;
constexpr int SWPB = 128 + DSEQ;
constexpr int NSKR = NPR + DBATCH * SWPB;
constexpr int DFF = 5632, PLE = 256;
constexpr int NIN_MLA = 1088, NQUP = 3072, NKVUP = 4096, NQKV = 2560;
constexpr float EPS = 1e-6f;
constexpr float LOG2E = 1.4426950408889634f;

constexpr size_t O_Y = 0;
constexpr size_t O_LATP = (size_t)MR * DM;
constexpr size_t O_KRP = O_LATP + (size_t)2 * NPR * 512;
constexpr size_t O_SKP = O_KRP + (size_t)2 * NPR * 64;
constexpr size_t O_SVP = O_SKP + (size_t)2 * 4 * 128 * 256;
constexpr size_t O_LATS = O_SVP + (size_t)2 * 4 * 128 * 256;
constexpr size_t O_KRS = O_LATS + (size_t)2 * NSR * 512;
constexpr size_t O_SKS = O_KRS + (size_t)2 * NSR * 64;
constexpr size_t O_SVS = O_SKS + (size_t)2 * 16 * 128 * 256;
constexpr size_t O_END = O_SVS + (size_t)2 * 16 * 128 * 256;
static_assert(O_END == 55869440, "output size");

constexpr size_t MiB = 1u << 20;
constexpr size_t WS_CTL = 0, WS_TABM = 1 * MiB, WS_TABS = 2 * MiB, WS_W = 3 * MiB;
constexpr size_t WE_MLA = 10092544, WE_SWA0 = 2 * WE_MLA, WE_SWA = 9437184, WE_L0 = WE_SWA0 + 2 * WE_SWA, WE_L = 39321600, WE_END = WE_L0 + 4 * WE_L;
static_assert(WE_END == 196345856, "weights");
constexpr size_t WO_IN = 0, WO_QUP = 2228224, WO_KVUP = 3801088, WO_MOUT = 5898240;
constexpr size_t WO_QKV = 0, WO_SOUT = 5242880;
constexpr size_t WO_G = 0, WO_U = 11534336, WO_D = 23068672, WO_PG = 34603008, WO_PP = 38797312;
constexpr size_t WS_HN = 378 * MiB, WS_O = 443 * MiB, WS_R = 508 * MiB;
static_assert(WS_W + WE_END * 2 <= WS_HN, "W fits");
constexpr size_t WS_Q = WS_R, WS_A32 = WS_R, WS_CQ = WS_R + 98 * MiB, WS_LAT = WS_R + 115 * MiB, WS_KR = WS_R + 148 * MiB, WS_KV = WS_R + 153 * MiB;
constexpr size_t WS_QKV32 = WS_R, WS_SQ = WS_R + 163 * MiB, WS_SK = WS_R + 228 * MiB, WS_SV = WS_R + 238 * MiB;
constexpr size_t WS_ACT = WS_R;
constexpr size_t WS_PB = WS_R, WS_T32 = WS_R + 9 * MiB;
constexpr size_t WS_END = WS_KV + (size_t)NKVR * 4096 * 2;
static_assert(WS_END <= 1000 * MiB, "ws budget");

struct Params {
    const float* in[32];
    float* out;
    unsigned char* ws;
};
__device__ __forceinline__ int opaque_i(int k) { asm volatile("" : "+v"(k)); return __builtin_amdgcn_readfirstlane(k); }
__device__ __forceinline__ int lbid() { return opaque_i((int)blockIdx.x); }
__device__ __forceinline__ const float* inp(const Params& p, int k) { return p.in[opaque_i(k)]; }
__device__ __forceinline__ unsigned long long opaque_u64(unsigned long long a) { unsigned lo = (unsigned)a, hi = (unsigned)(a >> 32); asm volatile("" : "+v"(lo), "+v"(hi));
    lo = __builtin_amdgcn_readfirstlane(lo); hi = __builtin_amdgcn_readfirstlane(hi); return ((unsigned long long)hi << 32) | lo; }
__device__ __forceinline__ unsigned char* wsp(const Params& p) { return (unsigned char*)opaque_u64((unsigned long long)p.ws); }
__device__ __forceinline__ float* outp(const Params& p) { return (float*)opaque_u64((unsigned long long)p.out); }

__device__ __forceinline__ float bf2f(bf16_t b) { return __uint_as_float(((unsigned)b) << 16); }
__device__ __forceinline__ unsigned f2bf(float f) { unsigned u = __float_as_uint(f); return (u + 0x7fffu + ((u >> 16) & 1u)) >> 16; }
__device__ __forceinline__ unsigned pk2(float lo, float hi) { return f2bf(lo) | (f2bf(hi) << 16); }
__device__ __forceinline__ float wave_sum(float v) {
#pragma unroll
    for (int o = 1; o < 64; o <<= 1) v += __shfl_xor(v, o);
    return v;
}
__device__ __forceinline__ int crow(int r, int hi) { return (r & 3) + 8 * (r >> 2) + 4 * hi; }
__device__ __forceinline__ int pos_of_row(int m) { return m < NPR ? (m & (SEQ - 1)) : PAST + ((m - NPR) & (DSEQ - 1)); }
__device__ __forceinline__ int latrow_of(int m) { return m < NPR ? m : NPR + ((m - NPR) >> 4) * KVPB + PAST + ((m - NPR) & 15); }
__device__ __forceinline__ int skrow_of(int m) { return m < NPR ? m : NPR + ((m - NPR) >> 4) * SWPB + 128 + ((m - NPR) & 15); }

__device__ __forceinline__ void ph_tables(const Params& p) {
    const int tix = ltid();
    float* tm = (float*)(wsp(p) + WS_TABM); float* ts = (float*)(wsp(p) + WS_TABS);
    const int gt = blockIdx.x * blockDim.x + tix, ngt = gridDim.x * blockDim.x;
    for (int idx = gt; idx < 4096 * 32; idx += ngt) {
        const int pos = idx >> 5, i = idx & 31;
        const float inv = powf(10000.0f, -(float)i / 32.0f);
        const float ang = (float)pos * inv;
        tm[idx * 2] = cosf(ang); tm[idx * 2 + 1] = sinf(ang);
    }
    for (int idx = gt; idx < 4096 * 8; idx += ngt) {
        const int pos = idx >> 3, i = idx & 7;
        const float inv = powf(500000.0f, -(float)i / 8.0f);
        const float ang = (float)pos * inv;
        ts[idx * 2] = cosf(ang); ts[idx * 2 + 1] = sinf(ang);
    }
}

struct WDesc { const float* src; bf16_t* dst; int K, N, mode; };
__device__ __forceinline__ WDesc wdesc(const Params& p, int idx) {
    bf16_t* W = (bf16_t*)(wsp(p) + WS_W); WDesc d; d.mode = 0;
    if (idx < 8) { const int j = idx >> 2, k = idx & 3; bf16_t* b = W + (size_t)j * WE_MLA;
        if (k == 0) { d.src = inp(p, 9) + (size_t)j * 2048 * NIN_MLA; d.dst = b + WO_IN; d.K = 2048; d.N = NIN_MLA; }
        else if (k == 1) { d.src = inp(p, 11) + (size_t)j * 512 * NQUP; d.dst = b + WO_QUP; d.K = 512; d.N = NQUP; }
        else if (k == 2) { d.src = inp(p, 13) + (size_t)j * 512 * NKVUP; d.dst = b + WO_KVUP; d.K = 512; d.N = NKVUP; }
        else { d.src = inp(p, 18) + (size_t)j * 2048 * 2048; d.dst = b + WO_MOUT; d.K = 2048; d.N = 2048; }
    } else if (idx < 12) { const int j = (idx - 8) >> 1, k = (idx - 8) & 1; bf16_t* b = W + WE_SWA0 + (size_t)j * WE_SWA;
        if (k == 0) { d.src = inp(p, 19) + (size_t)j * 2048 * NQKV; d.dst = b + WO_QKV; d.K = 2048; d.N = NQKV; }
        else { d.src = inp(p, 23) + (size_t)j * 2048 * 2048; d.dst = b + WO_SOUT; d.K = 2048; d.N = 2048; }
    } else { const int i = (idx - 12) / 5, k = (idx - 12) % 5; bf16_t* b = W + WE_L0 + (size_t)i * WE_L;
        if (k == 0) { d.src = inp(p, 25) + (size_t)i * 2048 * DFF; d.dst = b + WO_G; d.K = 2048; d.N = DFF; d.mode = 1; }
        else if (k == 1) { d.src = inp(p, 26) + (size_t)i * 2048 * DFF; d.dst = b + WO_G; d.K = 2048; d.N = DFF; d.mode = 2; }
        else if (k == 2) { d.src = inp(p, 27) + (size_t)i * DFF * 2048; d.dst = b + WO_D; d.K = DFF; d.N = 2048; }
        else if (k == 3) { d.src = inp(p, 29) + (size_t)i * 2048 * 2048; d.dst = b + WO_PG; d.K = 2048; d.N = 2048; }
        else { d.src = inp(p, 30) + (size_t)i * PLE * 2048; d.dst = b + WO_PP; d.K = PLE; d.N = 2048; }
    }
    return d;
}
__device__ __forceinline__ void ph_convert_w(const Params& p, float* tile  ) {
    const int tix = ltid();
    const int tid = tix;
    for (int w = 0; w < 32; ++w) {
        const WDesc d = wdesc(p, w);
        const int tn = d.N / 64, tk = d.K / 64, nt = tn * tk;
        for (int t = blockIdx.x; t < nt; t += gridDim.x) {
            const int k0 = (t / tn) * 64, n0 = (t % tn) * 64;
            __syncthreads();
#pragma unroll
            for (int i = 0; i < 8; ++i) { const int kk = (tid >> 6) + 8 * i, n = tid & 63; tile[kk * 65 + n] = d.src[(size_t)(k0 + kk) * d.N + n0 + n]; }
            __syncthreads();
            { const int n = tid >> 3, k8 = (tid & 7) * 8; const float* s = tile + k8 * 65 + n;
              u32x4 o; o.x = pk2(s[0], s[65]); o.y = pk2(s[2 * 65], s[3 * 65]); o.z = pk2(s[4 * 65], s[5 * 65]); o.w = pk2(s[6 * 65], s[7 * 65]);
              const int nn = n0 + n, dr = d.mode == 0 ? nn : ((nn >> 7) * 256 + (nn & 127) + (d.mode == 2 ? 128 : 0));
              *(u32x4*)(d.dst + (size_t)dr * d.K + k0 + k8) = o; }
        }
    }
}

__device__ __forceinline__ void ph_init_h(const Params& p) {
    const int tix = ltid();
    f32x4* h = (f32x4*)outp(p); const f32x4* xp = (const f32x4*)inp(p, 0); const f32x4* xs = (const f32x4*)inp(p, 1);
    const size_t np4 = (size_t)NPR * DM / 4, ns4 = (size_t)NSR * DM / 4;
    const size_t gt = (size_t)blockIdx.x * blockDim.x + tix, ngt = (size_t)gridDim.x * blockDim.x;
    for (size_t i = gt; i < np4; i += ngt) h[i] = xp[i];
    for (size_t i = gt; i < ns4; i += ngt) h[np4 + i] = xs[i];
}

template <bool FINAL>
__device__ __forceinline__ void ph_rmsnorm_h(const Params& p, const float* g) {
    const int tix = ltid();
    float* h = outp(p); bf16_t* hn = (bf16_t*)(wsp(p) + WS_HN);
    const int lane = tix & 63, gw = blockIdx.x * (blockDim.x >> 6) + (tix >> 6), ngw = gridDim.x * (blockDim.x >> 6);
    for (int m = gw; m < MR; m += ngw) {
        f32x4* hr = (f32x4*)(h + (size_t)m * DM); f32x4 v[8]; float ss = 0.f;
#pragma unroll
        for (int j = 0; j < 8; ++j) { v[j] = hr[j * 64 + lane]; ss += v[j].x * v[j].x + v[j].y * v[j].y + v[j].z * v[j].z + v[j].w * v[j].w; }
        const float rstd = rsqrtf(wave_sum(ss) * (1.0f / DM) + EPS);
#pragma unroll
        for (int j = 0; j < 8; ++j) { const f32x4 gg = ((const f32x4*)g)[j * 64 + lane]; const f32x4 y = v[j] * rstd * gg;
            if (FINAL) hr[j * 64 + lane] = y;
            else { u32x2 o; o.x = pk2(y.x, y.y); o.y = pk2(y.z, y.w); *(u32x2*)(hn + (size_t)m * DM + (j * 64 + lane) * 4) = o; } }
    }
}

template <bool DUAL, class Epi>
__device__ __forceinline__ void naive_gemm(const bf16_t* A, int lda, const bf16_t* B0, const bf16_t* B1, int M, int N, int K, const Epi& epi) {
    const int tix = ltid();
    const int tid = tix, wid = tid >> 6, lane = tid & 63, r32 = lane & 31, hi = lane >> 5;
    const int tilesN = N / 64, ntiles = (M / 256) * tilesN;
    for (int t = blockIdx.x; t < ntiles; t += gridDim.x) {
        const int tm = t / tilesN, tn = t % tilesN;
        const int row0 = tm * 256 + wid * 32, col0 = tn * 64;
        const bf16_t* ap = A + (size_t)(row0 + r32) * lda + hi * 8;
        const bf16_t* bp0 = B0 + (size_t)(col0 + r32) * K + hi * 8;
        const bf16_t* bp1 = DUAL ? B1 + (size_t)(col0 + r32) * K + hi * 8 : bp0;
        f32x16 a00 = {}, a01 = {}, a10 = {}, a11 = {};
#pragma unroll 4
        for (int k = 0; k < K; k += 16) {
            const bf16x8 a = *(const bf16x8*)(ap + k);
            const bf16x8 b0 = *(const bf16x8*)(bp0 + k), b1 = *(const bf16x8*)(bp0 + (size_t)32 * K + k);
            a00 = __builtin_amdgcn_mfma_f32_32x32x16_bf16(a, b0, a00, 0, 0, 0);
            a01 = __builtin_amdgcn_mfma_f32_32x32x16_bf16(a, b1, a01, 0, 0, 0);
            if (DUAL) { const bf16x8 c0 = *(const bf16x8*)(bp1 + k), c1 = *(const bf16x8*)(bp1 + (size_t)32 * K + k);
                a10 = __builtin_amdgcn_mfma_f32_32x32x16_bf16(a, c0, a10, 0, 0, 0);
                a11 = __builtin_amdgcn_mfma_f32_32x32x16_bf16(a, c1, a11, 0, 0, 0); }
        }
#pragma unroll
        for (int r = 0; r < 16; ++r) { const int row = row0 + crow(r, hi);
            epi(row, col0 + r32, a00[r], a10[r]); epi(row, col0 + 32 + r32, a01[r], a11[r]); }
    }
}
struct EpiF32 { float* C; int ldc; __device__ __forceinline__ void operator()(int r, int c, float v, float) const { C[(size_t)r * ldc + c] = v; } };
struct EpiBf16 { bf16_t* C; int ldc; __device__ __forceinline__ void operator()(int r, int c, float v, float) const { C[(size_t)r * ldc + c] = (bf16_t)f2bf(v); } };
struct EpiResid { float* h; __device__ __forceinline__ void operator()(int r, int c, float v, float) const { h[(size_t)r * DM + c] += v; } };
struct EpiSwiglu { bf16_t* act; __device__ __forceinline__ void operator()(int r, int c, float g, float u) const { act[(size_t)r * DFF + c] = (bf16_t)f2bf(g / (1.0f + __expf(-g)) * u); } };
struct EpiPle { float* h; const float* t; __device__ __forceinline__ void operator()(int r, int c, float v, float) const { const size_t o = (size_t)r * DM + c; h[o] += t[o] / (1.0f + __expf(-v)); } };

__device__ __forceinline__ void ph_mla_norms(const Params& p, int j) {
    const int tix = ltid();
    const float* a32 = (const float*)(wsp(p) + WS_A32); bf16_t* CQ = (bf16_t*)(wsp(p) + WS_CQ); bf16_t* LAT = (bf16_t*)(wsp(p) + WS_LAT); bf16_t* KR = (bf16_t*)(wsp(p) + WS_KR);
    const float* tm = (const float*)(wsp(p) + WS_TABM);
    const float* gq = inp(p, 10) + j * 512; const float* gkv = inp(p, 12) + j * 512; const float* gkr = inp(p, 17) + j * 64;
    const int lane = tix & 63, gw = blockIdx.x * (blockDim.x >> 6) + (tix >> 6), ngw = gridDim.x * (blockDim.x >> 6);
    for (int m = gw; m < MR; m += ngw) {
        const float* ar = a32 + (size_t)m * NIN_MLA;
        { f32x4 v0 = ((const f32x4*)ar)[lane], v1 = ((const f32x4*)ar)[64 + lane];
          const float ss = v0.x * v0.x + v0.y * v0.y + v0.z * v0.z + v0.w * v0.w + v1.x * v1.x + v1.y * v1.y + v1.z * v1.z + v1.w * v1.w;
          const float rstd = rsqrtf(wave_sum(ss) * (1.0f / 512) + EPS);
          const f32x4 y0 = v0 * rstd * ((const f32x4*)gq)[lane], y1 = v1 * rstd * ((const f32x4*)gq)[64 + lane];
          u32x2 o0, o1; o0.x = pk2(y0.x, y0.y); o0.y = pk2(y0.z, y0.w); o1.x = pk2(y1.x, y1.y); o1.y = pk2(y1.z, y1.w);
          *(u32x2*)(CQ + (size_t)m * 512 + lane * 4) = o0; *(u32x2*)(CQ + (size_t)m * 512 + 256 + lane * 4) = o1; }
        { f32x4 v0 = ((const f32x4*)(ar + 512))[lane], v1 = ((const f32x4*)(ar + 512))[64 + lane];
          const float ss = v0.x * v0.x + v0.y * v0.y + v0.z * v0.z + v0.w * v0.w + v1.x * v1.x + v1.y * v1.y + v1.z * v1.z + v1.w * v1.w;
          const float rstd = rsqrtf(wave_sum(ss) * (1.0f / 512) + EPS);
          const f32x4 y0 = v0 * rstd * ((const f32x4*)gkv)[lane], y1 = v1 * rstd * ((const f32x4*)gkv)[64 + lane];
          float* o32 = (m < NPR) ? outp(p) + O_LATP + ((size_t)j * NPR + m) * 512 : outp(p) + O_LATS + ((size_t)j * NSR + (m - NPR)) * 512;
          ((f32x4*)o32)[lane] = y0; ((f32x4*)o32)[64 + lane] = y1;
          u32x2 o0, o1; o0.x = pk2(y0.x, y0.y); o0.y = pk2(y0.z, y0.w); o1.x = pk2(y1.x, y1.y); o1.y = pk2(y1.z, y1.w);
          bf16_t* lr = LAT + (size_t)latrow_of(m) * 512;
          *(u32x2*)(lr + lane * 4) = o0; *(u32x2*)(lr + 256 + lane * 4) = o1; }
        { const float x = ar[1024 + lane]; const float rstd = rsqrtf(wave_sum(x * x) * (1.0f / 64) + EPS);
          const float y = x * rstd * gkr[lane]; const float pr = __shfl_xor(y, 32);
          const int pos = pos_of_row(m), i = lane & 31; const float c = tm[(pos * 32 + i) * 2], s = tm[(pos * 32 + i) * 2 + 1];
          const float o = lane < 32 ? y * c - pr * s : y * c + pr * s;
          float* o32 = (m < NPR) ? outp(p) + O_KRP + ((size_t)j * NPR + m) * 64 : outp(p) + O_KRS + ((size_t)j * NSR + (m - NPR)) * 64;
          o32[lane] = o; KR[(size_t)latrow_of(m) * 64 + lane] = (bf16_t)f2bf(o); }
    }
    const float* cl = inp(p, 4) + (size_t)j * DBATCH * PAST * 512; const float* ck = inp(p, 5) + (size_t)j * DBATCH * PAST * 64;
    for (int r = gw; r < DBATCH * PAST; r += ngw) {
        const int b = r >> 10, t = r & 1023; const size_t dr = (size_t)NPR + b * KVPB + t;
        const f32x4 v0 = ((const f32x4*)(cl + (size_t)r * 512))[lane], v1 = ((const f32x4*)(cl + (size_t)r * 512))[64 + lane];
        u32x2 o0, o1; o0.x = pk2(v0.x, v0.y); o0.y = pk2(v0.z, v0.w); o1.x = pk2(v1.x, v1.y); o1.y = pk2(v1.z, v1.w);
        *(u32x2*)(LAT + dr * 512 + lane * 4) = o0; *(u32x2*)(LAT + dr * 512 + 256 + lane * 4) = o1;
        KR[dr * 64 + lane] = (bf16_t)f2bf(ck[(size_t)r * 64 + lane]);
    }
}

__device__ __forceinline__ void ph_mla_headnorm(const Params& p, int j) {
    const int tix = ltid();
    bf16_t* Q = (bf16_t*)(wsp(p) + WS_Q); bf16_t* KV = (bf16_t*)(wsp(p) + WS_KV); const float* tm = (const float*)(wsp(p) + WS_TABM);
    const float* gqn = inp(p, 14) + j * 128; const float* gqr = inp(p, 15) + j * 64; const float* gkn = inp(p, 16) + j * 128;
    const int lane = tix & 63, gw = blockIdx.x * (blockDim.x >> 6) + (tix >> 6), ngw = gridDim.x * (blockDim.x >> 6);
    for (int it = gw; it < MR * 16; it += ngw) {
        const int m = it >> 4, h = it & 15; bf16_t* q = Q + (size_t)m * NQUP + h * 192;
        { const unsigned w = *(const unsigned*)(q + 2 * lane); const float x0 = __uint_as_float(w << 16), x1 = __uint_as_float(w & 0xffff0000u);
          const float rstd = rsqrtf(wave_sum(x0 * x0 + x1 * x1) * (1.0f / 128) + EPS);
          *(unsigned*)(q + 2 * lane) = pk2(x0 * rstd * gqn[2 * lane], x1 * rstd * gqn[2 * lane + 1]); }
        { const float x = bf2f(q[128 + lane]); const float rstd = rsqrtf(wave_sum(x * x) * (1.0f / 64) + EPS);
          const float y = x * rstd * gqr[lane]; const float pr = __shfl_xor(y, 32);
          const int pos = pos_of_row(m), i = lane & 31; const float c = tm[(pos * 32 + i) * 2], s = tm[(pos * 32 + i) * 2 + 1];
          q[128 + lane] = (bf16_t)f2bf(lane < 32 ? y * c - pr * s : y * c + pr * s); }
    }
    for (int it = gw; it < NKVR * 16; it += ngw) {
        const int r = it >> 4, h = it & 15; bf16_t* k = KV + (size_t)r * NKVUP + h * 256;
        const unsigned w = *(const unsigned*)(k + 2 * lane); const float x0 = __uint_as_float(w << 16), x1 = __uint_as_float(w & 0xffff0000u);
        const float rstd = rsqrtf(wave_sum(x0 * x0 + x1 * x1) * (1.0f / 128) + EPS);
        *(unsigned*)(k + 2 * lane) = pk2(x0 * rstd * gkn[2 * lane], x1 * rstd * gkn[2 * lane + 1]);
    }
}

#define SBAR() __builtin_amdgcn_sched_barrier(0)
__device__ __forceinline__ unsigned cvtpk(float lo, float hi) { unsigned r; asm volatile("v_cvt_pk_bf16_f32 %0, %1, %2" : "=v"(r) : "v"(lo), "v"(hi)); return r; }
#define PK4(P, BASE, OUT) do { unsigned a0_ = cvtpk(P[BASE + 0], P[BASE + 1]), a1_ = cvtpk(P[BASE + 2], P[BASE + 3]);   \
    unsigned b0_ = cvtpk(P[BASE + 4], P[BASE + 5]), b1_ = cvtpk(P[BASE + 6], P[BASE + 7]);                              \
    auto r0_ = __builtin_amdgcn_permlane32_swap(a0_, b0_, false, false); auto r1_ = __builtin_amdgcn_permlane32_swap(a1_, b1_, false, false); \
    u32x4 w_ = {r0_[0], r1_[0], r0_[1], r1_[1]}; OUT = *reinterpret_cast<bf16x8*>(&w_); } while (0)
__device__ __forceinline__ float half_swap_max(float v) { auto rr = __builtin_amdgcn_permlane32_swap(__float_as_uint(v), __float_as_uint(v), false, false); return fmaxf(__uint_as_float(rr[0]), __uint_as_float(rr[1])); }
__device__ __forceinline__ float half_swap_sum(float v) { auto rr = __builtin_amdgcn_permlane32_swap(__float_as_uint(v), __float_as_uint(v), false, false); return __uint_as_float(rr[0]) + __uint_as_float(rr[1]); }
template <int NC> __device__ __forceinline__ int v_st(int k, int c) { const int kk = (k & ~0xC) | ((k & 4) << 1) | ((k & 8) >> 1); return ((kk >> 3) * (NC / 32) + (c >> 5)) * 512 + ((kk & 7) * 32 + (c & 31)) * 2; }
__device__ __forceinline__ int v_rd_base(int lane) { return ((lane & 3) << 3) | (((lane >> 2) & 3) << 6) | (((lane >> 4) & 1) << 5) | (((lane >> 5) & 1) << 8); }
template <int NC> constexpr int v_rd_off(int d0, int ks, int half) { return d0 * 512 + ks * (NC / 32) * 1024 + half * (NC / 32) * 512; }
template <int OFF> __device__ __forceinline__ s16x4 tr_read(int vb) { s16x4 r; asm volatile("ds_read_b64_tr_b16 %0, %1 offset:%2" : "=&v"(r) : "v"(vb), "i"(OFF) : "memory"); return r; }
#define PKV(L, H) (bf16x8){L[0], L[1], L[2], L[3], H[0], H[1], H[2], H[3]}
template <int NC, int D0> __device__ __forceinline__ void pv_one(f32x16& od, int vb, bf16x8 pa0, bf16x8 pa1, bf16x8 pa2, bf16x8 pa3) {
    const s16x4 l0 = tr_read<v_rd_off<NC>(D0, 0, 0)>(vb), h0 = tr_read<v_rd_off<NC>(D0, 0, 1)>(vb), l1 = tr_read<v_rd_off<NC>(D0, 1, 0)>(vb), h1 = tr_read<v_rd_off<NC>(D0, 1, 1)>(vb);
    const s16x4 l2 = tr_read<v_rd_off<NC>(D0, 2, 0)>(vb), h2 = tr_read<v_rd_off<NC>(D0, 2, 1)>(vb), l3 = tr_read<v_rd_off<NC>(D0, 3, 0)>(vb), h3 = tr_read<v_rd_off<NC>(D0, 3, 1)>(vb);
    asm volatile("s_waitcnt lgkmcnt(0)" ::: "memory"); SBAR();
    od = __builtin_amdgcn_mfma_f32_32x32x16_bf16(pa0, PKV(l0, h0), od, 0, 0, 0);
    od = __builtin_amdgcn_mfma_f32_32x32x16_bf16(pa1, PKV(l1, h1), od, 0, 0, 0);
    od = __builtin_amdgcn_mfma_f32_32x32x16_bf16(pa2, PKV(l2, h2), od, 0, 0, 0);
    od = __builtin_amdgcn_mfma_f32_32x32x16_bf16(pa3, PKV(l3, h3), od, 0, 0, 0);
}
#define KSWZ256(row, colB) ((row) * 256 + ((colB) ^ (((row) & 7) << 4)))
#define KSWZ128(row, colB) ((row) * 128 + ((colB) ^ (((row) & 7) << 4)))

constexpr int MLA_V = 0, MLA_K = 32768, MLA_KR = 65536, MLA_WS = 81920, MLA_LDS = 83968;
constexpr float MLA_C = 0.07216878364870322f * LOG2E;
__device__ __forceinline__ void mla_attn_unit(const bf16_t* Qh, int nq, const bf16_t* KVh, const bf16_t* KRb, int nkeys, int NT, int my_nt, bf16_t* Oh, char* lds) {
    int tid = threadIdx.x; asm volatile("" : "+v"(tid));
    const int wid = __builtin_amdgcn_readfirstlane(tid >> 6), lane = tid & 63, r32 = lane & 31, hi = lane >> 5;
    LAS char* L = (LAS char*)lds;
    LAS float* wsf = (LAS float*)(L + MLA_WS) + wid * 64;
    bf16x8 qr[12];
    { int qrow = wid * 32 + r32; if (qrow > nq - 1) qrow = nq - 1; const bf16_t* qp = Qh + (size_t)qrow * NQUP + hi * 8;
#pragma unroll
      for (int d0 = 0; d0 < 12; ++d0) qr[d0] = *(const bf16x8*)(qp + d0 * 16); }
    int kq[4];
#pragma unroll
    for (int q = 0; q < 4; ++q) kq[q] = ((q * 32 + hi * 16) ^ ((r32 & 7) << 4));
    const int krow256 = r32 * 256, krow128 = r32 * 128;
    const int sr = tid >> 4, sc = (tid & 15) * 8, vst0 = v_st<128>(sr, sc), vst1 = v_st<128>(32 + sr, sc);
    const int kst0 = KSWZ256(sr, sc * 2), kst1 = KSWZ256(32 + sr, sc * 2);
    const int krr = tid >> 3, krc = (tid & 7) * 8, krst = KSWZ128(krr, krc * 2);
    const int vb0 = (int)(uintptr_t)(lds + MLA_V) + v_rd_base(lane);
#define MLA_STAGE(t, b) do { int ra = (t) * 64 + sr, rb = ra + 32, rc = (t) * 64 + krr; if (ra > nkeys - 1) ra = nkeys - 1; if (rb > nkeys - 1) rb = nkeys - 1; if (rc > nkeys - 1) rc = nkeys - 1; \
        const bf16x8 sk0 = *(const bf16x8*)(KVh + (size_t)ra * NKVUP + sc), sk1 = *(const bf16x8*)(KVh + (size_t)rb * NKVUP + sc); \
        const bf16x8 sv0 = *(const bf16x8*)(KVh + (size_t)ra * NKVUP + 128 + sc), sv1 = *(const bf16x8*)(KVh + (size_t)rb * NKVUP + 128 + sc); \
        const bf16x8 skr = *(const bf16x8*)(KRb + (size_t)rc * 64 + krc); \
        *(LAS bf16x8*)(L + MLA_V + (b) * 16384 + vst0) = sv0; *(LAS bf16x8*)(L + MLA_V + (b) * 16384 + vst1) = sv1; \
        *(LAS bf16x8*)(L + MLA_K + (b) * 16384 + kst0) = sk0; *(LAS bf16x8*)(L + MLA_K + (b) * 16384 + kst1) = sk1; \
        *(LAS bf16x8*)(L + MLA_KR + (b) * 8192 + krst) = skr; } while (0)
    float m_reg = -1e30f, l_reg = 0.f; f32x16 o[4] = {};
    MLA_STAGE(0, 0); __syncthreads();
    for (int j = 0; j < NT; ++j) {
        const int b = j & 1;
        if (j < my_nt) {
            f32x16 p0 = {}, p1 = {};
            const LAS char* Kb = L + MLA_K + b * 16384 + krow256; const LAS char* KRp = L + MLA_KR + b * 8192 + krow128;
#pragma unroll
            for (int d0 = 0; d0 < 8; ++d0) {
                const bf16x8 k0 = *(const LAS bf16x8*)(Kb + kq[d0 & 3] + (d0 >> 2) * 128), k1 = *(const LAS bf16x8*)(Kb + kq[d0 & 3] + (d0 >> 2) * 128 + 8192);
                p0 = __builtin_amdgcn_mfma_f32_32x32x16_bf16(k0, qr[d0], p0, 0, 0, 0);
                p1 = __builtin_amdgcn_mfma_f32_32x32x16_bf16(k1, qr[d0], p1, 0, 0, 0); if (d0 & 1) SBAR(); }
#pragma unroll
            for (int d0 = 0; d0 < 4; ++d0) {
                const bf16x8 k0 = *(const LAS bf16x8*)(KRp + kq[d0]), k1 = *(const LAS bf16x8*)(KRp + kq[d0] + 4096);
                p0 = __builtin_amdgcn_mfma_f32_32x32x16_bf16(k0, qr[8 + d0], p0, 0, 0, 0);
                p1 = __builtin_amdgcn_mfma_f32_32x32x16_bf16(k1, qr[8 + d0], p1, 0, 0, 0); if (d0 & 1) SBAR(); }
            if (j * 64 + 64 > nkeys) {
#pragma unroll
                for (int r = 0; r < 16; ++r) { const int kk = j * 64 + crow(r, hi); if (kk >= nkeys) p0[r] = -1e30f; if (kk + 32 >= nkeys) p1[r] = -1e30f; }
            }
            float pmax = p0[0];
#pragma unroll
            for (int r = 1; r < 16; ++r) pmax = fmaxf(pmax, p0[r]);
#pragma unroll
            for (int r = 0; r < 16; ++r) pmax = fmaxf(pmax, p1[r]);
            pmax = half_swap_max(pmax);
            const float mn = fmaxf(m_reg, pmax); const float alpha = __builtin_amdgcn_exp2f((m_reg - mn) * MLA_C); m_reg = mn;
            const float mnC = -mn * MLA_C; float ps = 0.f;
#pragma unroll
            for (int r = 0; r < 16; ++r) { p0[r] = __builtin_amdgcn_exp2f(fmaf(p0[r], MLA_C, mnC)); p1[r] = __builtin_amdgcn_exp2f(fmaf(p1[r], MLA_C, mnC)); ps += p0[r] + p1[r]; }
            ps = half_swap_sum(ps);
            l_reg = l_reg * alpha + ps;
            bf16x8 pa0, pa1, pa2, pa3;
            PK4(p0, 0, pa0); PK4(p0, 8, pa1); PK4(p1, 0, pa2); PK4(p1, 8, pa3);
            if (hi == 0) wsf[r32] = alpha; asm volatile("s_waitcnt lgkmcnt(0)" ::: "memory");
#pragma unroll
            for (int r = 0; r < 16; ++r) { const float a = wsf[crow(r, hi)];
#pragma unroll
                for (int d = 0; d < 4; ++d) o[d][r] *= a; }
            asm volatile("s_waitcnt lgkmcnt(0)" ::: "memory");
            const int vb = vb0 + b * 16384;
            pv_one<128, 0>(o[0], vb, pa0, pa1, pa2, pa3); pv_one<128, 1>(o[1], vb, pa0, pa1, pa2, pa3);
            pv_one<128, 2>(o[2], vb, pa0, pa1, pa2, pa3); pv_one<128, 3>(o[3], vb, pa0, pa1, pa2, pa3);
        }
        if (j + 1 < NT) MLA_STAGE(j + 1, b ^ 1);
        __syncthreads();
    }
    if (hi == 0) wsf[32 + r32] = l_reg; asm volatile("s_waitcnt lgkmcnt(0)" ::: "memory");
#pragma unroll
    for (int r = 0; r < 16; ++r) { const int orow = wid * 32 + crow(r, hi); const float rl = 1.0f / wsf[32 + crow(r, hi)];
        if (orow < nq) {
#pragma unroll
            for (int d = 0; d < 4; ++d) Oh[orow * DM + d * 32 + r32] = (bf16_t)f2bf(o[d][r] * rl); } }
    __syncthreads();
#undef MLA_STAGE
}
__device__ __forceinline__ void ph_mla_attn(const Params& p, char* lds) {
    const int tix = ltid();
    const bf16_t* Q = (const bf16_t*)(wsp(p) + WS_Q); const bf16_t* KV = (const bf16_t*)(wsp(p) + WS_KV); const bf16_t* KR = (const bf16_t*)(wsp(p) + WS_KR); bf16_t* O = (bf16_t*)(wsp(p) + WS_O);
    const int wid = tix >> 6, G = gridDim.x;
    const int npr = (512 + G - 1) / G, nsr = (DBATCH * 16 + G - 1) / G;
    for (int sl = 0; sl < 2 * npr + nsr; ++sl) {
        size_t row0, kr0; int h, nq, nkeys, NT, my_nt;
        if (sl < 2 * npr) {
            const int pi = blockIdx.x + (sl >> 1) * G; if (pi >= 512) continue;
            const int bh = pi >> 3, s = pi & 7, b = bh >> 4, qb = (sl & 1) ? 15 - s : s; h = bh & 15;
            row0 = (size_t)b * SEQ + qb * 256; kr0 = (size_t)b * SEQ; nq = 256; nkeys = SEQ; NT = 4 * qb + 4; my_nt = 4 * qb + (wid >> 1) + 1;
        } else {
            const int u = blockIdx.x + (sl - 2 * npr) * G; if (u >= DBATCH * 16) continue;
            const int b = u >> 4; h = u & 15;
            row0 = (size_t)NPR + b * 16; kr0 = (size_t)NPR + b * KVPB; nq = 16; nkeys = KVPB; NT = 17; my_nt = wid == 0 ? 17 : 0;
        }
        mla_attn_unit(Q + row0 * NQUP + h * 192, nq, KV + kr0 * NKVUP + h * 256, KR + kr0 * 64, nkeys, NT, my_nt, O + row0 * DM + h * 128, lds);
    }
}

__device__ __forceinline__ void ph_swa_prep(const Params& p, int j) {
    const int tix = ltid();
    const float* qkv = (const float*)(wsp(p) + WS_QKV32); bf16_t* SQ = (bf16_t*)(wsp(p) + WS_SQ); bf16_t* SK = (bf16_t*)(wsp(p) + WS_SK); bf16_t* SV = (bf16_t*)(wsp(p) + WS_SV);
    const float* ts = (const float*)(wsp(p) + WS_TABS); const float* gq = inp(p, 20) + j * 64; const float* gk = inp(p, 21) + j * 64;
    const int lane = tix & 63, gw = blockIdx.x * (blockDim.x >> 6) + (tix >> 6), ngw = gridDim.x * (blockDim.x >> 6);
    for (int it = gw; it < MR * 40; it += ngw) {
        const int m = it / 40, s = it % 40; const float x = qkv[(size_t)m * NQKV + s * 64 + lane];
        float y = x;
        if (s < 36) {
            const float rstd = rsqrtf(wave_sum(x * x) * (1.0f / 64) + EPS); y = x * rstd * (s < 32 ? gq[lane] : gk[lane]);
            const float pr = __shfl_xor(y, 8); const int pos = pos_of_row(m), i = lane & 7;
            const float c = ts[(pos * 8 + i) * 2], sn = ts[(pos * 8 + i) * 2 + 1];
            if (lane < 8) y = y * c - pr * sn; else if (lane < 16) y = y * c + pr * sn;
        }
        if (s < 32) SQ[(size_t)m * DM + s * 64 + lane] = (bf16_t)f2bf(y);
        else {
            const int g = (s - 32) & 3; const bool isk = s < 36; bf16_t* dst = isk ? SK : SV;
            dst[(size_t)skrow_of(m) * 256 + g * 64 + lane] = (bf16_t)f2bf(y);
            if (m < NPR) { const int b = m >> 12, t = m & 4095;
                if (t >= SEQ - 128) outp(p)[(isk ? O_SKP : O_SVP) + (((size_t)j * 4 + b) * 128 + (t - (SEQ - 128))) * 256 + g * 64 + lane] = y; }
            else { const int b = (m - NPR) >> 4, t = (m - NPR) & 15;
                outp(p)[(isk ? O_SKS : O_SVS) + (((size_t)j * 16 + b) * 128 + 112 + t) * 256 + g * 64 + lane] = y; }
        }
    }
    const float* sk = inp(p, 6) + (size_t)j * DBATCH * 128 * 256; const float* sv = inp(p, 7) + (size_t)j * DBATCH * 128 * 256;
    for (int r = gw; r < DBATCH * 128; r += ngw) {
        const int b = r >> 7, i = r & 127; const size_t dr = (size_t)NPR + b * SWPB + i;
        const f32x4 kx = ((const f32x4*)(sk + (size_t)r * 256))[lane], vx = ((const f32x4*)(sv + (size_t)r * 256))[lane];
        u32x2 ko, vo; ko.x = pk2(kx.x, kx.y); ko.y = pk2(kx.z, kx.w); vo.x = pk2(vx.x, vx.y); vo.y = pk2(vx.z, vx.w);
        *(u32x2*)(SK + dr * 256 + lane * 4) = ko; *(u32x2*)(SV + dr * 256 + lane * 4) = vo;
        if (i >= 16) { ((f32x4*)(outp(p) + O_SKS + (((size_t)j * 16 + b) * 128 + (i - 16)) * 256))[lane] = kx;
                       ((f32x4*)(outp(p) + O_SVS + (((size_t)j * 16 + b) * 128 + (i - 16)) * 256))[lane] = vx; }
    }
}

constexpr int SWA_K = 0, SWA_V = 24576, SWA_WS = 49152, SWA_LDS = 51200;
__device__ __forceinline__ void swa_attn_unit(const bf16_t* Qb, int nq, const bf16_t* Kb, const bf16_t* Vb, int nkeys, const float* sinks8, bf16_t* Ob, char* lds) {
    int tid = threadIdx.x; asm volatile("" : "+v"(tid));
    const int wid = __builtin_amdgcn_readfirstlane(tid >> 6), lane = tid & 63, r32 = lane & 31, hi = lane >> 5;
    LAS char* L = (LAS char*)lds; LAS float* wsf = (LAS float*)(L + SWA_WS) + wid * 64;
#pragma unroll
    for (int i = 0; i < 3; ++i) { const int idx = tid + i * 512, row = idx >> 3, ch = idx & 7; const bool valid = row < nkeys; const int rr = valid ? row : 0;
        bf16x8 kx = *(const bf16x8*)(Kb + (size_t)rr * 256 + ch * 8), vx = *(const bf16x8*)(Vb + (size_t)rr * 256 + ch * 8);
        if (!valid) { kx = (bf16x8){0, 0, 0, 0, 0, 0, 0, 0}; vx = kx; }
        *(LAS bf16x8*)(L + SWA_K + KSWZ128(row, ch * 16)) = kx;
        *(LAS bf16x8*)(L + SWA_V + (row >> 6) * 8192 + v_st<64>(row & 63, ch * 8)) = vx; }
    __syncthreads();
    const float sink2 = sinks8[wid] * LOG2E; const int vb0 = (int)(uintptr_t)(lds + SWA_V) + v_rd_base(lane);
    constexpr float SC = 0.125f * LOG2E;
    int kq[4];
#pragma unroll
    for (int q = 0; q < 4; ++q) kq[q] = r32 * 128 + ((q * 32 + hi * 16) ^ ((r32 & 7) << 4));
    const int ntile = (nkeys + 63) >> 6;
    for (int q2 = 0; q2 * 32 < nq; ++q2) {
        bf16x8 qr[4];
        { int qrow = q2 * 32 + r32; if (qrow > nq - 1) qrow = nq - 1; const bf16_t* qp = Qb + (size_t)qrow * DM + wid * 64 + hi * 8;
#pragma unroll
          for (int d0 = 0; d0 < 4; ++d0) qr[d0] = *(const bf16x8*)(qp + d0 * 16); }
        float m_reg = sink2, l_reg = 1.0f; f32x16 o0 = {}, o1 = {};
        for (int t = 0; t < ntile; ++t) {
            f32x16 p0 = {}, p1 = {};
            const LAS char* Kt = L + SWA_K + t * 8192;
#pragma unroll
            for (int d0 = 0; d0 < 4; ++d0) { const bf16x8 k0 = *(const LAS bf16x8*)(Kt + kq[d0]), k1 = *(const LAS bf16x8*)(Kt + kq[d0] + 4096);
                p0 = __builtin_amdgcn_mfma_f32_32x32x16_bf16(k0, qr[d0], p0, 0, 0, 0);
                p1 = __builtin_amdgcn_mfma_f32_32x32x16_bf16(k1, qr[d0], p1, 0, 0, 0); }
            if (t * 64 + 64 > nkeys) {
#pragma unroll
                for (int r = 0; r < 16; ++r) { const int kk = t * 64 + crow(r, hi); if (kk >= nkeys) p0[r] = -1e30f; if (kk + 32 >= nkeys) p1[r] = -1e30f; }
            }
            float pmax = p0[0];
#pragma unroll
            for (int r = 1; r < 16; ++r) pmax = fmaxf(pmax, p0[r]);
#pragma unroll
            for (int r = 0; r < 16; ++r) pmax = fmaxf(pmax, p1[r]);
            pmax = half_swap_max(pmax) * SC;
            const float mn = fmaxf(m_reg, pmax); const float alpha = __builtin_amdgcn_exp2f(m_reg - mn); m_reg = mn;
            float ps = 0.f;
#pragma unroll
            for (int r = 0; r < 16; ++r) { p0[r] = __builtin_amdgcn_exp2f(fmaf(p0[r], SC, -mn)); p1[r] = __builtin_amdgcn_exp2f(fmaf(p1[r], SC, -mn)); ps += p0[r] + p1[r]; }
            ps = half_swap_sum(ps);
            l_reg = l_reg * alpha + ps;
            bf16x8 pa0, pa1, pa2, pa3;
            PK4(p0, 0, pa0); PK4(p0, 8, pa1); PK4(p1, 0, pa2); PK4(p1, 8, pa3);
            if (hi == 0) wsf[r32] = alpha; asm volatile("s_waitcnt lgkmcnt(0)" ::: "memory");
#pragma unroll
            for (int r = 0; r < 16; ++r) { const float a = wsf[crow(r, hi)]; o0[r] *= a; o1[r] *= a; }
            asm volatile("s_waitcnt lgkmcnt(0)" ::: "memory");
            const int vb = vb0 + t * 8192;
            pv_one<64, 0>(o0, vb, pa0, pa1, pa2, pa3); pv_one<64, 1>(o1, vb, pa0, pa1, pa2, pa3);
        }
        if (hi == 0) wsf[32 + r32] = l_reg; asm volatile("s_waitcnt lgkmcnt(0)" ::: "memory");
#pragma unroll
        for (int r = 0; r < 16; ++r) { const int orow = q2 * 32 + crow(r, hi); const float rl = 1.0f / wsf[32 + crow(r, hi)];
            if (orow < nq) { Ob[orow * DM + wid * 64 + r32] = (bf16_t)f2bf(o0[r] * rl); Ob[orow * DM + wid * 64 + 32 + r32] = (bf16_t)f2bf(o1[r] * rl); } }
        asm volatile("s_waitcnt lgkmcnt(0)" ::: "memory");
    }
    __syncthreads();
}
__device__ __forceinline__ void ph_swa_attn(const Params& p, int j, char* lds) {
    const bf16_t* SQ = (const bf16_t*)(wsp(p) + WS_SQ); const bf16_t* SK = (const bf16_t*)(wsp(p) + WS_SK); const bf16_t* SV = (const bf16_t*)(wsp(p) + WS_SV); bf16_t* O = (bf16_t*)(wsp(p) + WS_O);
    const float* sinks = inp(p, 22) + j * 32;
    for (int u = blockIdx.x; u < 1024 + DBATCH * 4; u += gridDim.x) {
        size_t qrow0, krow0; int g, nq, nk;
        if (u < 1024) { const int c = u & 63, b = u >> 8; g = (u >> 6) & 3; const int c0 = c >= 2 ? c - 2 : 0; nk = (c - c0 + 1) * 64; nq = 64;
            qrow0 = (size_t)b * SEQ + c * 64; krow0 = (size_t)b * SEQ + c0 * 64; }
        else { const int v = u - 1024, b = v >> 2; g = v & 3; nq = 16; nk = SWPB; qrow0 = (size_t)NPR + b * 16; krow0 = (size_t)NPR + b * SWPB; }
        swa_attn_unit(SQ + qrow0 * DM + g * 512, nq, SK + krow0 * 256 + g * 64, SV + krow0 * 256 + g * 64, nk, sinks + g * 8, O + qrow0 * DM + g * 512, lds);
    }
}

__device__ __forceinline__ void ph_ple_prep(const Params& p, int i) {
    const int tix = ltid();
    bf16_t* PB = (bf16_t*)(wsp(p) + WS_PB);
    const f32x4* pp = (const f32x4*)(inp(p, 2) + (size_t)i * NPR * PLE); const f32x4* ps = (const f32x4*)(inp(p, 3) + (size_t)i * NSR * PLE);
    const size_t np4 = (size_t)NPR * PLE / 4, ns4 = (size_t)NSR * PLE / 4;
    const size_t gt = (size_t)blockIdx.x * blockDim.x + tix, ngt = (size_t)gridDim.x * blockDim.x;
    for (size_t k = gt; k < np4 + ns4; k += ngt) { const f32x4 v = k < np4 ? pp[k] : ps[k - np4]; u32x2 o; o.x = pk2(v.x, v.y); o.y = pk2(v.z, v.w); *(u32x2*)(PB + k * 4) = o; }
}

namespace pg8 {
#define PG8_LAS __attribute__((address_space(3)))
typedef unsigned short bf16_t;
typedef short bf16x8 __attribute__((ext_vector_type(8)));
typedef float f32x4 __attribute__((ext_vector_type(4)));
typedef unsigned u32x4 __attribute__((ext_vector_type(4)));
constexpr int BM = 256, BK = 64, HALF = 128, HTB = HALF * BK * 2  , STAGE_BYTES = 8 * HTB, NXCD = 8, WGM = 8;

__host__ __device__ __forceinline__ int lds_byte(int r, int c) { const int st = (r >> 4) * 2 + (c >> 5), rr = r & 15, cc = c & 31, ob = rr * 64 + cc * 2; return st * 1024 + (ob ^ (((ob >> 9) & 1) << 5)); }
__host__ __device__ __forceinline__ void stage_rc(int b, int& R, int& C) { const int st = b / 1024, sb = b % 1024, swz = sb ^ (((sb >> 9) & 1) << 5); R = (st >> 1) * 16 + swz / 64; C = (st & 1) * 32 + (swz % 64) / 2; }
__host__ __device__ __forceinline__ int perm32(int rho) { const int n = rho >> 4, i = rho & 15; return 8 * (i >> 2) + 4 * n + (i & 3); }

struct Unit { int pm, pn; };
struct Gemm { const bf16_t* A; const bf16_t* Bt; int M, N, K; };

struct StaticOrder {
    int nM, nN, nwg, G, c;
    __host__ __device__ void init(int M, int N, int G_, int c_) { nM = M / BM; nN = N / BM; nwg = nM * nN; G = G_; c = c_; }
    __host__ __device__ bool next(int i, Unit& u) const {
        const long L = (long)i * G + c; if (L >= nwg) return false;
        int wgid = (int)L; { const int q = nwg / NXCD, r = nwg % NXCD, xcd = wgid % NXCD, off = wgid / NXCD; wgid = (xcd < r ? xcd * (q + 1) : r * (q + 1) + (xcd - r) * q) + off; }
        const int nig = WGM * nN, gid = wgid / nig, fm = gid * WGM, gsz = (nM - fm) < WGM ? (nM - fm) : WGM;
        u.pm = fm + ((wgid % nig) % gsz); u.pn = (wgid % nig) / gsz; return true;
    }
    __device__ __forceinline__ void a_ready(const Unit&) const {}
    __device__ __forceinline__ void done(const Unit&) const {}
};

__device__ __forceinline__ unsigned cvt_pk_bf16(float lo, float hi) { unsigned r; asm volatile("v_cvt_pk_bf16_f32 %0, %1, %2" : "=v"(r) : "v"(lo), "v"(hi)); return r; }
#define PG8_FOR_ROWS for (int ai = 0; ai < 2; ++ai) _Pragma("unroll") for (int m = 0; m < 4; ++m)
struct EpiStoreF32 {
    static constexpr bool PERM = false, AFTER_DRAIN = false;
    float* C; int ldc, ncols;
    __device__ __forceinline__ void operator()(const f32x4 (&acc)[2][2][4][2], const Unit& u, int wr, int wc, int fr, int fq) const {
        const int row0 = u.pm * BM + wr * 64 + fr, col0 = u.pn * BM + wc * 32 + 4 * fq;
#pragma unroll
        PG8_FOR_ROWS { float* rowp = C + (size_t)(row0 + ai * HALF + m * 16) * ldc + col0;
#pragma unroll
            for (int bj = 0; bj < 2; ++bj)
#pragma unroll
                for (int n = 0; n < 2; ++n) if (col0 + bj * HALF + n * 16 < ncols) *(f32x4*)(rowp + bj * HALF + n * 16) = acc[ai][bj][m][n]; }
    }
};
struct EpiResidF32 {
    static constexpr bool PERM = false, AFTER_DRAIN = false;
    float* h;
    __device__ __forceinline__ void operator()(const f32x4 (&acc)[2][2][4][2], const Unit& u, int wr, int wc, int fr, int fq) const {
        const int row0 = u.pm * BM + wr * 64 + fr, col0 = u.pn * BM + wc * 32 + 4 * fq;
#pragma unroll
        PG8_FOR_ROWS { float* rowp = h + (size_t)(row0 + ai * HALF + m * 16) * 2048 + col0;
            f32x4 v[2][2];
#pragma unroll
            for (int bj = 0; bj < 2; ++bj)
#pragma unroll
                for (int n = 0; n < 2; ++n) v[bj][n] = *(const f32x4*)(rowp + bj * HALF + n * 16);
#pragma unroll
            for (int bj = 0; bj < 2; ++bj)
#pragma unroll
                for (int n = 0; n < 2; ++n) *(f32x4*)(rowp + bj * HALF + n * 16) = v[bj][n] + acc[ai][bj][m][n];
            asm volatile("" ::: "memory"); }
    }
};
struct EpiPleF32 {
    static constexpr bool PERM = false, AFTER_DRAIN = false;
    float* h; const float* t;
    __device__ __forceinline__ void operator()(const f32x4 (&acc)[2][2][4][2], const Unit& u, int wr, int wc, int fr, int fq) const {
        const int row0 = u.pm * BM + wr * 64 + fr, col0 = u.pn * BM + wc * 32 + 4 * fq;
#pragma unroll
        PG8_FOR_ROWS { const size_t off = (size_t)(row0 + ai * HALF + m * 16) * 2048 + col0;
#pragma unroll
            for (int bj = 0; bj < 2; ++bj)
#pragma unroll
                for (int n = 0; n < 2; ++n) { const f32x4 hv = *(const f32x4*)(h + off + bj * HALF + n * 16), tv = *(const f32x4*)(t + off + bj * HALF + n * 16), a = acc[ai][bj][m][n]; f32x4 o;
#pragma unroll
                    for (int e = 0; e < 4; ++e) o[e] = hv[e] + tv[e] * __builtin_amdgcn_rcpf(1.0f + __expf(-a[e]));
                    *(f32x4*)(h + off + bj * HALF + n * 16) = o; }
            asm volatile("" ::: "memory"); }
    }
};
struct EpiStoreBf16 {
    static constexpr bool PERM = true, AFTER_DRAIN = false;
    bf16_t* O; int ldc;
    __device__ __forceinline__ void operator()(const f32x4 (&acc)[2][2][4][2], const Unit& u, int wr, int wc, int fr, int fq) const {
        const int row0 = u.pm * BM + wr * 64 + fr, col0 = u.pn * BM + wc * 32 + 8 * fq;
#pragma unroll
        PG8_FOR_ROWS { bf16_t* rowp = O + (size_t)(row0 + ai * HALF + m * 16) * ldc + col0;
#pragma unroll
            for (int bj = 0; bj < 2; ++bj) { const f32x4 v0 = acc[ai][bj][m][0], v1 = acc[ai][bj][m][1];
                u32x4 w; w.x = cvt_pk_bf16(v0[0], v0[1]); w.y = cvt_pk_bf16(v0[2], v0[3]); w.z = cvt_pk_bf16(v1[0], v1[1]); w.w = cvt_pk_bf16(v1[2], v1[3]);
                *(u32x4*)(rowp + bj * HALF) = w; } }
    }
};
struct EpiSwigluBf16 {
    static constexpr bool PERM = true, AFTER_DRAIN = false;
    bf16_t* act; int ldc;
    __device__ __forceinline__ void operator()(const f32x4 (&acc)[2][2][4][2], const Unit& u, int wr, int wc, int fr, int fq) const {
        const int row0 = u.pm * BM + wr * 64 + fr, ch0 = u.pn * HALF + wc * 32 + 8 * fq;
#pragma unroll
        PG8_FOR_ROWS { bf16_t* rowp = act + (size_t)(row0 + ai * HALF + m * 16) * ldc + ch0; float o[8];
#pragma unroll
            for (int n = 0; n < 2; ++n)
#pragma unroll
                for (int e = 0; e < 4; ++e) { const float g = acc[ai][0][m][n][e], up = acc[ai][1][m][n][e]; o[n * 4 + e] = g * __builtin_amdgcn_rcpf(1.0f + __expf(-g)) * up; }
            u32x4 w; w.x = cvt_pk_bf16(o[0], o[1]); w.y = cvt_pk_bf16(o[2], o[3]); w.z = cvt_pk_bf16(o[4], o[5]); w.w = cvt_pk_bf16(o[6], o[7]);
            *(u32x4*)rowp = w; }
    }
};
#undef PG8_FOR_ROWS

template <class Epi, class Sched, bool ALIGN_EPI = false, bool SP2 = false>
__device__ __forceinline__ void gemm_phase(PG8_LAS unsigned char* lds, const Gemm g, const Sched& S, const Epi& E) {
    const int tid = ltid(), wid = __builtin_amdgcn_readfirstlane(tid >> 6), lane = tid & 63, wr = wid >> 2, wc = wid & 3, fr = lane & 15, fq = lane >> 4;
    const int K = g.K, nt = K / BK;
    unsigned voffA[2], voffB[2];
#pragma unroll
    for (int i = 0; i < 2; ++i) { int R, C; stage_rc(tid * 16 + i * 8192, R, C); const int Rb = Epi::PERM ? ((R & ~31) + perm32(R & 31)) : R;
        voffA[i] = (unsigned)(R * K + C) * 2u; voffB[i] = (unsigned)(Rb * K + C) * 2u; }
    const size_t kstep = (size_t)(BK * 2);
    const size_t hstep = (size_t)HALF * K * 2;
    const size_t tstep = 2 * hstep;
    const unsigned ldsw = (unsigned)wid * 1024u;
    const int aoff = lds_byte(wr * 64 + fr, fq * 8), boff = lds_byte(wc * 32 + fr, fq * 8);
#define PG8_SA(b, h) (((b) * 2 + (h)) * HTB)
#define PG8_SB(b, h) ((4 + (b) * 2 + (h)) * HTB)
#define PG8_STAGE(bufoff, gbase, voff) do { _Pragma("unroll") for (int _i = 0; _i < 2; ++_i) \
        __builtin_amdgcn_global_load_lds((const unsigned*)((const char*)(gbase) + (voff)[_i]), (PG8_LAS unsigned*)(lds + (bufoff) + ldsw + _i * 8192), 16, 0, 0); } while (0)
#define PG8_LDA(dst, b, h) do { _Pragma("unroll") for (int m = 0; m < 4; ++m) _Pragma("unroll") for (int k = 0; k < 2; ++k) dst[m][k] = *(const PG8_LAS bf16x8*)(lds + PG8_SA(b, h) + aoff + m * 2048 + k * 1024); } while (0)
#define PG8_LDB(dst, b, h) do { _Pragma("unroll") for (int n = 0; n < 2; ++n) _Pragma("unroll") for (int k = 0; k < 2; ++k) dst[n][k] = *(const PG8_LAS bf16x8*)(lds + PG8_SB(b, h) + boff + n * 2048 + k * 1024); } while (0)
#define PG8_MMA(ai, bj, At, Bt) do { __builtin_amdgcn_s_setprio(1); _Pragma("unroll") for (int m = 0; m < 4; ++m) _Pragma("unroll") for (int n = 0; n < 2; ++n) _Pragma("unroll") for (int k = 0; k < 2; ++k) \
        acc[ai][bj][m][n] = __builtin_amdgcn_mfma_f32_16x16x32_bf16(Bt[n][k], At[m][k], acc[ai][bj][m][n], 0, 0, 0); __builtin_amdgcn_s_setprio(0); } while (0)
#define PG8_WAIT_V(n) asm volatile("s_waitcnt vmcnt(" #n ")" ::: "memory")
#define PG8_WAIT_L(n) asm volatile("s_waitcnt lgkmcnt(" #n ")" ::: "memory")
#define PG8_BAR __builtin_amdgcn_s_barrier()
#define PG8_SCHED __builtin_amdgcn_sched_barrier(0)
    Unit cur, nxt; int ui = 0;
    if (!S.next(0, cur)) return;
    f32x4 acc[2][2][4][2];
#pragma unroll
    for (int a = 0; a < 2; ++a)
#pragma unroll
        for (int b = 0; b < 2; ++b)
#pragma unroll
            for (int m = 0; m < 4; ++m)
#pragma unroll
                for (int n = 0; n < 2; ++n) acc[a][b][m][n] = (f32x4){0.f, 0.f, 0.f, 0.f};
    bf16x8 At[4][2], B0[2][2], B1[2][2];
    const char* cA = (const char*)g.A + (size_t)cur.pm * tstep; const char* cB = (const char*)g.Bt + (size_t)cur.pn * tstep;
    S.a_ready(cur);
    if constexpr (SP2) {
        PG8_STAGE(PG8_SB(0, 0), cB, voffB); PG8_STAGE(PG8_SB(0, 1), cB + hstep, voffB); PG8_STAGE(PG8_SA(0, 0), cA, voffA); PG8_STAGE(PG8_SA(0, 1), cA + hstep, voffA);
        if (wr == 1) PG8_BAR;
        PG8_WAIT_V(2); PG8_BAR;
        PG8_STAGE(PG8_SB(1, 0), cB + kstep, voffB); PG8_STAGE(PG8_SA(1, 0), cA + kstep, voffA); PG8_STAGE(PG8_SB(1, 1), cB + hstep + kstep, voffB);
        PG8_WAIT_V(6); PG8_BAR;
    } else {
        PG8_STAGE(PG8_SB(0, 0), cB, voffB); PG8_STAGE(PG8_SA(0, 0), cA, voffA); PG8_STAGE(PG8_SB(0, 1), cB + hstep, voffB); PG8_STAGE(PG8_SA(0, 1), cA + hstep, voffA);
        if (wr == 1) PG8_BAR;
        PG8_WAIT_V(4); PG8_BAR;
        PG8_STAGE(PG8_SB(1, 0), cB + kstep, voffB); PG8_STAGE(PG8_SA(1, 0), cA + kstep, voffA); PG8_STAGE(PG8_SB(1, 1), cB + hstep + kstep, voffB);
        PG8_WAIT_V(6); PG8_BAR;
    }
    for (;;) {
        const bool has_next = S.next(ui + 1, nxt);
        const char* nA = has_next ? (const char*)g.A + (size_t)nxt.pm * tstep : cA; const char* nB = has_next ? (const char*)g.Bt + (size_t)nxt.pn * tstep : cB;
        for (int t = 0; t < nt; t += 2) {
            const bool last = (t == nt - 2);
            const char* a1 = cA + (size_t)(t + 1) * kstep;
            const char* a2 = last ? nA : cA + (size_t)(t + 2) * kstep; const char* b2 = last ? nB : cB + (size_t)(t + 2) * kstep;
            const char* a3 = a2 + kstep; const char* b3 = b2 + kstep;
            if (last && has_next) S.a_ready(nxt);
            if constexpr (SP2) {
            PG8_LDB(B0, 0, 0); PG8_LDB(B1, 0, 1); PG8_SCHED; PG8_LDA(At, 0, 0); PG8_STAGE(PG8_SA(1, 1), a1 + hstep, voffA);
            PG8_WAIT_V(8); PG8_WAIT_L(0); PG8_BAR; PG8_MMA(0, 0, At, B0); PG8_MMA(0, 1, At, B1); PG8_BAR; PG8_SCHED;
            PG8_LDA(At, 0, 1); PG8_STAGE(PG8_SB(0, 0), b2, voffB); PG8_STAGE(PG8_SB(0, 1), b2 + hstep, voffB); PG8_STAGE(PG8_SA(0, 0), a2, voffA);
            PG8_WAIT_V(8); PG8_WAIT_L(0); PG8_BAR; PG8_MMA(1, 0, At, B0); PG8_MMA(1, 1, At, B1); PG8_BAR; PG8_SCHED;
            PG8_LDB(B0, 1, 0); PG8_LDB(B1, 1, 1); PG8_SCHED; PG8_LDA(At, 1, 0); PG8_STAGE(PG8_SA(0, 1), a2 + hstep, voffA);
            PG8_WAIT_V(8); PG8_WAIT_L(0); PG8_BAR; PG8_MMA(0, 0, At, B0); PG8_MMA(0, 1, At, B1); PG8_BAR; PG8_SCHED;
            PG8_LDA(At, 1, 1); PG8_STAGE(PG8_SB(1, 0), b3, voffB); PG8_STAGE(PG8_SB(1, 1), b3 + hstep, voffB); PG8_STAGE(PG8_SA(1, 0), a3, voffA);
            PG8_WAIT_V(8); PG8_WAIT_L(0); PG8_BAR; PG8_MMA(1, 0, At, B0); PG8_MMA(1, 1, At, B1); PG8_BAR; PG8_SCHED;
            } else {
            PG8_LDB(B0, 0, 0); PG8_SCHED; PG8_LDA(At, 0, 0); PG8_STAGE(PG8_SA(1, 1), a1 + hstep, voffA);
            PG8_WAIT_L(8); PG8_BAR; PG8_WAIT_L(0); PG8_MMA(0, 0, At, B0); PG8_BAR; PG8_SCHED;
            PG8_LDB(B1, 0, 1); PG8_STAGE(PG8_SB(0, 0), b2, voffB);
            PG8_BAR; PG8_WAIT_L(0); PG8_MMA(0, 1, At, B1); PG8_BAR;
            PG8_LDA(At, 0, 1); PG8_STAGE(PG8_SA(0, 0), a2, voffA);
            PG8_BAR; PG8_WAIT_L(0); PG8_MMA(1, 0, At, B0); PG8_BAR; PG8_SCHED;
            PG8_STAGE(PG8_SB(0, 1), b2 + hstep, voffB);
            PG8_WAIT_V(6); PG8_BAR; PG8_MMA(1, 1, At, B1); PG8_BAR;
            PG8_LDB(B0, 1, 0); PG8_SCHED; PG8_LDA(At, 1, 0); PG8_STAGE(PG8_SA(0, 1), a2 + hstep, voffA);
            PG8_WAIT_L(8); PG8_BAR; PG8_WAIT_L(0); PG8_MMA(0, 0, At, B0); PG8_BAR; PG8_SCHED;
            PG8_LDB(B1, 1, 1); PG8_STAGE(PG8_SB(1, 0), b3, voffB);
            PG8_BAR; PG8_WAIT_L(0); PG8_MMA(0, 1, At, B1); PG8_BAR;
            PG8_LDA(At, 1, 1); PG8_STAGE(PG8_SA(1, 0), a3, voffA);
            PG8_BAR; PG8_WAIT_L(0); PG8_MMA(1, 0, At, B0); PG8_BAR; PG8_SCHED;
            PG8_STAGE(PG8_SB(1, 1), b3 + hstep, voffB);
            PG8_WAIT_V(6); PG8_BAR; PG8_MMA(1, 1, At, B1); PG8_BAR;
            }
        }
        if constexpr (ALIGN_EPI) { if (wr == 0) PG8_BAR; }
        if constexpr (!Epi::AFTER_DRAIN) { E(acc, cur, wr, wc, fr, fq); S.done(cur); }
        if (!has_next) break;
#pragma unroll
        for (int a = 0; a < 2; ++a)
#pragma unroll
            for (int b = 0; b < 2; ++b)
#pragma unroll
                for (int m = 0; m < 4; ++m)
#pragma unroll
                    for (int n = 0; n < 2; ++n) acc[a][b][m][n] = (f32x4){0.f, 0.f, 0.f, 0.f};
        cur = nxt; cA = nA; cB = nB; ++ui;
        if constexpr (ALIGN_EPI) { if (wr == 1) PG8_BAR; }
    }
    PG8_WAIT_V(0);
    if constexpr (!ALIGN_EPI) { if (wr == 0) PG8_BAR; }
    PG8_BAR;
    if constexpr (Epi::AFTER_DRAIN) { E.fused(acc, cur, wr, wc, fr, fq, lds, wid, lane); S.done(cur); }
#undef PG8_SA
#undef PG8_SB
#undef PG8_STAGE
#undef PG8_LDA
#undef PG8_LDB
#undef PG8_MMA
#undef PG8_WAIT_V
#undef PG8_WAIT_L
#undef PG8_BAR
#undef PG8_SCHED
}
}

#define XB_TMO      128
#define XB_XCNT(j)  (256  + 64 * (j))
#define XB_XSUB(j)  (1280 + 64 * (j))
#define XB_XGEN(j)  (2304 + 64 * (j))
#define XB_TOP      3328
#define XB_TOPGEN   3392
#define XCD_BAR_WORDS 3456
#define XB_SPIN_CAP (1u << 18)

__device__ __forceinline__ unsigned xb_ld(unsigned* p)              { return __hip_atomic_load(p, __ATOMIC_RELAXED, __HIP_MEMORY_SCOPE_AGENT); }
__device__ __forceinline__ unsigned xb_add(unsigned* p, unsigned v) { return __hip_atomic_fetch_add(p, v, __ATOMIC_RELAXED, __HIP_MEMORY_SCOPE_AGENT); }
__device__ __forceinline__ unsigned xb_xcc_id() { return (unsigned)__builtin_amdgcn_s_getreg((3 << 11) | 20) & 0xFu; }
#define XB_SPIN(cond, bar) do { unsigned _sp = 0; while (cond) { __builtin_amdgcn_s_sleep(1); \
    if ((++_sp & 255u) == 0u) { if (xb_ld(&(bar)[XB_TMO])) break; if (_sp > XB_SPIN_CAP) { atomicAdd(&(bar)[XB_TMO], 1u); break; } } } } while (0)

struct XcdBarrier {
    unsigned* bar; unsigned x;
    volatile LAS unsigned* st;
};

__device__ __forceinline__ XcdBarrier xcd_barrier_post(unsigned* bar, volatile LAS unsigned* st) {
    XcdBarrier b; b.bar = bar; b.x = xb_xcc_id(); b.st = st;
    if (threadIdx.x == 0) (void)xb_add(&bar[XB_XCNT(b.x)], 1u);
    return b;
}
__device__ __forceinline__ void xcd_barrier_complete(unsigned* bar, unsigned x, unsigned& nloc, unsigned& nx) {
    const unsigned G = gridDim.x * gridDim.y * gridDim.z;
    unsigned sum, cnt, mine, sp = 0u;
    for (;;) {
        sum = 0u; cnt = 0u; mine = 0u;
#pragma unroll
        for (unsigned j = 0; j < 16; ++j) { const unsigned c = xb_ld(&bar[XB_XCNT(j)]); sum += c; cnt += (c > 0u) ? 1u : 0u; }
        mine = xb_ld(&bar[XB_XCNT(x)]);
        if (sum == G) { mine = xb_ld(&bar[XB_XCNT(x)]); break; }
        __builtin_amdgcn_s_sleep(1);
        if ((++sp & 255u) == 0u) { if (xb_ld(&bar[XB_TMO])) break; if (sp > XB_SPIN_CAP) { atomicAdd(&bar[XB_TMO], 1u); break; } }
    }
    nloc = mine > 0u ? mine : 1u; nx = cnt > 0u ? cnt : 1u;
}

__device__ __forceinline__ void xcd_barrier(const XcdBarrier& b) {
    asm volatile("s_waitcnt vmcnt(0)" ::: "memory");
    __syncthreads();
    if (threadIdx.x == 0) {
        unsigned* bar = b.bar;
        __builtin_amdgcn_s_waitcnt(0);
        unsigned nloc = b.st[0], nx = b.st[1];
        if (nloc == 0u) { xcd_barrier_complete(bar, b.x, nloc, nx); b.st[0] = nloc; b.st[1] = nx; }
        const unsigned old = xb_add(&bar[XB_XSUB(b.x)], 1u);
        const unsigned gen = old / nloc;
        if (old + 1u == (gen + 1u) * nloc) {
            __builtin_amdgcn_fence(__ATOMIC_RELEASE, "agent");
            asm volatile("s_waitcnt vmcnt(0)" ::: "memory");
            const unsigned og = xb_add(&bar[XB_TOP], 1u);
            const unsigned tg = og / nx;
            if (og + 1u == (tg + 1u) * nx) xb_add(&bar[XB_TOPGEN], 1u);
            else XB_SPIN(xb_ld(&bar[XB_TOPGEN]) == tg, bar);
            __builtin_amdgcn_fence(__ATOMIC_ACQUIRE, "agent");
            xb_add(&bar[XB_XGEN(b.x)], 1u);
            asm volatile("s_waitcnt vmcnt(0)" ::: "memory");
        } else {
            XB_SPIN(xb_ld(&bar[XB_XGEN(b.x)]) == gen, bar);
            __builtin_amdgcn_fence(__ATOMIC_ACQUIRE, "agent");
            asm volatile("s_waitcnt vmcnt(0)" ::: "memory");
        }
    }
    __syncthreads();
}

constexpr int LDS_BYTES = 147456;
constexpr int LDS_MISC = 131072 + 320;
constexpr int CW_BAR = 4096;
__global__ void __launch_bounds__(512, 2) mega_fwd(Params p) {
    extern __shared__ __attribute__((aligned(16))) char lds[];
    volatile LAS unsigned* MISC = (volatile LAS unsigned*)((LAS char*)lds + LDS_MISC);
    for (int u = threadIdx.x; u < (LDS_BYTES - 131072) / 4; u += 512) ((LAS unsigned*)((LAS char*)lds + 131072))[u] = 0u;
    __syncthreads();
    PG8_LAS unsigned char* GL = (PG8_LAS unsigned char*)lds;
    XcdBarrier bar = xcd_barrier_post((unsigned*)(wsp(p) + WS_CTL) + CW_BAR, MISC + 8);
#define GRID_BAR() xcd_barrier(bar)
#define HN ((const bf16_t*)(wsp(p) + WS_HN))
#define O ((const bf16_t*)(wsp(p) + WS_O))
#define Wm ((const bf16_t*)(wsp(p) + WS_W) + (size_t)j * WE_MLA)
#define Wsw ((const bf16_t*)(wsp(p) + WS_W) + WE_SWA0 + (size_t)j * WE_SWA)
#define Wl ((const bf16_t*)(wsp(p) + WS_W) + WE_L0 + (size_t)i * WE_L)
    ph_tables(p); ph_convert_w(p, (float*)lds); ph_init_h(p);
    GRID_BAR();
    for (int i = 0; i < 4; ++i) {
        const int j = i >> 1;
        ph_rmsnorm_h<false>(p, inp(p, 8) + i * DM);
        GRID_BAR();
        if ((i & 1) == 0) {
            { pg8::Gemm g{HN, Wm + WO_IN, MR, 1280, DM}; pg8::StaticOrder S; S.init(MR, 1280, gridDim.x, lbid()); pg8::EpiStoreF32 E{(float*)(wsp(p) + WS_A32), NIN_MLA, NIN_MLA};
              pg8::gemm_phase<pg8::EpiStoreF32, pg8::StaticOrder, true, true>(GL, g, S, E); }
            GRID_BAR();
            ph_mla_norms(p, j);
            GRID_BAR();
            { pg8::Gemm g{(const bf16_t*)(wsp(p) + WS_CQ), Wm + WO_QUP, MR, NQUP, 512}; pg8::StaticOrder S; S.init(MR, NQUP, gridDim.x, lbid()); pg8::EpiStoreBf16 E{(bf16_t*)(wsp(p) + WS_Q), NQUP};
              pg8::gemm_phase<pg8::EpiStoreBf16, pg8::StaticOrder, true, true>(GL, g, S, E); }
            { pg8::Gemm g{(const bf16_t*)(wsp(p) + WS_LAT), Wm + WO_KVUP, NKVR, NKVUP, 512}; pg8::StaticOrder S; S.init(NKVR, NKVUP, gridDim.x, lbid()); pg8::EpiStoreBf16 E{(bf16_t*)(wsp(p) + WS_KV), NKVUP};
              pg8::gemm_phase<pg8::EpiStoreBf16, pg8::StaticOrder, true, true>(GL, g, S, E); }
            GRID_BAR();
            ph_mla_headnorm(p, j);
            GRID_BAR();
            ph_mla_attn(p, lds);
            GRID_BAR();
            { pg8::Gemm g{O, Wm + WO_MOUT, MR, DM, DM}; pg8::StaticOrder S; S.init(MR, DM, gridDim.x, lbid()); pg8::EpiResidF32 E{outp(p)};
              pg8::gemm_phase<pg8::EpiResidF32, pg8::StaticOrder, true, true>(GL, g, S, E); }
            GRID_BAR();
        } else {
            { pg8::Gemm g{HN, Wsw + WO_QKV, MR, NQKV, DM}; pg8::StaticOrder S; S.init(MR, NQKV, gridDim.x, lbid()); pg8::EpiStoreF32 E{(float*)(wsp(p) + WS_QKV32), NQKV, NQKV};
              pg8::gemm_phase<pg8::EpiStoreF32, pg8::StaticOrder, true, true>(GL, g, S, E); }
            GRID_BAR();
            ph_swa_prep(p, j);
            GRID_BAR();
            ph_swa_attn(p, j, lds);
            GRID_BAR();
            { pg8::Gemm g{O, Wsw + WO_SOUT, MR, DM, DM}; pg8::StaticOrder S; S.init(MR, DM, gridDim.x, lbid()); pg8::EpiResidF32 E{outp(p)};
              pg8::gemm_phase<pg8::EpiResidF32, pg8::StaticOrder, true, true>(GL, g, S, E); }
            GRID_BAR();
        }
        ph_rmsnorm_h<false>(p, inp(p, 24) + i * DM);
        GRID_BAR();
        { pg8::Gemm g{HN, Wl + WO_G, MR, 2 * DFF, DM}; pg8::StaticOrder S; S.init(MR, 2 * DFF, gridDim.x, lbid()); pg8::EpiSwigluBf16 E{(bf16_t*)(wsp(p) + WS_ACT), DFF};
          pg8::gemm_phase<pg8::EpiSwigluBf16, pg8::StaticOrder, true, true>(GL, g, S, E); }
        GRID_BAR();
        { pg8::Gemm g{(const bf16_t*)(wsp(p) + WS_ACT), Wl + WO_D, MR, DM, DFF}; pg8::StaticOrder S; S.init(MR, DM, gridDim.x, lbid()); pg8::EpiResidF32 E{outp(p)};
          pg8::gemm_phase<pg8::EpiResidF32, pg8::StaticOrder, true, true>(GL, g, S, E); }
        GRID_BAR();
        ph_rmsnorm_h<false>(p, inp(p, 28) + i * DM); ph_ple_prep(p, i);
        GRID_BAR();
        { pg8::Gemm g{(const bf16_t*)(wsp(p) + WS_PB), Wl + WO_PP, MR, DM, PLE}; pg8::StaticOrder S; S.init(MR, DM, gridDim.x, lbid()); pg8::EpiStoreF32 E{(float*)(wsp(p) + WS_T32), DM, DM};
          pg8::gemm_phase<pg8::EpiStoreF32, pg8::StaticOrder, true, true>(GL, g, S, E); }
        GRID_BAR();
        { pg8::Gemm g{HN, Wl + WO_PG, MR, DM, DM}; pg8::StaticOrder S; S.init(MR, DM, gridDim.x, lbid()); pg8::EpiPleF32 E{outp(p), (const float*)(wsp(p) + WS_T32)};
          pg8::gemm_phase<pg8::EpiPleF32, pg8::StaticOrder, true, true>(GL, g, S, E); }
        GRID_BAR();
    }
    ph_rmsnorm_h<true>(p, inp(p, 31));
#undef GRID_BAR
#undef HN
#undef O
#undef Wm
#undef Wsw
#undef Wl
}

__global__ void k_report(float* out, float v) { if (threadIdx.x == 0 && blockIdx.x == 0) out[0] = v; }

extern "C" void kernel_launch(void* const* d_in, const int* in_sizes, int n_in, void* d_out, int out_size, void* d_ws, size_t ws_size, hipStream_t stream) {
    if (n_in != 32 || (size_t)out_size != O_END || ws_size < WS_END) {
        fprintf(stderr, "kernel_launch: unexpected sizes n_in %d out %d ws %zu (need %zu)\n", n_in, out_size, ws_size, (size_t)WS_END);
        hipLaunchKernelGGL(k_report, dim3(1), dim3(64), 0, stream, (float*)d_out, (float)(ws_size >> 20));
        return;
    }
    Params p{};
    for (int k = 0; k < 32; ++k) p.in[k] = (const float*)d_in[k];
    p.out = (float*)d_out; p.ws = (unsigned char*)d_ws;
    static int grid = 0;
    if (grid == 0) {
        int dev = 0, cus = 0, per_cu = 0;
        if (hipGetDevice(&dev) != hipSuccess || hipDeviceGetAttribute(&cus, hipDeviceAttributeMultiprocessorCount, dev) != hipSuccess) { fprintf(stderr, "kernel_launch: device query failed\n"); grid = -1; return; }
        if (hipFuncSetAttribute((const void*)mega_fwd, hipFuncAttributeMaxDynamicSharedMemorySize, LDS_BYTES) != hipSuccess) { fprintf(stderr, "kernel_launch: hipFuncSetAttribute failed\n"); grid = -1; return; }
        if (hipOccupancyMaxActiveBlocksPerMultiprocessor(&per_cu, (const void*)mega_fwd, 512, LDS_BYTES) != hipSuccess || per_cu < 1) fprintf(stderr, "kernel_launch: occupancy query says %d\n", per_cu);
        (void)hipGetLastError();
        grid = cus;
    }
    if (grid < 0) return;
    (void)hipMemsetAsync((char*)d_ws + WS_CTL, 0, 1 * MiB, stream);
    hipLaunchKernelGGL(mega_fwd, dim3(grid), dim3(512), LDS_BYTES, stream, p);
}
```

```cpp
#include <hip/hip_runtime.h>
#include <cstdint>
#include <cstdio>

#define LAS __attribute__((address_space(3)))
typedef unsigned short bf16_t;
typedef short bf16x8 __attribute__((ext_vector_type(8)));
typedef short s16x4 __attribute__((ext_vector_type(4)));
typedef float f32x4 __attribute__((ext_vector_type(4)));
typedef float f32x16 __attribute__((ext_vector_type(16)));
typedef unsigned u32x4 __attribute__((ext_vector_type(4)));
typedef unsigned u32x2 __attribute__((ext_vector_type(2)));

__device__ __forceinline__ int ltid(int wv) { int t = (wv << 6) | (int)__builtin_amdgcn_mbcnt_hi(~0u, __builtin_amdgcn_mbcnt_lo(~0u, 0u)); asm volatile("" : "+v"(t)); return t; }

constexpr int DM = 2048, SEQ = 4096, NPR = 4 * SEQ  , NSR = 256  , MR = NPR + NSR  ;
constexpr int PAST = 1024, DSEQ = 16, DBATCH = 16;
constexpr int KVPB = PAST + DSEQ;
constexpr int NKVR = NPR + DBATCH * KVPB;
constexpr int SWPB = 128 + DSEQ;
constexpr int NSKR = NPR + DBATCH * SWPB;
constexpr int DFF = 5632, PLE = 256;
constexpr int NIN_MLA = 1088, NQUP = 3072, NKVUP = 4096, NQKV = 2560;
constexpr float EPS = 1e-6f;
constexpr float LOG2E = 1.4426950408889634f;

constexpr size_t O_Y = 0;
constexpr size_t O_LATP = (size_t)MR * DM;
constexpr size_t O_KRP = O_LATP + (size_t)2 * NPR * 512;
constexpr size_t O_SKP = O_KRP + (size_t)2 * NPR * 64;
constexpr size_t O_SVP = O_SKP + (size_t)2 * 4 * 128 * 256;
constexpr size_t O_LATS = O_SVP + (size_t)2 * 4 * 128 * 256;
constexpr size_t O_KRS = O_LATS + (size_t)2 * NSR * 512;
constexpr size_t O_SKS = O_KRS + (size_t)2 * NSR * 64;
constexpr size_t O_SVS = O_SKS + (size_t)2 * 16 * 128 * 256;
constexpr size_t O_END = O_SVS + (size_t)2 * 16 * 128 * 256;
static_assert(O_END == 55869440, "output size");

constexpr size_t MiB = 1u << 20;
constexpr size_t al256(size_t x) { return (x + 255) & ~(size_t)255; }
constexpr size_t WS_CTL = 0, CTL_BYTES = 3 * MiB;
typedef unsigned long long ssq_t;
constexpr size_t WS_SSQ = 65536;
constexpr size_t WS_SSQQ = 2 * MiB, WS_SSQKV = WS_SSQQ + 2 * (size_t)MR * 8;
static_assert(WS_SSQ + 13 * (size_t)MR * 8 <= WS_SSQQ && WS_SSQKV + 2 * (size_t)MR * 8 <= CTL_BYTES, "ctl");
constexpr size_t WS_TABM = 3 * MiB, WS_TABS = 4 * MiB, WS_W = 5 * MiB;
constexpr size_t WO_IN = 0, WO_QUP = 2621440, WO_KVP = 4194304, WO_KVF = 6291456, WO_MOUT = 8388608, WE_MLA = 12582912;
constexpr size_t WO_QKV = 0, WO_SOUT = 5242880, WE_SWA = 9437184;
constexpr size_t WO_G = 0, WO_D = 23068672, WO_PG = 34603008, WO_PP = 38797312, WE_L = 39321600;
constexpr size_t WE_SWA0 = 2 * WE_MLA, WE_L0 = WE_SWA0 + 2 * WE_SWA, WE_END = WE_L0 + 4 * WE_L;
static_assert(WE_END == 201326592, "weights");
constexpr size_t WS_LATC = WS_W + WE_END * 2;
constexpr size_t WS_KRB = WS_LATC + 2 * (size_t)16384 * 512 * 2;
constexpr size_t KRB_STRIDE = al256((size_t)NKVR * 64 * 2);
constexpr size_t WS_SKB = WS_KRB + 2 * KRB_STRIDE;
constexpr size_t SKB_STRIDE = al256((size_t)NSKR * 256 * 2);
constexpr size_t WS_SVB = WS_SKB + 2 * SKB_STRIDE;
constexpr size_t HB_BYTES = (size_t)MR * DM * 2;
constexpr size_t WS_HB0 = al256(WS_SVB + 2 * SKB_STRIDE), WS_HB1 = WS_HB0 + HB_BYTES;
constexpr size_t WS_R = WS_HB1 + HB_BYTES;
constexpr size_t WS_CQ = WS_R, WS_CKV = WS_CQ + (size_t)MR * 512 * 2, WS_Q = WS_CKV + (size_t)MR * 512 * 2, WS_KV = WS_Q + (size_t)MR * NQUP * 2;
constexpr size_t WS_SQ = WS_R;
constexpr size_t WS_ACT = WS_R, WS_T32 = WS_ACT + (size_t)MR * DFF * 2, WS_PB = WS_T32 + (size_t)MR * DM * 4;
constexpr size_t WS_END = WS_KV + (size_t)NKVR * 4096 * 2;
static_assert(WS_PB + (size_t)MR * PLE * 2 <= WS_END, "ffn overlay");
static_assert(WS_END <= 984 * MiB, "ws budget (984 MiB was seen to be available)");
__device__ __forceinline__ float ssq_val(const ssq_t* q, size_t i) { return (float)((const __attribute__((address_space(1))) ssq_t*)q)[i] * (1.0f / 4096.0f); }
__device__ __forceinline__ void ssq_add(ssq_t* q, size_t i, float ss) { __hip_atomic_fetch_add((__attribute__((address_space(1))) ssq_t*)(q + i), (ssq_t)(ss * 4096.0f + 0.5f), __ATOMIC_RELAXED, __HIP_MEMORY_SCOPE_AGENT); }

struct Params {
    const float* in[32];
    float* out;
    unsigned char* ws;
};
__device__ __forceinline__ int opaque_i(int k) { asm volatile("" : "+v"(k)); return __builtin_amdgcn_readfirstlane(k); }
__device__ __forceinline__ int lbid() { int b = (int)blockIdx.x; asm volatile("" : "+s"(b)); return b; }
__device__ __forceinline__ const float* inp(const Params& p, int k) { return p.in[opaque_i(k)]; }
__device__ __forceinline__ unsigned long long opaque_u64(unsigned long long a) { unsigned lo = (unsigned)a, hi = (unsigned)(a >> 32); asm volatile("" : "+v"(lo), "+v"(hi));
    lo = __builtin_amdgcn_readfirstlane(lo); hi = __builtin_amdgcn_readfirstlane(hi); return ((unsigned long long)hi << 32) | lo; }
__device__ __forceinline__ unsigned char* wsp(const Params& p) { return (unsigned char*)opaque_u64((unsigned long long)p.ws); }
__device__ __forceinline__ float* outp(const Params& p) { return (float*)opaque_u64((unsigned long long)p.out); }

__device__ __forceinline__ float bf2f(bf16_t b) { return __uint_as_float(((unsigned)b) << 16); }
__device__ __forceinline__ unsigned f2bf(float f) { unsigned u = __float_as_uint(f); return (u + 0x7fffu + ((u >> 16) & 1u)) >> 16; }
__device__ __forceinline__ unsigned pk2(float lo, float hi) { return f2bf(lo) | (f2bf(hi) << 16); }
__device__ __forceinline__ float wave_sum(float v) {
#pragma unroll
    for (int o = 1; o < 64; o <<= 1) v += __shfl_xor(v, o);
    return v;
}
__device__ __forceinline__ int crow(int r, int hi) { return (r & 3) + 8 * (r >> 2) + 4 * hi; }
__device__ __forceinline__ int pos_of_row(int m) { return m < NPR ? (m & (SEQ - 1)) : PAST + ((m - NPR) & (DSEQ - 1)); }
__device__ __forceinline__ int latrow_of(int m) { return m < NPR ? m : NPR + ((m - NPR) >> 4) * KVPB + PAST + ((m - NPR) & 15); }
__device__ __forceinline__ int skrow_of(int m) { return m < NPR ? m : NPR + ((m - NPR) >> 4) * SWPB + 128 + ((m - NPR) & 15); }

typedef __attribute__((address_space(1))) float PG8_GASF; typedef __attribute__((address_space(1))) u32x4 PG8_GASU4;
__device__ __forceinline__ void ph_tables(const Params& p, int wv) {
    const int tix = ltid(wv);
    float* tm = (float*)(wsp(p) + WS_TABM); float* ts = (float*)(wsp(p) + WS_TABS);
    const int gt = lbid() * 512 + tix, ngt = gridDim.x * 512;
    for (int idx = gt; idx < 4096 * 32; idx += ngt) {
        const int pos = idx >> 5, i = idx & 31;
        const float inv = powf(10000.0f, -(float)i / 32.0f);
        const float ang = (float)pos * inv;
        tm[idx * 2] = cosf(ang); tm[idx * 2 + 1] = sinf(ang);
    }
    for (int idx = gt; idx < 4096 * 8; idx += ngt) {
        const int pos = idx >> 3, i = idx & 7;
        const float inv = powf(500000.0f, -(float)i / 8.0f);
        const float ang = (float)pos * inv;
        ts[idx * 2] = cosf(ang); ts[idx * 2 + 1] = sinf(ang);
    }
}

__device__ __forceinline__ int swa_dim(int bj, int i) { const int g = i >> 3, e = i & 7; return e < 2 ? 8 * bj + 2 * g + e : 16 + 24 * bj + 6 * g + (e - 2); }
struct WDesc { const float* src; const float* src2; bf16_t* dst; const float* gain; int K, Nsrc, Ndst, mode; };
__device__ __forceinline__ int wsrc_col(int mode, int r, bool& second) {
    second = false;
    if (mode == 1) { const int t = r >> 8, w = r & 255; second = w >= 128; return 128 * t + (w & 127); }
    if (mode == 3) { if (r < 1024) return r; const int w = r - 1024; return 1024 + 32 * ((w >> 7) & 1) + (w & 31); }
    if (mode == 4) { if (r < 2048) return (r >> 7) * 192 + (r & 127);
        const int w = r - 2048, t = w >> 8, bj = (w >> 7) & 1, wc = (w >> 5) & 3, i = w & 31; return (4 * t + wc) * 192 + 128 + 32 * bj + i; }
    if (mode == 5) { if (r >= 2304) return r;
        const int t = r >> 8, bj = (r >> 7) & 1, wc = (r >> 5) & 3, i = r & 31; return (t < 8 ? (4 * t + wc) * 64 : 2048 + wc * 64) + swa_dim(bj, i); }
    return r;
}
__device__ __forceinline__ WDesc wdesc(const Params& p, int idx) {
    bf16_t* W = (bf16_t*)(wsp(p) + WS_W); WDesc d; d.mode = 0; d.gain = nullptr; d.src2 = nullptr;
    if (idx < 10) { const int j = idx / 5, k = idx % 5; bf16_t* b = W + (size_t)j * WE_MLA;
        if (k == 0) { d.src = inp(p, 9) + (size_t)j * 2048 * NIN_MLA; d.dst = b + WO_IN; d.K = 2048; d.Nsrc = NIN_MLA; d.Ndst = 1280; d.mode = 3; d.gain = inp(p, 8) + (2 * j) * DM; }
        else if (k == 1) { d.src = inp(p, 11) + (size_t)j * 512 * NQUP; d.dst = b + WO_QUP; d.K = 512; d.Nsrc = NQUP; d.Ndst = NQUP; d.mode = 4; d.gain = inp(p, 10) + j * 512; }
        else if (k == 2) { d.src = inp(p, 13) + (size_t)j * 512 * NKVUP; d.dst = b + WO_KVP; d.K = 512; d.Nsrc = NKVUP; d.Ndst = NKVUP; }
        else if (k == 3) { d.src = inp(p, 13) + (size_t)j * 512 * NKVUP; d.dst = b + WO_KVF; d.K = 512; d.Nsrc = NKVUP; d.Ndst = NKVUP; d.gain = inp(p, 12) + j * 512; }
        else { d.src = inp(p, 18) + (size_t)j * 2048 * 2048; d.dst = b + WO_MOUT; d.K = 2048; d.Nsrc = 2048; d.Ndst = 2048; }
    } else if (idx < 14) { const int j = (idx - 10) >> 1, k = (idx - 10) & 1; bf16_t* b = W + WE_SWA0 + (size_t)j * WE_SWA;
        if (k == 0) { d.src = inp(p, 19) + (size_t)j * 2048 * NQKV; d.dst = b + WO_QKV; d.K = 2048; d.Nsrc = NQKV; d.Ndst = NQKV; d.mode = 5; d.gain = inp(p, 8) + (2 * j + 1) * DM; }
        else { d.src = inp(p, 23) + (size_t)j * 2048 * 2048; d.dst = b + WO_SOUT; d.K = 2048; d.Nsrc = 2048; d.Ndst = 2048; }
    } else { const int i = (idx - 14) >> 2, k = (idx - 14) & 3; bf16_t* b = W + WE_L0 + (size_t)i * WE_L;
        if (k == 0) { d.src = inp(p, 25) + (size_t)i * 2048 * DFF; d.src2 = inp(p, 26) + (size_t)i * 2048 * DFF; d.dst = b + WO_G; d.K = 2048; d.Nsrc = DFF; d.Ndst = 2 * DFF; d.mode = 1; d.gain = inp(p, 24) + i * DM; }
        else if (k == 1) { d.src = inp(p, 27) + (size_t)i * DFF * 2048; d.dst = b + WO_D; d.K = DFF; d.Nsrc = 2048; d.Ndst = 2048; }
        else if (k == 2) { d.src = inp(p, 29) + (size_t)i * 2048 * 2048; d.dst = b + WO_PG; d.K = 2048; d.Nsrc = 2048; d.Ndst = 2048; d.gain = inp(p, 28) + i * DM; }
        else { d.src = inp(p, 30) + (size_t)i * PLE * 2048; d.dst = b + WO_PP; d.K = PLE; d.Nsrc = 2048; d.Ndst = 2048; }
    }
    return d;
}
__device__ __forceinline__ void ph_convert_w(const Params& p, int wv, char* lds) {
    const int tid = ltid(wv), lane = tid & 63, wq = tid >> 6;
    LAS float* tile0 = (LAS float*)lds; int par = 0;
    const int G = (int)gridDim.x;
    float v[32], vn[32];
    int wn = 0, basen = 0; WDesc dn = wdesc(p, 0); int tnn = dn.Ndst / 64, ntn = tnn * (dn.K / 256);
#define CW_SEEK(T_) do { while (wn < 29 && (T_) >= basen + ntn) { basen += ntn; ++wn; dn = wdesc(p, wn); tnn = dn.Ndst / 64; ntn = tnn * (dn.K / 256); } } while (0)
#define CW_LOAD(dstv, t_) do { const int k0_ = ((t_) / tnn) * 256, n0_ = ((t_) % tnn) * 64; bool second_; const int sc_ = wsrc_col(dn.mode, n0_ + lane, second_); \
        const PG8_GASF* s_ = (const PG8_GASF*)(second_ ? dn.src2 : dn.src) + (size_t)k0_ * dn.Nsrc + sc_; \
        _Pragma("unroll") for (int i = 0; i < 32; ++i) dstv[i] = s_[(size_t)(wq + 8 * i) * dn.Nsrc]; } while (0)
    int ntot = 0;
    for (int w = 0; w < 30; ++w) { const WDesc t_ = wdesc(p, w); ntot += (t_.Ndst / 64) * (t_.K / 256); }
    int T = lbid();
    if (T < ntot) { CW_SEEK(T); CW_LOAD(vn, T - basen); }
    for (; T < ntot; T += G) {
        const WDesc d = dn; const int tn = tnn, tl = T - basen;
        const int k0 = (tl / tn) * 256, n0 = (tl % tn) * 64;
#pragma unroll
        for (int i = 0; i < 32; ++i) v[i] = vn[i];
        const int Tn = T + G;
        if (Tn < ntot) { CW_SEEK(Tn); CW_LOAD(vn, Tn - basen); }
        __builtin_amdgcn_sched_barrier(0);
        if (d.gain) {
#pragma unroll
            for (int i = 0; i < 32; ++i) v[i] *= ((const PG8_GASF*)d.gain)[k0 + wq + 8 * i];
        }
        LAS float* tile = tile0 + par * (256 * 65); par ^= 1;
#pragma unroll
        for (int i = 0; i < 32; ++i) tile[(wq + 8 * i) * 65 + lane] = v[i];
        __syncthreads();
#pragma unroll
        for (int q = 0; q < 4; ++q) { const int n = (tid >> 5) + 16 * q, k8 = (tid & 31) * 8; const LAS float* sp = tile + k8 * 65 + n;
            u32x4 o; o.x = pk2(sp[0], sp[65]); o.y = pk2(sp[2 * 65], sp[3 * 65]); o.z = pk2(sp[4 * 65], sp[5 * 65]); o.w = pk2(sp[6 * 65], sp[7 * 65]);
            *(PG8_GASU4*)(d.dst + (size_t)(n0 + n) * d.K + k0 + k8) = o; }
    }
#undef CW_LOAD
#undef CW_SEEK
}

__device__ __forceinline__ void ph_init_h(const Params& p, int wv) {
    const int tix = ltid(wv);
    bf16_t* hb = (bf16_t*)(wsp(p) + WS_HB0); ssq_t* ssq = (ssq_t*)(wsp(p) + WS_SSQ);
    const float* xp = inp(p, 0); const float* xs = inp(p, 1);
    const int lane = tix & 63, gw = lbid() * 8 + (tix >> 6), ngw = gridDim.x * 8;
    for (int m = gw; m < MR; m += ngw) {
        const f32x4* xr = (const f32x4*)(m < NPR ? xp + (size_t)m * DM : xs + (size_t)(m - NPR) * DM); float ss = 0.f;
        f32x4 v[8];
#pragma unroll
        for (int j = 0; j < 8; ++j) v[j] = xr[j * 64 + lane];
#pragma unroll
        for (int j = 0; j < 8; ++j) { ss += v[j].x * v[j].x + v[j].y * v[j].y + v[j].z * v[j].z + v[j].w * v[j].w;
            u32x2 o; o.x = pk2(v[j].x, v[j].y); o.y = pk2(v[j].z, v[j].w); *(u32x2*)(hb + (size_t)m * DM + (j * 64 + lane) * 4) = o; }
        ss = wave_sum(ss); if (lane == 0) ssq[m] = (ssq_t)(ss * 4096.0f + 0.5f);
    }
}

__device__ __forceinline__ void ph_caches(const Params& p, int wv) {
    const int tix = ltid(wv); const size_t gt = (size_t)lbid() * 512 + tix, ngt = (size_t)gridDim.x * 512;
    { const f32x4* src = (const f32x4*)inp(p, 4); bf16_t* dst = (bf16_t*)(wsp(p) + WS_LATC); const size_t n4 = (size_t)2 * 16384 * 512 / 4;
      for (size_t k = gt; k < n4; k += ngt) { const f32x4 v = src[k]; u32x2 o; o.x = pk2(v.x, v.y); o.y = pk2(v.z, v.w); *(u32x2*)(dst + k * 4) = o; } }
    { const f32x4* src = (const f32x4*)inp(p, 5); const size_t n4 = (size_t)2 * 16384 * 64 / 4;
      for (size_t k = gt; k < n4; k += ngt) { const f32x4 v = src[k]; const int c4 = (int)(k & 15), r = (int)((k >> 4) & 16383), j = (int)(k >> 18), b = r >> 10, t = r & 1023;
          bf16_t* dst = (bf16_t*)(wsp(p) + WS_KRB + (size_t)j * KRB_STRIDE) + ((size_t)NPR + b * KVPB + t) * 64 + c4 * 4;
          u32x2 o; o.x = pk2(v.x, v.y); o.y = pk2(v.z, v.w); *(u32x2*)dst = o; } }
    { const float* sk = inp(p, 6); const float* sv = inp(p, 7); float* out = outp(p); const size_t n = (size_t)2 * 16 * 128 * 256;
      for (size_t k = gt; k < n; k += ngt) { const int c = (int)(k & 255), i = (int)((k >> 8) & 127), b = (int)((k >> 15) & 15), j = (int)(k >> 19);
          const int g = c >> 6, w = c & 63, d = swa_dim(w >> 5, w & 31);
          const size_t row = ((size_t)j * 16 + b) * 128 + i; const float kx = sk[row * 256 + g * 64 + d], vx = sv[row * 256 + c], kt = sk[row * 256 + c];
          const size_t dr = (size_t)NPR + b * SWPB + i;
          ((bf16_t*)(wsp(p) + WS_SKB + (size_t)j * SKB_STRIDE))[dr * 256 + c] = (bf16_t)f2bf(kx);
          ((bf16_t*)(wsp(p) + WS_SVB + (size_t)j * SKB_STRIDE))[dr * 256 + c] = (bf16_t)f2bf(vx);
          if (i >= 16) { const size_t o = (((size_t)j * 16 + b) * 128 + (i - 16)) * 256 + c; out[O_SKS + o] = kt; out[O_SVS + o] = vx; } } }
}

__device__ __forceinline__ void ph_final(const Params& p, int wv) {
    const int tix = ltid(wv);
    float* y = outp(p); const bf16_t* hb = (const bf16_t*)(wsp(p) + WS_HB0); const ssq_t* ssq = (const ssq_t*)(wsp(p) + WS_SSQ) + 12 * MR; const float* g = inp(p, 31);
    const int lane = tix & 63, gw = lbid() * 8 + (tix >> 6), ngw = gridDim.x * 8;
    for (int m = gw; m < MR; m += ngw) {
        const float rstd = rsqrtf(ssq_val(ssq, m) * (1.0f / DM) + EPS); u32x4 v[4];
#pragma unroll
        for (int j = 0; j < 4; ++j) v[j] = *(const u32x4*)(hb + (size_t)m * DM + (j * 64 + lane) * 8);
#pragma unroll
        for (int j = 0; j < 4; ++j) { const int c = (j * 64 + lane) * 8; const f32x4 g0 = *(const f32x4*)(g + c), g1 = *(const f32x4*)(g + c + 4); f32x4 a, b;
            a[0] = __uint_as_float(v[j].x << 16); a[1] = __uint_as_float(v[j].x & 0xffff0000u); a[2] = __uint_as_float(v[j].y << 16); a[3] = __uint_as_float(v[j].y & 0xffff0000u);
            b[0] = __uint_as_float(v[j].z << 16); b[1] = __uint_as_float(v[j].z & 0xffff0000u); b[2] = __uint_as_float(v[j].w << 16); b[3] = __uint_as_float(v[j].w & 0xffff0000u);
            *(f32x4*)(y + (size_t)m * DM + c) = a * rstd * g0; *(f32x4*)(y + (size_t)m * DM + c + 4) = b * rstd * g1; }
    }
}

__device__ __forceinline__ void ph_lat_fix(const Params& p, int wv, int j, int c, int n  ) {
    const int tix = ltid(wv); const int lane = tix & 63, gw = c * 8 + (tix >> 6), ngw = n * 8;
    const ssq_t* ssq = (const ssq_t*)(wsp(p) + WS_SSQKV) + (size_t)j * MR; const float* g = inp(p, 12) + j * 512; float* out = outp(p);
    const f32x4 g0 = ((const f32x4*)g)[lane], g1 = ((const f32x4*)g)[64 + lane];
    for (int m = gw; m < MR; m += ngw) {
        f32x4* r = (f32x4*)(m < NPR ? out + O_LATP + ((size_t)j * NPR + m) * 512 : out + O_LATS + ((size_t)j * NSR + (m - NPR)) * 512);
        const float rs = rsqrtf(ssq_val(ssq, m) * (1.0f / 512) + EPS);
        const f32x4 a = r[lane], b = r[64 + lane]; r[lane] = a * rs * g0; r[64 + lane] = b * rs * g1;
    }
}

__device__ __forceinline__ void ph_ple_prep(const Params& p, int wv, int i) {
    const int tix = ltid(wv);
    bf16_t* PB = (bf16_t*)(wsp(p) + WS_PB);
    const f32x4* pp = (const f32x4*)(inp(p, 2) + (size_t)i * NPR * PLE); const f32x4* ps = (const f32x4*)(inp(p, 3) + (size_t)i * NSR * PLE);
    const size_t np4 = (size_t)NPR * PLE / 4, ns4 = (size_t)NSR * PLE / 4;
    const size_t gt = (size_t)lbid() * 512 + tix, ngt = (size_t)gridDim.x * 512;
    for (size_t k = gt; k < np4 + ns4; k += ngt) { const f32x4 v = k < np4 ? pp[k] : ps[k - np4]; u32x2 o; o.x = pk2(v.x, v.y); o.y = pk2(v.z, v.w); *(u32x2*)(PB + k * 4) = o; }
}

#define SBAR() __builtin_amdgcn_sched_barrier(0)
__device__ __forceinline__ unsigned cvtpk(float lo, float hi) { unsigned r; asm volatile("v_cvt_pk_bf16_f32 %0, %1, %2" : "=v"(r) : "v"(lo), "v"(hi)); return r; }
#define PK4(P, BASE, OUT) do { unsigned a0_ = cvtpk(P[BASE + 0], P[BASE + 1]), a1_ = cvtpk(P[BASE + 2], P[BASE + 3]);   \
    unsigned b0_ = cvtpk(P[BASE + 4], P[BASE + 5]), b1_ = cvtpk(P[BASE + 6], P[BASE + 7]);                              \
    auto r0_ = __builtin_amdgcn_permlane32_swap(a0_, b0_, false, false); auto r1_ = __builtin_amdgcn_permlane32_swap(a1_, b1_, false, false); \
    u32x4 w_ = {r0_[0], r1_[0], r0_[1], r1_[1]}; OUT = *reinterpret_cast<bf16x8*>(&w_); } while (0)
__device__ __forceinline__ float half_swap_max(float v) { auto rr = __builtin_amdgcn_permlane32_swap(__float_as_uint(v), __float_as_uint(v), false, false); return fmaxf(__uint_as_float(rr[0]), __uint_as_float(rr[1])); }
__device__ __forceinline__ float half_swap_sum(float v) { auto rr = __builtin_amdgcn_permlane32_swap(__float_as_uint(v), __float_as_uint(v), false, false); return __uint_as_float(rr[0]) + __uint_as_float(rr[1]); }
template <int NC> __device__ __forceinline__ int v_st(int k, int c) { const int kk = (k & ~0xC) | ((k & 4) << 1) | ((k & 8) >> 1); return ((kk >> 3) * (NC / 32) + (c >> 5)) * 512 + ((kk & 7) * 32 + (c & 31)) * 2; }
__device__ __forceinline__ int v_rd_base(int lane) { return ((lane & 3) << 3) | (((lane >> 2) & 3) << 6) | (((lane >> 4) & 1) << 5) | (((lane >> 5) & 1) << 8); }
template <int NC> constexpr int v_rd_off(int d0, int ks, int half) { return d0 * 512 + ks * (NC / 32) * 1024 + half * (NC / 32) * 512; }
template <int OFF> __device__ __forceinline__ s16x4 tr_read(int vb) { s16x4 r; asm volatile("ds_read_b64_tr_b16 %0, %1 offset:%2" : "=&v"(r) : "v"(vb), "i"(OFF) : "memory"); return r; }
#define PKV(L, H) (bf16x8){L[0], L[1], L[2], L[3], H[0], H[1], H[2], H[3]}
template <int NC, int D0> __device__ __forceinline__ void pv_one(f32x16& od, int vb, bf16x8 pa0, bf16x8 pa1, bf16x8 pa2, bf16x8 pa3) {
    const s16x4 l0 = tr_read<v_rd_off<NC>(D0, 0, 0)>(vb), h0 = tr_read<v_rd_off<NC>(D0, 0, 1)>(vb), l1 = tr_read<v_rd_off<NC>(D0, 1, 0)>(vb), h1 = tr_read<v_rd_off<NC>(D0, 1, 1)>(vb);
    const s16x4 l2 = tr_read<v_rd_off<NC>(D0, 2, 0)>(vb), h2 = tr_read<v_rd_off<NC>(D0, 2, 1)>(vb), l3 = tr_read<v_rd_off<NC>(D0, 3, 0)>(vb), h3 = tr_read<v_rd_off<NC>(D0, 3, 1)>(vb);
    asm volatile("s_waitcnt lgkmcnt(0)" ::: "memory"); SBAR();
    od = __builtin_amdgcn_mfma_f32_32x32x16_bf16(pa0, PKV(l0, h0), od, 0, 0, 0);
    od = __builtin_amdgcn_mfma_f32_32x32x16_bf16(pa1, PKV(l1, h1), od, 0, 0, 0);
    od = __builtin_amdgcn_mfma_f32_32x32x16_bf16(pa2, PKV(l2, h2), od, 0, 0, 0);
    od = __builtin_amdgcn_mfma_f32_32x32x16_bf16(pa3, PKV(l3, h3), od, 0, 0, 0);
}
#define TRD8(v, NC, D0, vb) do { v[0] = tr_read<v_rd_off<NC>(D0, 0, 0)>(vb); v[1] = tr_read<v_rd_off<NC>(D0, 0, 1)>(vb); v[2] = tr_read<v_rd_off<NC>(D0, 1, 0)>(vb); v[3] = tr_read<v_rd_off<NC>(D0, 1, 1)>(vb); \
        v[4] = tr_read<v_rd_off<NC>(D0, 2, 0)>(vb); v[5] = tr_read<v_rd_off<NC>(D0, 2, 1)>(vb); v[6] = tr_read<v_rd_off<NC>(D0, 3, 0)>(vb); v[7] = tr_read<v_rd_off<NC>(D0, 3, 1)>(vb); } while (0)
#define PVM4(od, v) do { od = __builtin_amdgcn_mfma_f32_32x32x16_bf16(pa0, PKV(v[0], v[1]), od, 0, 0, 0); od = __builtin_amdgcn_mfma_f32_32x32x16_bf16(pa1, PKV(v[2], v[3]), od, 0, 0, 0); \
        od = __builtin_amdgcn_mfma_f32_32x32x16_bf16(pa2, PKV(v[4], v[5]), od, 0, 0, 0); od = __builtin_amdgcn_mfma_f32_32x32x16_bf16(pa3, PKV(v[6], v[7]), od, 0, 0, 0); } while (0)
#define LGKM_WAIT(n) do { asm volatile("s_waitcnt lgkmcnt(" #n ")" ::: "memory"); SBAR(); } while (0)
#define KSWZ256(row, colB) ((row) * 256 + ((colB) ^ (((row) & 7) << 4)))
#define KSWZ128(row, colB) ((row) * 128 + ((colB) ^ (((row) & 7) << 4)))

constexpr int MLA_V = 0, MLA_K = 32768, MLA_KR = 65536, MLA_WS = 81920, MLA_LDS = 83968;
constexpr float MLA_C = 0.07216878364870322f * LOG2E;
__device__ __forceinline__ void mla_attn_unit(int wv, const bf16_t* Qh, int nq, const bf16_t* KVh, const bf16_t* KRb, int nkeys, int NT, int my_nt, bf16_t* Oh, char* lds) {
    const int tid = ltid(wv);
    const int wid = __builtin_amdgcn_readfirstlane(tid >> 6), lane = tid & 63, r32 = lane & 31, hi = lane >> 5;
    LAS char* L = (LAS char*)lds;
    LAS float* wsf = (LAS float*)(L + MLA_WS) + wid * 64;
    bf16x8 qr[12];
    { int qrow = wid * 32 + r32; if (qrow > nq - 1) qrow = nq - 1; const bf16_t* qp = Qh + (size_t)qrow * NQUP + hi * 8;
#pragma unroll
      for (int d0 = 0; d0 < 12; ++d0) qr[d0] = *(const bf16x8*)(qp + d0 * 16); }
    int kq[4];
#pragma unroll
    for (int q = 0; q < 4; ++q) kq[q] = ((q * 32 + hi * 16) ^ ((r32 & 7) << 4));
    const int krow256 = r32 * 256, krow128 = r32 * 128;
    const int sr = tid >> 4, sc = (tid & 15) * 8, vst0 = v_st<128>(sr, sc), vst1 = v_st<128>(32 + sr, sc);
    const int kst0 = KSWZ256(sr, sc * 2), kst1 = KSWZ256(32 + sr, sc * 2);
    const int krr = tid >> 3, krc = (tid & 7) * 8, krst = KSWZ128(krr, krc * 2);
    const int vb0 = (int)(uintptr_t)(lds + MLA_V) + v_rd_base(lane);
    typedef __attribute__((address_space(1))) bf16x8 gbf8_t;
    bf16x8 sk0, sk1, sv0, sv1, skr;
#define MLA_LOAD(t) do { int ra = (t) * 64 + sr, rb = ra + 32, rc = (t) * 64 + krr; if (ra > nkeys - 1) ra = nkeys - 1; if (rb > nkeys - 1) rb = nkeys - 1; if (rc > nkeys - 1) rc = nkeys - 1; \
        sk0 = *(const gbf8_t*)(KVh + (size_t)ra * NKVUP + sc); sk1 = *(const gbf8_t*)(KVh + (size_t)rb * NKVUP + sc); \
        sv0 = *(const gbf8_t*)(KVh + (size_t)ra * NKVUP + 128 + sc); sv1 = *(const gbf8_t*)(KVh + (size_t)rb * NKVUP + 128 + sc); \
        skr = *(const gbf8_t*)(KRb + (size_t)rc * 64 + krc); } while (0)
#define MLA_WRITE(b) do { \
        *(LAS bf16x8*)(L + MLA_V + (b) * 16384 + vst0) = sv0; *(LAS bf16x8*)(L + MLA_V + (b) * 16384 + vst1) = sv1; \
        *(LAS bf16x8*)(L + MLA_K + (b) * 16384 + kst0) = sk0; *(LAS bf16x8*)(L + MLA_K + (b) * 16384 + kst1) = sk1; \
        *(LAS bf16x8*)(L + MLA_KR + (b) * 8192 + krst) = skr; } while (0)
    float m_reg = -1e30f, l_reg = 0.f; f32x16 o[4] = {};
    MLA_LOAD(0); MLA_WRITE(0); __syncthreads();
    for (int j = 0; j < NT; ++j) {
        const int b = j & 1;
        if (j + 1 < NT) MLA_LOAD(j + 1);
        SBAR();
        if (j < my_nt) {
            f32x16 p0 = {}, p1 = {};
            const LAS char* Kb = L + MLA_K + b * 16384 + krow256; const LAS char* KRp = L + MLA_KR + b * 8192 + krow128;
            {
                bf16x8 kk[12][2];
#pragma unroll
                for (int d0 = 0; d0 < 8; ++d0) { kk[d0][0] = *(const LAS bf16x8*)(Kb + kq[d0 & 3] + (d0 >> 2) * 128); kk[d0][1] = *(const LAS bf16x8*)(Kb + kq[d0 & 3] + (d0 >> 2) * 128 + 8192); }
#pragma unroll
                for (int d0 = 0; d0 < 4; ++d0) { kk[8 + d0][0] = *(const LAS bf16x8*)(KRp + kq[d0]); kk[8 + d0][1] = *(const LAS bf16x8*)(KRp + kq[d0] + 4096); }
#pragma unroll
                for (int d0 = 0; d0 < 12; ++d0) { p0 = __builtin_amdgcn_mfma_f32_32x32x16_bf16(kk[d0][0], qr[d0], p0, 0, 0, 0); p1 = __builtin_amdgcn_mfma_f32_32x32x16_bf16(kk[d0][1], qr[d0], p1, 0, 0, 0); }
                __builtin_amdgcn_sched_group_barrier(0x100, 6, 0);
#pragma unroll
                for (int i = 0; i < 9; ++i) { __builtin_amdgcn_sched_group_barrier(0x008, 2, 0); __builtin_amdgcn_sched_group_barrier(0x100, 2, 0); }
                __builtin_amdgcn_sched_group_barrier(0x008, 6, 0);
                SBAR(); }
            const int vb = vb0 + b * 16384; s16x4 va[8], vc[8];
            TRD8(va, 128, 0, vb);
            if (j * 64 + 64 > nkeys) {
#pragma unroll
                for (int r = 0; r < 16; ++r) { const int kk = j * 64 + crow(r, hi); if (kk >= nkeys) p0[r] = -1e30f; if (kk + 32 >= nkeys) p1[r] = -1e30f; }
            }
            float pmax = p0[0];
#pragma unroll
            for (int r = 1; r < 16; ++r) pmax = fmaxf(pmax, p0[r]);
#pragma unroll
            for (int r = 0; r < 16; ++r) pmax = fmaxf(pmax, p1[r]);
            pmax = half_swap_max(pmax);
            const bool upd = !__all((pmax - m_reg) * MLA_C <= 8.0f);
            float alpha = 1.0f;
            if (upd) { const float mn = fmaxf(m_reg, pmax); alpha = __builtin_amdgcn_exp2f((m_reg - mn) * MLA_C); m_reg = mn; }
            const float mnC = -m_reg * MLA_C; float ps = 0.f;
#pragma unroll
            for (int r = 0; r < 16; ++r) { p0[r] = __builtin_amdgcn_exp2f(fmaf(p0[r], MLA_C, mnC)); p1[r] = __builtin_amdgcn_exp2f(fmaf(p1[r], MLA_C, mnC)); ps += p0[r] + p1[r]; }
            ps = half_swap_sum(ps);
            l_reg = l_reg * alpha + ps;
            bf16x8 pa0, pa1, pa2, pa3;
            PK4(p0, 0, pa0); PK4(p0, 8, pa1); PK4(p1, 0, pa2); PK4(p1, 8, pa3);
            if (upd) {
                if (hi == 0) wsf[r32] = alpha; asm volatile("s_waitcnt lgkmcnt(0)" ::: "memory");
#pragma unroll
                for (int r = 0; r < 16; ++r) { const float a = wsf[crow(r, hi)];
#pragma unroll
                    for (int d = 0; d < 4; ++d) o[d][r] *= a; }
                asm volatile("s_waitcnt lgkmcnt(0)" ::: "memory"); }
            TRD8(vc, 128, 1, vb); LGKM_WAIT(8); PVM4(o[0], va);
            TRD8(va, 128, 2, vb); LGKM_WAIT(8); PVM4(o[1], vc);
            TRD8(vc, 128, 3, vb); LGKM_WAIT(8); PVM4(o[2], va);
            LGKM_WAIT(0); PVM4(o[3], vc);
        }
        if (j + 1 < NT) MLA_WRITE(b ^ 1);
        __syncthreads();
    }
    if (hi == 0) wsf[32 + r32] = l_reg; asm volatile("s_waitcnt lgkmcnt(0)" ::: "memory");
    {
        LAS char* ot = L + wid * 8704;
#pragma unroll
        for (int r = 0; r < 16; ++r) { const float rl = 1.0f / wsf[32 + crow(r, hi)]; LAS unsigned short* rp = (LAS unsigned short*)(ot + crow(r, hi) * 272) + r32;
#pragma unroll
            for (int d = 0; d < 4; ++d) rp[d * 32] = (unsigned short)f2bf(o[d][r] * rl); }
        asm volatile("s_waitcnt lgkmcnt(0)" ::: "memory");
#pragma unroll
        for (int q = 0; q < 8; ++q) { const int ci = q * 64 + lane, row = ci >> 4, c16 = ci & 15, orow = wid * 32 + row;
            const u32x4 w = *(const LAS u32x4*)(ot + row * 272 + c16 * 16);
            if (orow < nq) *(u32x4*)(Oh + (size_t)orow * DM + c16 * 8) = w; }
    }
    __syncthreads();
#undef MLA_LOAD
#undef MLA_WRITE
}
__device__ __forceinline__ void ph_mla_attn(const Params& p, int wv, const bf16_t* KR, bf16_t* O, char* lds) {
    const int tix = ltid(wv);
    const bf16_t* Q = (const bf16_t*)(wsp(p) + WS_Q); const bf16_t* KV = (const bf16_t*)(wsp(p) + WS_KV);
    const int wid = tix >> 6, G = gridDim.x;
    const int npr = (512 + G - 1) / G, nsr = (DBATCH * 16 + G - 1) / G;
    for (int sl = 0; sl < 2 * npr + nsr; ++sl) {
        size_t row0, kr0; int h, nq, nkeys, NT, my_nt;
        if (sl < 2 * npr) {
            const int bb = lbid(), vb = (G & 7) ? bb : (bb & 7) * (G >> 3) + (bb >> 3);
            const int pi = vb + (sl >> 1) * G; if (pi >= 512) continue;
            const int bh = pi >> 3, s = pi & 7, b = bh >> 4, qb = (sl & 1) ? 15 - s : s; h = bh & 15;
            row0 = (size_t)b * SEQ + qb * 256; kr0 = (size_t)b * SEQ; nq = 256; nkeys = SEQ; NT = 4 * qb + 4; my_nt = 4 * qb + (wid >> 1) + 1;
        } else {
            const int u = lbid() + (sl - 2 * npr) * G; if (u >= DBATCH * 16) continue;
            const int b = u >> 4; h = u & 15;
            row0 = (size_t)NPR + b * 16; kr0 = (size_t)NPR + b * KVPB; nq = 16; nkeys = KVPB; NT = 17; my_nt = wid == 0 ? 17 : 0;
        }
        mla_attn_unit(wv, Q + row0 * NQUP + h * 192, nq, KV + kr0 * NKVUP + h * 256, KR + kr0 * 64, nkeys, NT, my_nt, O + row0 * DM + h * 128, lds);
    }
}

constexpr int SWA_K = 0, SWA_V = 24576, SWA_WS = 49152, SWA_LDS = 51200;
__device__ __forceinline__ void swa_attn_unit(int wv, const bf16_t* Qb, int nq, const bf16_t* Kb, const bf16_t* Vb, int nkeys, const float* sinks8, bf16_t* Ob, char* lds) {
    const int tid = ltid(wv);
    const int wid = __builtin_amdgcn_readfirstlane(tid >> 6), lane = tid & 63, r32 = lane & 31, hi = lane >> 5;
    LAS char* L = (LAS char*)lds; LAS float* wsf = (LAS float*)(L + SWA_WS) + wid * 64;
#pragma unroll
    for (int i = 0; i < 3; ++i) { const int idx = tid + i * 512, row = idx >> 3, ch = idx & 7; const bool valid = row < nkeys; const int rr = valid ? row : 0;
        bf16x8 kx = *(const bf16x8*)(Kb + (size_t)rr * 256 + ch * 8), vx = *(const bf16x8*)(Vb + (size_t)rr * 256 + ch * 8);
        if (!valid) { kx = (bf16x8){0, 0, 0, 0, 0, 0, 0, 0}; vx = kx; }
        *(LAS bf16x8*)(L + SWA_K + KSWZ128(row, ch * 16)) = kx;
        *(LAS bf16x8*)(L + SWA_V + (row >> 6) * 8192 + v_st<64>(row & 63, ch * 8)) = vx; }
    __syncthreads();
    const float sink2 = sinks8[wid] * LOG2E; const int vb0 = (int)(uintptr_t)(lds + SWA_V) + v_rd_base(lane);
    constexpr float SC = 0.125f * LOG2E;
    int kq[4];
#pragma unroll
    for (int q = 0; q < 4; ++q) kq[q] = r32 * 128 + ((q * 32 + hi * 16) ^ ((r32 & 7) << 4));
    const int ntile = (nkeys + 63) >> 6;
    for (int q2 = 0; q2 * 32 < nq; ++q2) {
        bf16x8 qr[4];
        { int qrow = q2 * 32 + r32; if (qrow > nq - 1) qrow = nq - 1; const bf16_t* qp = Qb + (size_t)qrow * DM + wid * 64 + hi * 8;
#pragma unroll
          for (int d0 = 0; d0 < 4; ++d0) qr[d0] = *(const bf16x8*)(qp + d0 * 16); }
        float m_reg = sink2, l_reg = 1.0f; f32x16 o0 = {}, o1 = {};
        for (int t = 0; t < ntile; ++t) {
            f32x16 p0 = {}, p1 = {};
            const LAS char* Kt = L + SWA_K + t * 8192;
#pragma unroll
            for (int d0 = 0; d0 < 4; ++d0) { const bf16x8 k0 = *(const LAS bf16x8*)(Kt + kq[d0]), k1 = *(const LAS bf16x8*)(Kt + kq[d0] + 4096);
                p0 = __builtin_amdgcn_mfma_f32_32x32x16_bf16(k0, qr[d0], p0, 0, 0, 0);
                p1 = __builtin_amdgcn_mfma_f32_32x32x16_bf16(k1, qr[d0], p1, 0, 0, 0); }
            if (t * 64 + 64 > nkeys) {
#pragma unroll
                for (int r = 0; r < 16; ++r) { const int kk = t * 64 + crow(r, hi); if (kk >= nkeys) p0[r] = -1e30f; if (kk + 32 >= nkeys) p1[r] = -1e30f; }
            }
            float pmax = p0[0];
#pragma unroll
            for (int r = 1; r < 16; ++r) pmax = fmaxf(pmax, p0[r]);
#pragma unroll
            for (int r = 0; r < 16; ++r) pmax = fmaxf(pmax, p1[r]);
            pmax = half_swap_max(pmax) * SC;
            const float mn = fmaxf(m_reg, pmax); const float alpha = __builtin_amdgcn_exp2f(m_reg - mn); m_reg = mn;
            float ps = 0.f;
#pragma unroll
            for (int r = 0; r < 16; ++r) { p0[r] = __builtin_amdgcn_exp2f(fmaf(p0[r], SC, -mn)); p1[r] = __builtin_amdgcn_exp2f(fmaf(p1[r], SC, -mn)); ps += p0[r] + p1[r]; }
            ps = half_swap_sum(ps);
            l_reg = l_reg * alpha + ps;
            bf16x8 pa0, pa1, pa2, pa3;
            PK4(p0, 0, pa0); PK4(p0, 8, pa1); PK4(p1, 0, pa2); PK4(p1, 8, pa3);
            if (hi == 0) wsf[r32] = alpha; asm volatile("s_waitcnt lgkmcnt(0)" ::: "memory");
#pragma unroll
            for (int r = 0; r < 16; ++r) { const float a = wsf[crow(r, hi)]; o0[r] *= a; o1[r] *= a; }
            asm volatile("s_waitcnt lgkmcnt(0)" ::: "memory");
            const int vb = vb0 + t * 8192;
            pv_one<64, 0>(o0, vb, pa0, pa1, pa2, pa3); pv_one<64, 1>(o1, vb, pa0, pa1, pa2, pa3);
        }
        if (hi == 0) wsf[32 + r32] = l_reg; asm volatile("s_waitcnt lgkmcnt(0)" ::: "memory");
#pragma unroll
        for (int r = 0; r < 16; ++r) { const int orow = q2 * 32 + crow(r, hi); const float rl = 1.0f / wsf[32 + crow(r, hi)];
            if (orow < nq) { Ob[orow * DM + wid * 64 + r32] = (bf16_t)f2bf(o0[r] * rl); Ob[orow * DM + wid * 64 + 32 + r32] = (bf16_t)f2bf(o1[r] * rl); } }
        asm volatile("s_waitcnt lgkmcnt(0)" ::: "memory");
    }
    __syncthreads();
}
__device__ __forceinline__ void ph_swa_attn(const Params& p, int wv, int j, const bf16_t* SK, const bf16_t* SV, bf16_t* O, char* lds) {
    const bf16_t* SQ = (const bf16_t*)(wsp(p) + WS_SQ);
    const float* sinks = inp(p, 22) + j * 32;
    const int bb_ = lbid(), G_ = (int)gridDim.x, vb_ = (G_ & 7) ? bb_ : (bb_ & 7) * (G_ >> 3) + (bb_ >> 3);
    for (int u = vb_; u < 1024 + DBATCH * 4; u += gridDim.x) {
        size_t qrow0, krow0; int g, nq, nk;
        if (u < 1024) { const int c = u & 63, b = u >> 8; g = (u >> 6) & 3; const int c0 = c >= 2 ? c - 2 : 0; nk = (c - c0 + 1) * 64; nq = 64;
            qrow0 = (size_t)b * SEQ + c * 64; krow0 = (size_t)b * SEQ + c0 * 64; }
        else { const int v = u - 1024, b = v >> 2; g = v & 3; nq = 16; nk = SWPB; qrow0 = (size_t)NPR + b * 16; krow0 = (size_t)NPR + b * SWPB; }
        swa_attn_unit(wv, SQ + qrow0 * DM + g * 512, nq, SK + krow0 * 256 + g * 64, SV + krow0 * 256 + g * 64, nk, sinks + g * 8, O + qrow0 * DM + g * 512, lds);
    }
}

namespace pg8 {
#define PG8_LAS __attribute__((address_space(3)))
typedef unsigned short bf16_t;
typedef short bf16x8 __attribute__((ext_vector_type(8)));
typedef float f32x4 __attribute__((ext_vector_type(4)));
typedef unsigned u32x4 __attribute__((ext_vector_type(4)));
constexpr int BM = 256, BK = 64, HALF = 128, HTB = HALF * BK * 2  , STAGE_BYTES = 8 * HTB, NXCD = 8, WGM = 8;

__host__ __device__ __forceinline__ int lds_byte(int r, int c) { const int st = (r >> 4) * 2 + (c >> 5), rr = r & 15, cc = c & 31, ob = rr * 64 + cc * 2; return st * 1024 + (ob ^ (((ob >> 9) & 1) << 5)); }
__host__ __device__ __forceinline__ void stage_rc(int b, int& R, int& C) { const int st = b / 1024, sb = b % 1024, swz = sb ^ (((sb >> 9) & 1) << 5); R = (st >> 1) * 16 + swz / 64; C = (st & 1) * 32 + (swz % 64) / 2; }
__host__ __device__ __forceinline__ int perm32(int rho) { const int n = rho >> 4, i = rho & 15; return 8 * (i >> 2) + 4 * n + (i & 3); }

struct Unit { int pm, pn; };
struct Gemm { const bf16_t* A; const bf16_t* Bt; int M, N, K; };

struct StaticOrder {
    int nM, nN, nwg, G, c, wgm;
    __host__ __device__ void init(int M, int N, int G_, int c_, int wgm_ = WGM) { nM = M / BM; nN = N / BM; nwg = nM * nN; G = G_; c = c_; wgm = wgm_; }
    __host__ __device__ bool next(int i, Unit& u) const {
        const int L = i * G + c; if (L >= nwg) return false;
        int wgid = L; { const int q = nwg / NXCD, r = nwg % NXCD, xcd = wgid % NXCD, off = wgid / NXCD; wgid = (xcd < r ? xcd * (q + 1) : r * (q + 1) + (xcd - r) * q) + off; }
        const int nig = wgm * nN, gid = wgid / nig, fm = gid * wgm, gsz = (nM - fm) < wgm ? (nM - fm) : wgm;
        u.pm = fm + ((wgid % nig) % gsz); u.pn = (wgid % nig) / gsz; return true;
    }
    __device__ __forceinline__ void a_ready(const Unit&) const {}
    __device__ __forceinline__ void done(const Unit&) const {}
};

__device__ __forceinline__ unsigned cvt_pk_bf16(float lo, float hi) { unsigned r; asm volatile("v_cvt_pk_bf16_f32 %0, %1, %2" : "=v"(r) : "v"(lo), "v"(hi)); return r; }
#define PG8_FOR_ROWS for (int ai = 0; ai < 2; ++ai) _Pragma("unroll") for (int m = 0; m < 4; ++m)
#define PG8_GAS __attribute__((address_space(1)))
typedef PG8_GAS f32x4 gf32x4; typedef PG8_GAS u32x4 gu32x4; typedef unsigned u32x2 __attribute__((ext_vector_type(2))); typedef PG8_GAS u32x2 gu32x2; typedef PG8_GAS float gfloat;
__device__ __forceinline__ float rstd_of(const ssq_t* ssq, int row) { return rsqrtf(ssq_val(ssq, row) * (1.0f / 2048) + 1e-6f); }
typedef PG8_LAS float lfloat; typedef PG8_LAS f32x4 lf32x4;
__device__ __forceinline__ void wg_bar() { asm volatile("s_waitcnt lgkmcnt(0)\n\ts_barrier" ::: "memory"); }
__device__ __forceinline__ float fq_sum(float v) {
    { auto r = __builtin_amdgcn_permlane16_swap(__float_as_uint(v), __float_as_uint(v), false, false); v = __uint_as_float(r[0]) + __uint_as_float(r[1]); }
    { auto r = __builtin_amdgcn_permlane32_swap(__float_as_uint(v), __float_as_uint(v), false, false); v = __uint_as_float(r[0]) + __uint_as_float(r[1]); }
    return v; }
__device__ __forceinline__ u32x4 pack8(const f32x4& a, const f32x4& b) { u32x4 w; w.x = cvt_pk_bf16(a[0], a[1]); w.y = cvt_pk_bf16(a[2], a[3]); w.z = cvt_pk_bf16(b[0], b[1]); w.w = cvt_pk_bf16(b[2], b[3]); return w; }

struct EpiStoreF32 {
    static constexpr bool PERM = false, AFTER_DRAIN = false;
    float* C; int ldc, ncols; const ssq_t* ssq;
    __device__ __forceinline__ void operator()(const f32x4 (&acc)[2][2][4][2], const Unit& u, int wr, int wc, int fr, int fq) const {
        { int l_ = (int)__builtin_amdgcn_mbcnt_hi(~0u, __builtin_amdgcn_mbcnt_lo(~0u, 0u)); asm volatile("" : "+v"(l_)); fr = l_ & 15; fq = l_ >> 4; }
        const int row0 = u.pm * BM + wr * 64 + fr, col0 = u.pn * BM + wc * 32 + 4 * fq;
        float rs[2][4];
#pragma unroll
        PG8_FOR_ROWS rs[ai][m] = ssq ? rstd_of(ssq, row0 + ai * HALF + m * 16) : 1.0f;
#pragma unroll
        PG8_FOR_ROWS { float* rowp = C + (size_t)(row0 + ai * HALF + m * 16) * ldc + col0;
#pragma unroll
            for (int bj = 0; bj < 2; ++bj)
#pragma unroll
                for (int n = 0; n < 2; ++n) if (col0 + bj * HALF + n * 16 < ncols) *(gf32x4*)(rowp + bj * HALF + n * 16) = acc[ai][bj][m][n] * rs[ai][m]; }
    }
};
__device__ __forceinline__ void unpack8(const u32x4& w, f32x4& a, f32x4& b) {
    a[0] = __uint_as_float(w.x << 16); a[1] = __uint_as_float(w.x & 0xffff0000u); a[2] = __uint_as_float(w.y << 16); a[3] = __uint_as_float(w.y & 0xffff0000u);
    b[0] = __uint_as_float(w.z << 16); b[1] = __uint_as_float(w.z & 0xffff0000u); b[2] = __uint_as_float(w.w << 16); b[3] = __uint_as_float(w.w & 0xffff0000u); }
struct EpiResidF32 {
    static constexpr bool PERM = true, AFTER_DRAIN = false;
    const bf16_t* hin; bf16_t* hout; ssq_t* ssq_out;
    __device__ __forceinline__ void operator()(const f32x4 (&acc)[2][2][4][2], const Unit& u, int wr, int wc, int fr, int fq) const {
        { int l_ = (int)__builtin_amdgcn_mbcnt_hi(~0u, __builtin_amdgcn_mbcnt_lo(~0u, 0u)); asm volatile("" : "+v"(l_)); fr = l_ & 15; fq = l_ >> 4; }
        const int row0 = u.pm * BM + wr * 64 + fr, col0 = u.pn * BM + wc * 32 + 8 * fq;
#pragma unroll
        for (int ai = 0; ai < 2; ++ai) {
            u32x4 v[4][2];
#pragma unroll
            for (int m = 0; m < 4; ++m)
#pragma unroll
                for (int bj = 0; bj < 2; ++bj) v[m][bj] = *(const gu32x4*)(hin + (size_t)(row0 + ai * HALF + m * 16) * 2048 + col0 + bj * HALF);
#pragma unroll
            for (int m = 0; m < 4; ++m) { const int row = row0 + ai * HALF + m * 16; const size_t off = (size_t)row * 2048 + col0; float ss = 0.f;
#pragma unroll
                for (int bj = 0; bj < 2; ++bj) { f32x4 h0, h1; unpack8(v[m][bj], h0, h1); const f32x4 o0 = h0 + acc[ai][bj][m][0], o1 = h1 + acc[ai][bj][m][1];
                    ss += o0[0] * o0[0] + o0[1] * o0[1] + o0[2] * o0[2] + o0[3] * o0[3] + o1[0] * o1[0] + o1[1] * o1[1] + o1[2] * o1[2] + o1[3] * o1[3];
                    *(gu32x4*)(hout + off + bj * HALF) = pack8(o0, o1); }
                ss = fq_sum(ss);
                if (fq == 0) ssq_add(ssq_out, row, ss); }
            asm volatile("" ::: "memory"); }
    }
};
struct EpiPleF32 {
    static constexpr bool PERM = true, AFTER_DRAIN = false;
    const bf16_t* hin; const bf16_t* t; bf16_t* hout; const ssq_t* ssq_in; ssq_t* ssq_out;
    __device__ __forceinline__ void operator()(const f32x4 (&acc)[2][2][4][2], const Unit& u, int wr, int wc, int fr, int fq) const {
        { int l_ = (int)__builtin_amdgcn_mbcnt_hi(~0u, __builtin_amdgcn_mbcnt_lo(~0u, 0u)); asm volatile("" : "+v"(l_)); fr = l_ & 15; fq = l_ >> 4; }
        const int row0 = u.pm * BM + wr * 64 + fr, col0 = u.pn * BM + wc * 32 + 8 * fq;
#pragma unroll
        for (int ai = 0; ai < 2; ++ai)
#pragma unroll
            for (int mp = 0; mp < 2; ++mp) {
                u32x4 hv[2][2], tv[2][2];
#pragma unroll
                for (int mm = 0; mm < 2; ++mm)
#pragma unroll
                    for (int bj = 0; bj < 2; ++bj) { const size_t o_ = (size_t)(row0 + ai * HALF + (mp * 2 + mm) * 16) * 2048 + col0 + bj * HALF; hv[mm][bj] = *(const gu32x4*)(hin + o_); tv[mm][bj] = *(const gu32x4*)(t + o_); }
#pragma unroll
                for (int mm = 0; mm < 2; ++mm) { const int m = mp * 2 + mm, row = row0 + ai * HALF + m * 16; const size_t off = (size_t)row * 2048 + col0; const float rs = rstd_of(ssq_in, row); float ss = 0.f;
#pragma unroll
                    for (int bj = 0; bj < 2; ++bj) { f32x4 h[2], tt[2], o[2]; unpack8(hv[mm][bj], h[0], h[1]); unpack8(tv[mm][bj], tt[0], tt[1]);
#pragma unroll
                        for (int n = 0; n < 2; ++n)
#pragma unroll
                            for (int e = 0; e < 4; ++e) { const float x = h[n][e] + tt[n][e] * __builtin_amdgcn_rcpf(1.0f + __expf(-acc[ai][bj][m][n][e] * rs)); o[n][e] = x; ss += x * x; }
                        *(gu32x4*)(hout + off + bj * HALF) = pack8(o[0], o[1]); }
                    ss = fq_sum(ss);
                    if (fq == 0) ssq_add(ssq_out, row, ss); }
                asm volatile("" ::: "memory"); }
    }
};
struct EpiStoreBf16 {
    static constexpr bool PERM = true, AFTER_DRAIN = false;
    bf16_t* O; int ldc;
    __device__ __forceinline__ void operator()(const f32x4 (&acc)[2][2][4][2], const Unit& u, int wr, int wc, int fr, int fq) const {
        { int l_ = (int)__builtin_amdgcn_mbcnt_hi(~0u, __builtin_amdgcn_mbcnt_lo(~0u, 0u)); asm volatile("" : "+v"(l_)); fr = l_ & 15; fq = l_ >> 4; }
        const int row0 = u.pm * BM + wr * 64 + fr, col0 = u.pn * BM + wc * 32 + 8 * fq;
#pragma unroll
        PG8_FOR_ROWS { bf16_t* rowp = O + (size_t)(row0 + ai * HALF + m * 16) * ldc + col0;
#pragma unroll
            for (int bj = 0; bj < 2; ++bj) { const f32x4 v0 = acc[ai][bj][m][0], v1 = acc[ai][bj][m][1];
                u32x4 w; w.x = cvt_pk_bf16(v0[0], v0[1]); w.y = cvt_pk_bf16(v0[2], v0[3]); w.z = cvt_pk_bf16(v1[0], v1[1]); w.w = cvt_pk_bf16(v1[2], v1[3]);
                *(gu32x4*)(rowp + bj * HALF) = w; } }
    }
};
struct EpiSwigluBf16 {
    static constexpr bool PERM = true, AFTER_DRAIN = false;
    bf16_t* act; int ldc; const ssq_t* ssq;
    __device__ __forceinline__ void operator()(const f32x4 (&acc)[2][2][4][2], const Unit& u, int wr, int wc, int fr, int fq) const {
        { int l_ = (int)__builtin_amdgcn_mbcnt_hi(~0u, __builtin_amdgcn_mbcnt_lo(~0u, 0u)); asm volatile("" : "+v"(l_)); fr = l_ & 15; fq = l_ >> 4; }
        const int row0 = u.pm * BM + wr * 64 + fr, ch0 = u.pn * HALF + wc * 32 + 8 * fq;
        float rs[2][4];
#pragma unroll
        PG8_FOR_ROWS rs[ai][m] = rstd_of(ssq, row0 + ai * HALF + m * 16);
#pragma unroll
        PG8_FOR_ROWS { bf16_t* rowp = act + (size_t)(row0 + ai * HALF + m * 16) * ldc + ch0; float o[8]; const float r_ = rs[ai][m];
#pragma unroll
            for (int n = 0; n < 2; ++n)
#pragma unroll
                for (int e = 0; e < 4; ++e) { const float g = acc[ai][0][m][n][e] * r_, up = acc[ai][1][m][n][e] * r_; o[n * 4 + e] = g * __builtin_amdgcn_rcpf(1.0f + __expf(-g)) * up; }
            u32x4 w; w.x = cvt_pk_bf16(o[0], o[1]); w.y = cvt_pk_bf16(o[2], o[3]); w.z = cvt_pk_bf16(o[4], o[5]); w.w = cvt_pk_bf16(o[6], o[7]);
            *(gu32x4*)rowp = w; }
    }
};
struct EpiMlaIn {
    static constexpr bool PERM = true, AFTER_DRAIN = false;
    bf16_t* CQ; bf16_t* CKV; bf16_t* KRB; float* out; int j; const ssq_t* ssq_h; ssq_t* ssq_q; ssq_t* ssq_kv; const float* gkr; const float* tm;
    __device__ __forceinline__ void operator()(const f32x4 (&acc)[2][2][4][2], const Unit& u, int wr, int wc, int fr, int fq) const {
        { int l_ = (int)__builtin_amdgcn_mbcnt_hi(~0u, __builtin_amdgcn_mbcnt_lo(~0u, 0u)); asm volatile("" : "+v"(l_)); fr = l_ & 15; fq = l_ >> 4; }
        const int row0 = u.pm * BM + wr * 64 + fr, cw = wc * 32 + 8 * fq;
        if (u.pn < 4) {
            const bool iskv = u.pn >= 2; bf16_t* dst = iskv ? CKV : CQ; ssq_t* sq = iskv ? ssq_kv : ssq_q; const int c0 = (u.pn & 1) * 256 + cw;
#pragma unroll
            PG8_FOR_ROWS { const int row = row0 + ai * HALF + m * 16; const float rs = rstd_of(ssq_h, row); float ss = 0.f;
                float* lo = iskv ? (row < NPR ? out + O_LATP + ((size_t)j * NPR + row) * 512 : out + O_LATS + ((size_t)j * NSR + (row - NPR)) * 512) + c0 : nullptr;
#pragma unroll
                for (int bj = 0; bj < 2; ++bj) { const f32x4 a = acc[ai][bj][m][0] * rs, b = acc[ai][bj][m][1] * rs;
                    ss += a[0] * a[0] + a[1] * a[1] + a[2] * a[2] + a[3] * a[3] + b[0] * b[0] + b[1] * b[1] + b[2] * b[2] + b[3] * b[3];
                    *(gu32x4*)(dst + (size_t)row * 512 + c0 + bj * HALF) = pack8(a, b);
                    if (iskv) { *(gf32x4*)(lo + bj * HALF) = a; *(gf32x4*)(lo + bj * HALF + 4) = b; } }
                ss = fq_sum(ss); if (fq == 0) ssq_add(sq, row, ss); }
        } else if (wc == 0) {
            f32x4 g[2][2];
#pragma unroll
            for (int bj = 0; bj < 2; ++bj)
#pragma unroll
                for (int n = 0; n < 2; ++n) g[bj][n] = *(const gf32x4*)(gkr + 32 * bj + 8 * fq + 4 * n);
#pragma unroll
            PG8_FOR_ROWS { const int row = row0 + ai * HALF + m * 16; const float rs = rstd_of(ssq_h, row); f32x4 x[2][2]; float ss = 0.f;
#pragma unroll
                for (int bj = 0; bj < 2; ++bj)
#pragma unroll
                    for (int n = 0; n < 2; ++n) { x[bj][n] = acc[ai][bj][m][n] * rs; ss += x[bj][n][0] * x[bj][n][0] + x[bj][n][1] * x[bj][n][1] + x[bj][n][2] * x[bj][n][2] + x[bj][n][3] * x[bj][n][3]; }
                const float r2 = rsqrtf(fq_sum(ss) * (1.0f / 64) + 1e-6f);
                const float* tp = tm + ((size_t)pos_of_row(row) * 32 + 8 * fq) * 2;
                f32x4 o[2][2];
#pragma unroll
                for (int n = 0; n < 2; ++n) { const f32x4 t0 = *(const gf32x4*)(tp + 8 * n), t1 = *(const gf32x4*)(tp + 8 * n + 4);
                    const float cs[4] = {t0[0], t0[2], t1[0], t1[2]}, sn[4] = {t0[1], t0[3], t1[1], t1[3]};
#pragma unroll
                    for (int e = 0; e < 4; ++e) { const float x1 = x[0][n][e] * r2 * g[0][n][e], x2 = x[1][n][e] * r2 * g[1][n][e]; o[0][n][e] = x1 * cs[e] - x2 * sn[e]; o[1][n][e] = x2 * cs[e] + x1 * sn[e]; } }
                float* ko = (row < NPR ? out + O_KRP + ((size_t)j * NPR + row) * 64 : out + O_KRS + ((size_t)j * NSR + (row - NPR)) * 64) + 8 * fq;
                bf16_t* kb = KRB + (size_t)latrow_of(row) * 64 + 8 * fq;
#pragma unroll
                for (int bj = 0; bj < 2; ++bj) { *(gf32x4*)(ko + 32 * bj) = o[bj][0]; *(gf32x4*)(ko + 32 * bj + 4) = o[bj][1]; *(gu32x4*)(kb + 32 * bj) = pack8(o[bj][0], o[bj][1]); } }
        }
    }
};

struct EpiQup {
    static constexpr bool PERM = true, AFTER_DRAIN = false;
    bf16_t* Q; const ssq_t* ssq_q; const float* gqn; const float* gqr; const float* tm; lfloat* xch;
    __device__ __forceinline__ void operator()(const f32x4 (&acc)[2][2][4][2], const Unit& u, int wr, int wc, int fr, int fq) const {
        { int l_ = (int)__builtin_amdgcn_mbcnt_hi(~0u, __builtin_amdgcn_mbcnt_lo(~0u, 0u)); asm volatile("" : "+v"(l_)); fr = l_ & 15; fq = l_ >> 4; }
        const int row0 = u.pm * BM + wr * 64 + fr, rl0 = wr * 64 + fr;
        float rs[2][4];
#pragma unroll
        PG8_FOR_ROWS rs[ai][m] = rsqrtf(ssq_val(ssq_q, row0 + ai * HALF + m * 16) * (1.0f / 512) + 1e-6f);
        if (u.pn < 8) {
#pragma unroll
            PG8_FOR_ROWS {
#pragma unroll
                for (int bj = 0; bj < 2; ++bj) { const f32x4 a = acc[ai][bj][m][0], b = acc[ai][bj][m][1];
                    float ss = a[0] * a[0] + a[1] * a[1] + a[2] * a[2] + a[3] * a[3] + b[0] * b[0] + b[1] * b[1] + b[2] * b[2] + b[3] * b[3];
                    ss = fq_sum(ss) * rs[ai][m] * rs[ai][m]; if (fq == 0) xch[((rl0 + ai * HALF + m * 16) * 2 + bj) * 4 + wc] = ss; } }
            wg_bar();
            const f32x4 g0 = *(const gf32x4*)(gqn + wc * 32 + 8 * fq), g1 = *(const gf32x4*)(gqn + wc * 32 + 8 * fq + 4);
#pragma unroll
            PG8_FOR_ROWS { const int row = row0 + ai * HALF + m * 16;
#pragma unroll
                for (int bj = 0; bj < 2; ++bj) { const f32x4 t = *(const lf32x4*)(xch + ((rl0 + ai * HALF + m * 16) * 2 + bj) * 4);
                    const float r2 = rsqrtf((t[0] + t[1] + t[2] + t[3]) * (1.0f / 128) + 1e-6f) * rs[ai][m];
                    *(gu32x4*)(Q + (size_t)row * NQUP + (2 * u.pn + bj) * 192 + wc * 32 + 8 * fq) = pack8(acc[ai][bj][m][0] * r2 * g0, acc[ai][bj][m][1] * r2 * g1); } }
        } else {
            const int hd = 4 * (u.pn - 8) + wc; f32x4 g[2][2];
#pragma unroll
            for (int bj = 0; bj < 2; ++bj)
#pragma unroll
                for (int n = 0; n < 2; ++n) g[bj][n] = *(const gf32x4*)(gqr + 32 * bj + 8 * fq + 4 * n);
#pragma unroll
            PG8_FOR_ROWS { const int row = row0 + ai * HALF + m * 16; f32x4 x[2][2]; float ss = 0.f;
#pragma unroll
                for (int bj = 0; bj < 2; ++bj)
#pragma unroll
                    for (int n = 0; n < 2; ++n) { x[bj][n] = acc[ai][bj][m][n] * rs[ai][m]; ss += x[bj][n][0] * x[bj][n][0] + x[bj][n][1] * x[bj][n][1] + x[bj][n][2] * x[bj][n][2] + x[bj][n][3] * x[bj][n][3]; }
                const float r2 = rsqrtf(fq_sum(ss) * (1.0f / 64) + 1e-6f);
                const float* tp = tm + ((size_t)pos_of_row(row) * 32 + 8 * fq) * 2;
                f32x4 o[2][2];
#pragma unroll
                for (int n = 0; n < 2; ++n) { const f32x4 t0 = *(const gf32x4*)(tp + 8 * n), t1 = *(const gf32x4*)(tp + 8 * n + 4);
                    const float cs[4] = {t0[0], t0[2], t1[0], t1[2]}, sn[4] = {t0[1], t0[3], t1[1], t1[3]};
#pragma unroll
                    for (int e = 0; e < 4; ++e) { const float x1 = x[0][n][e] * r2 * g[0][n][e], x2 = x[1][n][e] * r2 * g[1][n][e]; o[0][n][e] = x1 * cs[e] - x2 * sn[e]; o[1][n][e] = x2 * cs[e] + x1 * sn[e]; } }
                bf16_t* qp = Q + (size_t)row * NQUP + hd * 192 + 128 + 8 * fq;
#pragma unroll
                for (int bj = 0; bj < 2; ++bj) *(gu32x4*)(qp + 32 * bj) = pack8(o[bj][0], o[bj][1]); }
        }
    }
};

struct EpiKvup {
    static constexpr bool PERM = true, AFTER_DRAIN = false;
    bf16_t* KV; const ssq_t* ssq_kv; const float* gkn; lfloat* xch;
    __device__ __forceinline__ void operator()(const f32x4 (&acc)[2][2][4][2], const Unit& u, int wr, int wc, int fr, int fq) const {
        { int l_ = (int)__builtin_amdgcn_mbcnt_hi(~0u, __builtin_amdgcn_mbcnt_lo(~0u, 0u)); asm volatile("" : "+v"(l_)); fr = l_ & 15; fq = l_ >> 4; }
        const int row0 = u.pm * BM + wr * 64 + fr, rl0 = wr * 64 + fr;
        float rs[2][4];
#pragma unroll
        PG8_FOR_ROWS rs[ai][m] = ssq_kv ? rsqrtf(ssq_val(ssq_kv, row0 + ai * HALF + m * 16) * (1.0f / 512) + 1e-6f) : 1.0f;
#pragma unroll
        PG8_FOR_ROWS { const f32x4 a = acc[ai][0][m][0], b = acc[ai][0][m][1];
            float ss = a[0] * a[0] + a[1] * a[1] + a[2] * a[2] + a[3] * a[3] + b[0] * b[0] + b[1] * b[1] + b[2] * b[2] + b[3] * b[3];
            ss = fq_sum(ss) * rs[ai][m] * rs[ai][m]; if (fq == 0) xch[(rl0 + ai * HALF + m * 16) * 4 + wc] = ss; }
        wg_bar();
        const f32x4 g0 = *(const gf32x4*)(gkn + wc * 32 + 8 * fq), g1 = *(const gf32x4*)(gkn + wc * 32 + 8 * fq + 4);
#pragma unroll
        PG8_FOR_ROWS { const int row = row0 + ai * HALF + m * 16; const int orow = ssq_kv ? latrow_of(row) : NPR + (row >> 10) * KVPB + (row & 1023);
            const f32x4 t = *(const lf32x4*)(xch + (rl0 + ai * HALF + m * 16) * 4);
            const float r2 = rsqrtf((t[0] + t[1] + t[2] + t[3]) * (1.0f / 128) + 1e-6f) * rs[ai][m];
            bf16_t* kp = KV + (size_t)orow * NKVUP + u.pn * 256 + wc * 32 + 8 * fq;
            *(gu32x4*)kp = pack8(acc[ai][0][m][0] * r2 * g0, acc[ai][0][m][1] * r2 * g1);
            *(gu32x4*)(kp + HALF) = pack8(acc[ai][1][m][0] * rs[ai][m], acc[ai][1][m][1] * rs[ai][m]); }
    }
};

struct EpiSwaQkv {
    static constexpr bool PERM = true, AFTER_DRAIN = false;
    bf16_t* SQ; bf16_t* SK; bf16_t* SV; float* out; int j; const ssq_t* ssq_h; const float* gq; const float* gk; const float* ts;
    __device__ __forceinline__ float* state_out(int row, bool isk) const {
        if (row < NPR) { const int b = row >> 12, t = row & 4095; if (t < SEQ - 128) return nullptr; return out + (isk ? O_SKP : O_SVP) + (((size_t)j * 4 + b) * 128 + (t - (SEQ - 128))) * 256; }
        const int b = (row - NPR) >> 4, t = (row - NPR) & 15; return out + (isk ? O_SKS : O_SVS) + (((size_t)j * 16 + b) * 128 + 112 + t) * 256;
    }
    __device__ __forceinline__ void operator()(const f32x4 (&acc)[2][2][4][2], const Unit& u, int wr, int wc, int fr, int fq) const {
        { int l_ = (int)__builtin_amdgcn_mbcnt_hi(~0u, __builtin_amdgcn_mbcnt_lo(~0u, 0u)); asm volatile("" : "+v"(l_)); fr = l_ & 15; fq = l_ >> 4; }
        const int row0 = u.pm * BM + wr * 64 + fr;
        if (u.pn < 9) {
            const bool isk = u.pn == 8; const float* gg = isk ? gk : gq;
            typedef float f32x2_ __attribute__((ext_vector_type(2))); typedef PG8_GAS f32x2_ gf32x2_;
            f32x4 g[2][2];
#pragma unroll
            for (int bj = 0; bj < 2; ++bj) { const f32x2_ gr = *(const gf32x2_*)(gg + 8 * bj + 2 * fq); const float* gn = gg + 16 + 24 * bj + 6 * fq;
                const f32x2_ g0 = *(const gf32x2_*)gn, g1 = *(const gf32x2_*)(gn + 2), g2 = *(const gf32x2_*)(gn + 4);
                g[bj][0] = (f32x4){gr[0], gr[1], g0[0], g0[1]}; g[bj][1] = (f32x4){g1[0], g1[1], g2[0], g2[1]}; }
            f32x4 tb[2][4];
#pragma unroll
            PG8_FOR_ROWS tb[ai][m] = *(const gf32x4*)(ts + (size_t)pos_of_row(row0 + ai * HALF + m * 16) * 16 + 4 * fq);
#pragma unroll
            PG8_FOR_ROWS { const int row = row0 + ai * HALF + m * 16; const float rs = rstd_of(ssq_h, row); f32x4 x[2][2]; float ss = 0.f;
#pragma unroll
                for (int bj = 0; bj < 2; ++bj)
#pragma unroll
                    for (int n = 0; n < 2; ++n) { x[bj][n] = acc[ai][bj][m][n] * rs; ss += x[bj][n][0] * x[bj][n][0] + x[bj][n][1] * x[bj][n][1] + x[bj][n][2] * x[bj][n][2] + x[bj][n][3] * x[bj][n][3]; }
                const float r2 = rsqrtf(fq_sum(ss) * (1.0f / 64) + 1e-6f);
#pragma unroll
                for (int bj = 0; bj < 2; ++bj)
#pragma unroll
                    for (int n = 0; n < 2; ++n) x[bj][n] = x[bj][n] * r2 * g[bj][n];
                { const f32x4 t = tb[ai][m];
#pragma unroll
                    for (int e = 0; e < 2; ++e) { const float cs = t[2 * e], sn = t[2 * e + 1], x1 = x[0][0][e], x2 = x[1][0][e]; x[0][0][e] = x1 * cs - x2 * sn; x[1][0][e] = x2 * cs + x1 * sn; } }
                if (!isk) {
#pragma unroll
                    for (int bj = 0; bj < 2; ++bj) *(gu32x4*)(SQ + (size_t)row * DM + (4 * u.pn + wc) * 64 + 32 * bj + 8 * fq) = pack8(x[bj][0], x[bj][1]);
                } else { float* so = state_out(row, true);
#pragma unroll
                    for (int bj = 0; bj < 2; ++bj) { *(gu32x4*)(SK + (size_t)skrow_of(row) * 256 + wc * 64 + 32 * bj + 8 * fq) = pack8(x[bj][0], x[bj][1]);
                        if (so) { float* sr_ = so + wc * 64 + 8 * bj + 2 * fq; float* sn_ = so + wc * 64 + 16 + 24 * bj + 6 * fq;
                            *(gf32x2_*)sr_ = (f32x2_){x[bj][0][0], x[bj][0][1]}; *(gf32x2_*)sn_ = (f32x2_){x[bj][0][2], x[bj][0][3]};
                            *(gf32x2_*)(sn_ + 2) = (f32x2_){x[bj][1][0], x[bj][1][1]}; *(gf32x2_*)(sn_ + 4) = (f32x2_){x[bj][1][2], x[bj][1][3]}; } } }
            }
        } else {
#pragma unroll
            PG8_FOR_ROWS { const int row = row0 + ai * HALF + m * 16; const float rs = rstd_of(ssq_h, row); float* so = state_out(row, false);
#pragma unroll
                for (int bj = 0; bj < 2; ++bj) { const f32x4 a = acc[ai][bj][m][0] * rs, b = acc[ai][bj][m][1] * rs; const int c = bj * HALF + wc * 32 + 8 * fq;
                    *(gu32x4*)(SV + (size_t)skrow_of(row) * 256 + c) = pack8(a, b);
                    if (so) { *(gf32x4*)(so + c) = a; *(gf32x4*)(so + c + 4) = b; } } }
        }
    }
};
#undef PG8_FOR_ROWS

template <class Epi, class Sched, bool ALIGN_EPI = false, bool SP2 = false>
__device__ __forceinline__ void gemm_phase(int wv, PG8_LAS unsigned char* lds, const Gemm g, const Sched& S, const Epi& E) {
    const int tid = ltid(wv), wid = __builtin_amdgcn_readfirstlane(tid >> 6), lane = tid & 63, wr = wid >> 2, wc = wid & 3, fr = lane & 15, fq = lane >> 4;
    const int K = g.K, nt = K / BK;
    unsigned voffA[2], voffB[2];
#pragma unroll
    for (int i = 0; i < 2; ++i) { int R, C; stage_rc(tid * 16 + i * 8192, R, C); const int Rb = Epi::PERM ? ((R & ~31) + perm32(R & 31)) : R;
        voffA[i] = (unsigned)(R * K + C) * 2u; voffB[i] = (unsigned)(Rb * K + C) * 2u; }
    const size_t kstep = (size_t)(BK * 2);
    const size_t hstep = (size_t)HALF * K * 2;
    const size_t tstep = 2 * hstep;
    const unsigned ldsw = (unsigned)wid * 1024u;
    const int aoff = lds_byte(wr * 64 + fr, fq * 8), boff = lds_byte(wc * 32 + fr, fq * 8);
#define PG8_SA(b, h) (((b) * 2 + (h)) * HTB)
#define PG8_SB(b, h) ((4 + (b) * 2 + (h)) * HTB)
#define PG8_STAGE(bufoff, gbase, voff) do { _Pragma("unroll") for (int _i = 0; _i < 2; ++_i) \
        __builtin_amdgcn_global_load_lds((const unsigned*)((const char*)(gbase) + (voff)[_i]), (PG8_LAS unsigned*)(lds + (bufoff) + ldsw + _i * 8192), 16, 0, 0); } while (0)
#define PG8_LDA(dst, b, h) do { _Pragma("unroll") for (int m = 0; m < 4; ++m) _Pragma("unroll") for (int k = 0; k < 2; ++k) dst[m][k] = *(const PG8_LAS bf16x8*)(lds + PG8_SA(b, h) + aoff + m * 2048 + k * 1024); } while (0)
#define PG8_LDB(dst, b, h) do { _Pragma("unroll") for (int n = 0; n < 2; ++n) _Pragma("unroll") for (int k = 0; k < 2; ++k) dst[n][k] = *(const PG8_LAS bf16x8*)(lds + PG8_SB(b, h) + boff + n * 2048 + k * 1024); } while (0)
#define PG8_MMA(ai, bj, At, Bt) do { __builtin_amdgcn_s_setprio(1); _Pragma("unroll") for (int m = 0; m < 4; ++m) _Pragma("unroll") for (int n = 0; n < 2; ++n) _Pragma("unroll") for (int k = 0; k < 2; ++k) \
        acc[ai][bj][m][n] = __builtin_amdgcn_mfma_f32_16x16x32_bf16(Bt[n][k], At[m][k], acc[ai][bj][m][n], 0, 0, 0); __builtin_amdgcn_s_setprio(0); } while (0)
#define PG8_WAIT_V(n) asm volatile("s_waitcnt vmcnt(" #n ")" ::: "memory")
#define PG8_WAIT_L(n) asm volatile("s_waitcnt lgkmcnt(" #n ")" ::: "memory")
#define PG8_BAR __builtin_amdgcn_s_barrier()
#define PG8_SCHED __builtin_amdgcn_sched_barrier(0)
    Unit cur, nxt; int ui = 0;
    if (!S.next(0, cur)) return;
    f32x4 acc[2][2][4][2];
#pragma unroll
    for (int a = 0; a < 2; ++a)
#pragma unroll
        for (int b = 0; b < 2; ++b)
#pragma unroll
            for (int m = 0; m < 4; ++m)
#pragma unroll
                for (int n = 0; n < 2; ++n) acc[a][b][m][n] = (f32x4){0.f, 0.f, 0.f, 0.f};
    bf16x8 At[4][2], B0[2][2], B1[2][2];
    const char* cA = (const char*)g.A + (size_t)cur.pm * tstep; const char* cB = (const char*)g.Bt + (size_t)cur.pn * tstep;
    S.a_ready(cur);
    if constexpr (SP2) {
        PG8_STAGE(PG8_SB(0, 0), cB, voffB); PG8_STAGE(PG8_SB(0, 1), cB + hstep, voffB); PG8_STAGE(PG8_SA(0, 0), cA, voffA); PG8_STAGE(PG8_SA(0, 1), cA + hstep, voffA);
        if (wr == 1) PG8_BAR;
        PG8_WAIT_V(2); PG8_BAR;
        PG8_STAGE(PG8_SB(1, 0), cB + kstep, voffB); PG8_STAGE(PG8_SA(1, 0), cA + kstep, voffA); PG8_STAGE(PG8_SB(1, 1), cB + hstep + kstep, voffB);
        PG8_WAIT_V(6); PG8_BAR;
    } else {
        PG8_STAGE(PG8_SB(0, 0), cB, voffB); PG8_STAGE(PG8_SA(0, 0), cA, voffA); PG8_STAGE(PG8_SB(0, 1), cB + hstep, voffB); PG8_STAGE(PG8_SA(0, 1), cA + hstep, voffA);
        if (wr == 1) PG8_BAR;
        PG8_WAIT_V(4); PG8_BAR;
        PG8_STAGE(PG8_SB(1, 0), cB + kstep, voffB); PG8_STAGE(PG8_SA(1, 0), cA + kstep, voffA); PG8_STAGE(PG8_SB(1, 1), cB + hstep + kstep, voffB);
        PG8_WAIT_V(6); PG8_BAR;
    }
    for (;;) {
        const bool has_next = S.next(ui + 1, nxt);
        const char* nA = has_next ? (const char*)g.A + (size_t)nxt.pm * tstep : cA; const char* nB = has_next ? (const char*)g.Bt + (size_t)nxt.pn * tstep : cB;
        for (int t = 0; t < nt; t += 2) {
            const bool last = (t == nt - 2);
            const char* a1 = cA + (size_t)(t + 1) * kstep;
            const char* a2 = last ? nA : cA + (size_t)(t + 2) * kstep; const char* b2 = last ? nB : cB + (size_t)(t + 2) * kstep;
            const char* a3 = a2 + kstep; const char* b3 = b2 + kstep;
            if (last && has_next) S.a_ready(nxt);
            if constexpr (SP2) {
            PG8_LDB(B0, 0, 0); PG8_LDB(B1, 0, 1); PG8_SCHED; PG8_LDA(At, 0, 0); PG8_STAGE(PG8_SA(1, 1), a1 + hstep, voffA);
            PG8_WAIT_V(8); PG8_WAIT_L(0); PG8_BAR; PG8_MMA(0, 0, At, B0); PG8_MMA(0, 1, At, B1); PG8_BAR; PG8_SCHED;
            PG8_LDA(At, 0, 1); PG8_STAGE(PG8_SB(0, 0), b2, voffB); PG8_STAGE(PG8_SB(0, 1), b2 + hstep, voffB); PG8_STAGE(PG8_SA(0, 0), a2, voffA);
            PG8_WAIT_V(8); PG8_WAIT_L(0); PG8_BAR; PG8_MMA(1, 0, At, B0); PG8_MMA(1, 1, At, B1); PG8_BAR; PG8_SCHED;
            PG8_LDB(B0, 1, 0); PG8_LDB(B1, 1, 1); PG8_SCHED; PG8_LDA(At, 1, 0); PG8_STAGE(PG8_SA(0, 1), a2 + hstep, voffA);
            PG8_WAIT_V(8); PG8_WAIT_L(0); PG8_BAR; PG8_MMA(0, 0, At, B0); PG8_MMA(0, 1, At, B1); PG8_BAR; PG8_SCHED;
            PG8_LDA(At, 1, 1); PG8_STAGE(PG8_SB(1, 0), b3, voffB); PG8_STAGE(PG8_SB(1, 1), b3 + hstep, voffB); PG8_STAGE(PG8_SA(1, 0), a3, voffA);
            PG8_WAIT_V(8); PG8_WAIT_L(0); PG8_BAR; PG8_MMA(1, 0, At, B0); PG8_MMA(1, 1, At, B1); PG8_BAR; PG8_SCHED;
            } else {
            PG8_LDB(B0, 0, 0); PG8_SCHED; PG8_LDA(At, 0, 0); PG8_STAGE(PG8_SA(1, 1), a1 + hstep, voffA);
            PG8_WAIT_L(8); PG8_BAR; PG8_WAIT_L(0); PG8_MMA(0, 0, At, B0); PG8_BAR; PG8_SCHED;
            PG8_LDB(B1, 0, 1); PG8_STAGE(PG8_SB(0, 0), b2, voffB);
            PG8_BAR; PG8_WAIT_L(0); PG8_MMA(0, 1, At, B1); PG8_BAR;
            PG8_LDA(At, 0, 1); PG8_STAGE(PG8_SA(0, 0), a2, voffA);
            PG8_BAR; PG8_WAIT_L(0); PG8_MMA(1, 0, At, B0); PG8_BAR; PG8_SCHED;
            PG8_STAGE(PG8_SB(0, 1), b2 + hstep, voffB);
            PG8_WAIT_V(6); PG8_BAR; PG8_MMA(1, 1, At, B1); PG8_BAR;
            PG8_LDB(B0, 1, 0); PG8_SCHED; PG8_LDA(At, 1, 0); PG8_STAGE(PG8_SA(0, 1), a2 + hstep, voffA);
            PG8_WAIT_L(8); PG8_BAR; PG8_WAIT_L(0); PG8_MMA(0, 0, At, B0); PG8_BAR; PG8_SCHED;
            PG8_LDB(B1, 1, 1); PG8_STAGE(PG8_SB(1, 0), b3, voffB);
            PG8_BAR; PG8_WAIT_L(0); PG8_MMA(0, 1, At, B1); PG8_BAR;
            PG8_LDA(At, 1, 1); PG8_STAGE(PG8_SA(1, 0), a3, voffA);
            PG8_BAR; PG8_WAIT_L(0); PG8_MMA(1, 0, At, B0); PG8_BAR; PG8_SCHED;
            PG8_STAGE(PG8_SB(1, 1), b3 + hstep, voffB);
            PG8_WAIT_V(6); PG8_BAR; PG8_MMA(1, 1, At, B1); PG8_BAR;
            }
        }
        if constexpr (ALIGN_EPI) { if (wr == 0) PG8_BAR; }
        if constexpr (!Epi::AFTER_DRAIN) { E(acc, cur, wr, wc, fr, fq); S.done(cur); }
        if (!has_next) break;
#pragma unroll
        for (int a = 0; a < 2; ++a)
#pragma unroll
            for (int b = 0; b < 2; ++b)
#pragma unroll
                for (int m = 0; m < 4; ++m)
#pragma unroll
                    for (int n = 0; n < 2; ++n) acc[a][b][m][n] = (f32x4){0.f, 0.f, 0.f, 0.f};
        cur = nxt; cA = nA; cB = nB; ++ui;
        if constexpr (ALIGN_EPI) { if (wr == 1) PG8_BAR; }
    }
    PG8_WAIT_V(0);
    if constexpr (!ALIGN_EPI) { if (wr == 0) PG8_BAR; }
    PG8_BAR;
    if constexpr (Epi::AFTER_DRAIN) { E.fused(acc, cur, wr, wc, fr, fq, lds, wid, lane); S.done(cur); }
#undef PG8_SA
#undef PG8_SB
#undef PG8_STAGE
#undef PG8_LDA
#undef PG8_LDB
#undef PG8_MMA
#undef PG8_WAIT_V
#undef PG8_WAIT_L
#undef PG8_BAR
#undef PG8_SCHED
}
}

#define DPPF(v, ctrl) __uint_as_float((unsigned)__builtin_amdgcn_update_dpp(0, (int)__float_as_uint(v), (ctrl), 0xF, 0xF, true))
__device__ __forceinline__ float g16_sum(float v) { v += DPPF(v, 0xB1); v += DPPF(v, 0x4E); v += DPPF(v, 0x141); v += DPPF(v, 0x140); return v; }
__device__ __forceinline__ float x8_16(float v) { return DPPF(v, 0x128); }
template <int NB> struct SgB { const bf16_t* p[NB]; };
template <int NB, int U, class F>
__device__ __forceinline__ void sg_item(int wv, char* lds, const bf16_t* A  , int K, const SgB<NB>& B, const F& f) {
    constexpr int NBC = NB * 32, NV = NBC / 16;
    const int tid = ltid(wv), lane = tid & 63, r32 = lane & 31, hi = lane >> 5;
    LAS float* L = (LAS float*)lds;
    const int k0 = wv * (K >> 3), nst = K >> 7;
    const size_t lo = (size_t)r32 * K + k0 + hi * 8;
    typedef __attribute__((address_space(1))) bf16x8 gbf8;
    const gbf8* ap = (const gbf8*)(A + lo);
    const gbf8* bp[NB];
#pragma unroll
    for (int cb = 0; cb < NB; ++cb) bp[cb] = (const gbf8*)(B.p[cb] + lo);
    f32x16 acc[NB];
#pragma unroll
    for (int cb = 0; cb < NB; ++cb) acc[cb] = (f32x16){};
    for (int s0 = 0; s0 < nst; s0 += U) {
        bf16x8 a[U], b[NB][U];
#pragma unroll
        for (int u = 0; u < U; ++u) { a[u] = ap[(s0 + u) * 2];
#pragma unroll
            for (int cb = 0; cb < NB; ++cb) b[cb][u] = bp[cb][(s0 + u) * 2]; }
        SBAR();
#pragma unroll
        for (int u = 0; u < U; ++u)
#pragma unroll
            for (int cb = 0; cb < NB; ++cb) acc[cb] = __builtin_amdgcn_mfma_f32_32x32x16_bf16(a[u], b[cb][u], acc[cb], 0, 0, 0);
    }
#pragma unroll
    for (int cb = 0; cb < NB; ++cb)
#pragma unroll
        for (int r = 0; r < 16; ++r) L[(wv * 32 + crow(r, hi)) * NBC + cb * 32 + r32] = acc[cb][r];
    __syncthreads();
    const int row = 4 * wv + (lane >> 4), c0 = (lane & 15) * NV;
    float v[NV];
#pragma unroll
    for (int e = 0; e < NV; ++e) v[e] = 0.f;
#pragma unroll
    for (int q = 0; q < 8; ++q)
#pragma unroll
        for (int e4 = 0; e4 < NV / 4; ++e4) { const f32x4 t = *(const LAS f32x4*)(L + (q * 32 + row) * NBC + c0 + e4 * 4); v[e4 * 4] += t[0]; v[e4 * 4 + 1] += t[1]; v[e4 * 4 + 2] += t[2]; v[e4 * 4 + 3] += t[3]; }
    f(row, c0, lane & 15, v);
    __syncthreads();
}
template <int NB16, int U>
__device__ __forceinline__ void sg16_batch(f32x4 (&acc)[2][NB16], const __attribute__((address_space(1))) bf16x8* const (&ap)[2], const __attribute__((address_space(1))) bf16x8* const (&bp)[NB16], int s0) {
    bf16x8 a[U][2], b[U][NB16];
#pragma unroll
    for (int u = 0; u < U; ++u) {
#pragma unroll
        for (int ra = 0; ra < 2; ++ra) a[u][ra] = ap[ra][(s0 + u) * 4];
#pragma unroll
        for (int cb = 0; cb < NB16; ++cb) b[u][cb] = bp[cb][(s0 + u) * 4]; }
    SBAR();
#pragma unroll
    for (int u = 0; u < U; ++u)
#pragma unroll
        for (int ra = 0; ra < 2; ++ra)
#pragma unroll
            for (int cb = 0; cb < NB16; ++cb) acc[ra][cb] = __builtin_amdgcn_mfma_f32_16x16x32_bf16(a[u][ra], b[u][cb], acc[ra][cb], 0, 0, 0);
    SBAR();
}
template <int NB, class F>
__device__ __forceinline__ void sg_item16(int wv, char* lds, const bf16_t* A  , int K, const SgB<NB>& B, const F& f) {
    constexpr int NB16 = 2 * NB, NBC = NB * 32, NV = NBC / 16;
    const int tid = ltid(wv), lane = tid & 63, c16 = lane & 15, q = lane >> 4;
    LAS float* L = (LAS float*)lds;
    const int k0 = wv * (K >> 3), nst = K >> 8;
    typedef __attribute__((address_space(1))) bf16x8 gbf8;
    const size_t lo = (size_t)c16 * K + k0 + q * 8;
    const gbf8* ap[2]; const gbf8* bp[NB16];
#pragma unroll
    for (int ra = 0; ra < 2; ++ra) ap[ra] = (const gbf8*)(A + (size_t)(ra * 16) * K + lo);
#pragma unroll
    for (int cb = 0; cb < NB16; ++cb) bp[cb] = (const gbf8*)(B.p[cb >> 1] + (size_t)((cb & 1) * 16) * K + lo);
    f32x4 acc[2][NB16];
#pragma unroll
    for (int ra = 0; ra < 2; ++ra)
#pragma unroll
        for (int cb = 0; cb < NB16; ++cb) acc[ra][cb] = (f32x4){0.f, 0.f, 0.f, 0.f};
    int s0 = 0;
    for (; s0 + 4 <= nst; s0 += 4) sg16_batch<NB16, 4>(acc, ap, bp, s0);
    if (nst & 2) { sg16_batch<NB16, 2>(acc, ap, bp, s0); s0 += 2; }
    if (nst & 1) sg16_batch<NB16, 1>(acc, ap, bp, s0);
#pragma unroll
    for (int ra = 0; ra < 2; ++ra)
#pragma unroll
        for (int cb = 0; cb < NB16; ++cb)
#pragma unroll
            for (int r = 0; r < 4; ++r) L[(wv * 32 + ra * 16 + 4 * q + r) * NBC + cb * 16 + c16] = acc[ra][cb][r];
    __syncthreads();
    const int row = 4 * wv + (lane >> 4), c0 = (lane & 15) * NV;
    float v[NV];
#pragma unroll
    for (int e = 0; e < NV; ++e) v[e] = 0.f;
#pragma unroll
    for (int w = 0; w < 8; ++w)
#pragma unroll
        for (int e4 = 0; e4 < NV / 4; ++e4) { const f32x4 t = *(const LAS f32x4*)(L + (w * 32 + row) * NBC + c0 + e4 * 4); v[e4 * 4] += t[0]; v[e4 * 4 + 1] += t[1]; v[e4 * 4 + 2] += t[2]; v[e4 * 4 + 3] += t[3]; }
    f(row, c0, lane & 15, v);
    __syncthreads();
}
typedef __attribute__((address_space(1))) f32x4 gf4; typedef __attribute__((address_space(1))) u32x4 gu4; typedef __attribute__((address_space(1))) u32x2 gu2; typedef __attribute__((address_space(1))) float gf1;
__device__ __forceinline__ unsigned pkbf(float lo, float hi) { return cvtpk(lo, hi); }
#define SG_ROWS(it) const int rb = (it) & 7, cbk = (it) >> 3
__device__ __forceinline__ int sg_vb() { const int b = lbid(), G = (int)gridDim.x; return (G & 7) ? b : (b & 7) * (G >> 3) + (b >> 3); }
__device__ __forceinline__ void sg_rope64(float (&y)[4], int c0, int l16, const float* tab_row  ) {
#pragma unroll
    for (int e = 0; e < 4; ++e) { const float pr = x8_16(y[e]); const int i = (c0 + e) & 31; const float c = tab_row[2 * i], s = tab_row[2 * i + 1]; y[e] = l16 < 8 ? y[e] * c - pr * s : y[e] * c + pr * s; }
}

__device__ __forceinline__ void sg_mla_in(const Params& p, int wv, char* lds, const bf16_t* A, const bf16_t* Bt, int j, const ssq_t* ssq_h) {
    bf16_t* CQ = (bf16_t*)(wsp(p) + WS_CQ); bf16_t* CKV = (bf16_t*)(wsp(p) + WS_CKV); bf16_t* KRB = (bf16_t*)(wsp(p) + WS_KRB + (size_t)j * KRB_STRIDE);
    ssq_t* ssq_q = (ssq_t*)(wsp(p) + WS_SSQQ) + (size_t)j * MR; ssq_t* ssq_kv = (ssq_t*)(wsp(p) + WS_SSQKV) + (size_t)j * MR; float* out = outp(p);
    const float* gkr = inp(p, 17) + j * 64; const float* tm = (const float*)(wsp(p) + WS_TABM);
    for (int it = sg_vb(); it < 8 * 17; it += gridDim.x) { SG_ROWS(it); const int K = DM;
        SgB<2> B; if (cbk < 16) { B.p[0] = Bt + (size_t)(cbk * 64) * K; B.p[1] = B.p[0] + (size_t)32 * K; } else { B.p[0] = Bt + (size_t)1024 * K; B.p[1] = Bt + (size_t)1152 * K; }
        sg_item<2, 8>(wv, lds, A + (size_t)(rb * 32) * K, K, B, [&](int row, int c0, int l16, const float (&v)[4]) {
            const int m = NPR + rb * 32 + row; const float rs = rsqrtf(ssq_val(ssq_h, m) * (1.0f / DM) + EPS); float x[4];
#pragma unroll
            for (int e = 0; e < 4; ++e) x[e] = v[e] * rs;
            if (cbk < 16) { const bool iskv = cbk >= 8; const int c = (cbk & 7) * 64 + c0; const float ss = g16_sum(x[0] * x[0] + x[1] * x[1] + x[2] * x[2] + x[3] * x[3]);
                u32x2 w; w.x = pkbf(x[0], x[1]); w.y = pkbf(x[2], x[3]); *(gu2*)((iskv ? CKV : CQ) + (size_t)m * 512 + c) = w;
                if (iskv) *(gf4*)(out + O_LATS + ((size_t)j * NSR + (m - NPR)) * 512 + c) = (f32x4){x[0], x[1], x[2], x[3]};
                if (l16 == 0) ssq_add(iskv ? ssq_kv : ssq_q, m, ss);
            } else { const float r2 = rsqrtf(g16_sum(x[0] * x[0] + x[1] * x[1] + x[2] * x[2] + x[3] * x[3]) * (1.0f / 64) + EPS); float y[4];
#pragma unroll
                for (int e = 0; e < 4; ++e) y[e] = x[e] * r2 * gkr[c0 + e];
                sg_rope64(y, c0, l16, tm + (size_t)pos_of_row(m) * 64);
                *(gf4*)(out + O_KRS + ((size_t)j * NSR + (m - NPR)) * 64 + c0) = (f32x4){y[0], y[1], y[2], y[3]};
                u32x2 w; w.x = pkbf(y[0], y[1]); w.y = pkbf(y[2], y[3]); *(gu2*)(KRB + (size_t)latrow_of(m) * 64 + c0) = w; }
        });
    }
}
__device__ __forceinline__ void sg_mla_up(const Params& p, int wv, char* lds, const bf16_t* Wq, const bf16_t* Wkvf, int j) {
    const bf16_t* CQ = (const bf16_t*)(wsp(p) + WS_CQ) + (size_t)NPR * 512; const bf16_t* CKV = (const bf16_t*)(wsp(p) + WS_CKV) + (size_t)NPR * 512;
    bf16_t* Q = (bf16_t*)(wsp(p) + WS_Q); bf16_t* KV = (bf16_t*)(wsp(p) + WS_KV);
    const ssq_t* ssq_q = (const ssq_t*)(wsp(p) + WS_SSQQ) + (size_t)j * MR; const ssq_t* ssq_kv = (const ssq_t*)(wsp(p) + WS_SSQKV) + (size_t)j * MR;
    const float* gqn = inp(p, 14) + j * 128; const float* gqr = inp(p, 15) + j * 64; const float* gkn = inp(p, 16) + j * 128; const float* tm = (const float*)(wsp(p) + WS_TABM);
    const int K = 512;
    for (int it = sg_vb(); it < 8 * 64; it += gridDim.x) { SG_ROWS(it);
        if (cbk < 16 || cbk >= 32) {
            const int kind = cbk < 16 ? 0 : (cbk < 48 ? 1 : 2), hd = cbk & 15;
            const bf16_t* W0 = kind == 0 ? Wq + (size_t)(128 * hd) * K : Wkvf + (size_t)(256 * hd + (kind == 2 ? 128 : 0)) * K;
            SgB<4> B;
#pragma unroll
            for (int q = 0; q < 4; ++q) B.p[q] = W0 + (size_t)(32 * q) * K;
            sg_item<4, 4>(wv, lds, (kind == 0 ? CQ : CKV) + (size_t)(rb * 32) * K, K, B, [&](int row, int c0, int l16, const float (&v)[8]) {
                const int m = NPR + rb * 32 + row; const float rs = rsqrtf(ssq_val(kind == 0 ? ssq_q : ssq_kv, m) * (1.0f / 512) + EPS); float x[8], ss = 0.f;
#pragma unroll
                for (int e = 0; e < 8; ++e) { x[e] = v[e] * rs; ss += x[e] * x[e]; }
                if (kind != 2) { const float r2 = rsqrtf(g16_sum(ss) * (1.0f / 128) + EPS); const float* g = kind == 0 ? gqn : gkn;
#pragma unroll
                    for (int e = 0; e < 8; ++e) x[e] *= r2 * g[c0 + e]; }
                u32x4 w; w.x = pkbf(x[0], x[1]); w.y = pkbf(x[2], x[3]); w.z = pkbf(x[4], x[5]); w.w = pkbf(x[6], x[7]);
                bf16_t* dst = kind == 0 ? Q + (size_t)m * NQUP + hd * 192 + c0 : KV + (size_t)latrow_of(m) * NKVUP + hd * 256 + (kind == 2 ? 128 : 0) + c0;
                *(gu4*)dst = w;
            });
        } else {
            const int hd = cbk - 16, t = hd >> 2, wc = hd & 3; SgB<2> B; B.p[0] = Wq + (size_t)(2048 + 256 * t + 32 * wc) * K; B.p[1] = B.p[0] + (size_t)128 * K;
            sg_item<2, 4>(wv, lds, CQ + (size_t)(rb * 32) * K, K, B, [&](int row, int c0, int l16, const float (&v)[4]) {
                const int m = NPR + rb * 32 + row; const float rs = rsqrtf(ssq_val(ssq_q, m) * (1.0f / 512) + EPS); float y[4], ss = 0.f;
#pragma unroll
                for (int e = 0; e < 4; ++e) { y[e] = v[e] * rs; ss += y[e] * y[e]; }
                const float r2 = rsqrtf(g16_sum(ss) * (1.0f / 64) + EPS);
#pragma unroll
                for (int e = 0; e < 4; ++e) y[e] *= r2 * gqr[c0 + e];
                sg_rope64(y, c0, l16, tm + (size_t)pos_of_row(m) * 64);
                u32x2 w; w.x = pkbf(y[0], y[1]); w.y = pkbf(y[2], y[3]); *(gu2*)(Q + (size_t)m * NQUP + hd * 192 + 128 + c0) = w;
            });
        }
    }
}
template <int U>
__device__ __forceinline__ void sg_resid(const Params& p, int wv, char* lds, const bf16_t* A, int K, const bf16_t* Bt, const bf16_t* hin, bf16_t* hout, ssq_t* ssq_out, const bf16_t* t, const ssq_t* ssq_in) {
    for (int it = sg_vb(); it < 8 * 32; it += gridDim.x) { SG_ROWS(it);
        SgB<2> B; B.p[0] = Bt + (size_t)(cbk * 64) * K; B.p[1] = B.p[0] + (size_t)32 * K;
        sg_item16<2>(wv, lds, A + (size_t)(rb * 32) * K, K, B, [&](int row, int c0, int l16, const float (&v)[4]) {
            const int m = NPR + rb * 32 + row; const size_t off = (size_t)m * DM + cbk * 64 + c0; const u32x2 hw = *(const gu2*)(hin + off); float o[4];
            const float hv[4] = {__uint_as_float(hw.x << 16), __uint_as_float(hw.x & 0xffff0000u), __uint_as_float(hw.y << 16), __uint_as_float(hw.y & 0xffff0000u)};
            if (t) { const float rs = rsqrtf(ssq_val(ssq_in, m) * (1.0f / DM) + EPS); const u32x2 tw = *(const gu2*)(t + off);
                const float tf[4] = {__uint_as_float(tw.x << 16), __uint_as_float(tw.x & 0xffff0000u), __uint_as_float(tw.y << 16), __uint_as_float(tw.y & 0xffff0000u)};
#pragma unroll
                for (int e = 0; e < 4; ++e) o[e] = hv[e] + tf[e] * __builtin_amdgcn_rcpf(1.0f + __expf(-v[e] * rs));
            } else {
#pragma unroll
                for (int e = 0; e < 4; ++e) o[e] = hv[e] + v[e]; }
            u32x2 w; w.x = pkbf(o[0], o[1]); w.y = pkbf(o[2], o[3]); *(gu2*)(hout + off) = w;
            const float ss = g16_sum(o[0] * o[0] + o[1] * o[1] + o[2] * o[2] + o[3] * o[3]);
            if (l16 == 0) ssq_add(ssq_out, m, ss);
        });
    }
}
__device__ __forceinline__ void sg_ffn_up(const Params& p, int wv, char* lds, const bf16_t* A, const bf16_t* Wgu, const ssq_t* ssq_in) {
    bf16_t* act = (bf16_t*)(wsp(p) + WS_ACT); const int K = DM;
    for (int it = sg_vb(); it < 8 * (DFF / 64); it += gridDim.x) { SG_ROWS(it); const int tl = cbk >> 1, hf = (cbk & 1) * 64;
        SgB<4> B; B.p[0] = Wgu + (size_t)(256 * tl + hf) * K; B.p[1] = B.p[0] + (size_t)32 * K; B.p[2] = B.p[0] + (size_t)128 * K; B.p[3] = B.p[2] + (size_t)32 * K;
        sg_item<4, 4>(wv, lds, A + (size_t)(rb * 32) * K, K, B, [&](int row, int c0, int l16, const float (&v)[8]) {
            const int m = NPR + rb * 32 + row; const float rs = rsqrtf(ssq_val(ssq_in, m) * (1.0f / DM) + EPS); float o[8];
#pragma unroll
            for (int e = 0; e < 8; ++e) { const float mine = v[e] * rs, other = x8_16(mine); o[e] = mine * __builtin_amdgcn_rcpf(1.0f + __expf(-mine)) * other; }
            if (l16 < 8) { u32x4 w; w.x = pkbf(o[0], o[1]); w.y = pkbf(o[2], o[3]); w.z = pkbf(o[4], o[5]); w.w = pkbf(o[6], o[7]);
                *(gu4*)(act + (size_t)m * DFF + 128 * tl + hf + c0) = w; }
        });
    }
}
__device__ __forceinline__ void sg_store_bf16(const Params& p, int wv, char* lds, const bf16_t* A, int K, const bf16_t* Bt, bf16_t* C, int ldc, int ncb) {
    for (int it = sg_vb(); it < 8 * ncb; it += gridDim.x) { SG_ROWS(it);
        SgB<2> B; B.p[0] = Bt + (size_t)(cbk * 64) * K; B.p[1] = B.p[0] + (size_t)32 * K;
        sg_item<2, 2>(wv, lds, A + (size_t)(rb * 32) * K, K, B, [&](int row, int c0, int l16, const float (&v)[4]) {
            const int m = NPR + rb * 32 + row; u32x2 w; w.x = pkbf(v[0], v[1]); w.y = pkbf(v[2], v[3]); *(gu2*)(C + (size_t)m * ldc + cbk * 64 + c0) = w; });
    }
}
__device__ __forceinline__ void sg_swa_qkv(const Params& p, int wv, char* lds, const bf16_t* A, const bf16_t* Bt, int j, const ssq_t* ssq_h) {
    bf16_t* SQ = (bf16_t*)(wsp(p) + WS_SQ); bf16_t* SK = (bf16_t*)(wsp(p) + WS_SKB + (size_t)j * SKB_STRIDE); bf16_t* SV = (bf16_t*)(wsp(p) + WS_SVB + (size_t)j * SKB_STRIDE);
    const float* gq = inp(p, 20) + j * 64; const float* gk = inp(p, 21) + j * 64; const float* ts = (const float*)(wsp(p) + WS_TABS); float* out = outp(p); const int K = DM;
    for (int it = sg_vb(); it < 8 * 40; it += gridDim.x) { SG_ROWS(it);
        SgB<2> B;
        if (cbk < 36) { const int t = cbk >> 2, wc = cbk & 3; B.p[0] = Bt + (size_t)(256 * t + 32 * wc) * K; B.p[1] = B.p[0] + (size_t)128 * K; }
        else { B.p[0] = Bt + (size_t)(2304 + 64 * (cbk - 36)) * K; B.p[1] = B.p[0] + (size_t)32 * K; }
        sg_item<2, 8>(wv, lds, A + (size_t)(rb * 32) * K, K, B, [&](int row, int c0, int l16, const float (&v)[4]) {
            const int m = NPR + rb * 32 + row, b = (m - NPR) >> 4, tt = (m - NPR) & 15; const float rs = rsqrtf(ssq_val(ssq_h, m) * (1.0f / DM) + EPS); float x[4];
#pragma unroll
            for (int e = 0; e < 4; ++e) x[e] = v[e] * rs;
            const size_t so = (((size_t)j * 16 + b) * 128 + 112 + tt) * 256;
            if (cbk < 36) { const bool isk = cbk >= 32; const int bj = c0 >> 5, i0 = c0 & 31, d0 = swa_dim(bj, i0);
                const float r2 = rsqrtf(g16_sum(x[0] * x[0] + x[1] * x[1] + x[2] * x[2] + x[3] * x[3]) * (1.0f / 64) + EPS); const float* g = isk ? gk : gq;
#pragma unroll
                for (int e = 0; e < 4; ++e) x[e] *= r2 * g[d0 + e];
                const float* tp = ts + (size_t)pos_of_row(m) * 16;
#pragma unroll
                for (int e = 0; e < 4; ++e) { const float pr = x8_16(x[e]); const int d = (i0 + e) & 7; const float c = tp[2 * d], s = tp[2 * d + 1];
                    if (i0 < 8) x[e] = bj == 0 ? x[e] * c - pr * s : x[e] * c + pr * s; }
                u32x2 w; w.x = pkbf(x[0], x[1]); w.y = pkbf(x[2], x[3]);
                if (!isk) *(gu2*)(SQ + (size_t)m * DM + cbk * 64 + c0) = w;
                else { const int g4 = cbk - 32; *(gu2*)(SK + (size_t)skrow_of(m) * 256 + g4 * 64 + c0) = w; *(gf4*)(out + O_SKS + so + g4 * 64 + d0) = (f32x4){x[0], x[1], x[2], x[3]}; }
            } else { const int c = (cbk - 36) * 64 + c0; u32x2 w; w.x = pkbf(x[0], x[1]); w.y = pkbf(x[2], x[3]);
                *(gu2*)(SV + (size_t)skrow_of(m) * 256 + c) = w; *(gf4*)(out + O_SVS + so + c) = (f32x4){x[0], x[1], x[2], x[3]}; }
        });
    }
}

#define XB_TMO      128
#define XB_XCNT(j)  (256  + 64 * (j))
#define XB_XSUB(j)  (1280 + 64 * (j))
#define XB_XGEN(j)  (2304 + 64 * (j))
#define XB_TOP      3328
#define XB_TOPGEN   3392
#define XCD_BAR_WORDS 3456
#define XB_SPIN_CAP (1u << 18)

__device__ __forceinline__ unsigned xb_ld(unsigned* p)              { return __hip_atomic_load(p, __ATOMIC_RELAXED, __HIP_MEMORY_SCOPE_AGENT); }
__device__ __forceinline__ unsigned xb_add(unsigned* p, unsigned v) { return __hip_atomic_fetch_add(p, v, __ATOMIC_RELAXED, __HIP_MEMORY_SCOPE_AGENT); }
__device__ __forceinline__ unsigned xb_xcc_id() { return (unsigned)__builtin_amdgcn_s_getreg((3 << 11) | 20) & 0xFu; }
#define XB_SPIN(cond, bar) do { unsigned _sp = 0; while (cond) { __builtin_amdgcn_s_sleep(1); \
    if ((++_sp & 255u) == 0u) { if (xb_ld(&(bar)[XB_TMO])) break; if (_sp > XB_SPIN_CAP) { atomicAdd(&(bar)[XB_TMO], 1u); break; } } } } while (0)

struct XcdBarrier {
    unsigned* bar; unsigned x;
    volatile LAS unsigned* st;
};

__device__ __forceinline__ XcdBarrier xcd_barrier_post(unsigned* bar, volatile LAS unsigned* st, bool leader  ) {
    XcdBarrier b; b.bar = bar; b.x = xb_xcc_id(); b.st = st;
    if (leader) (void)xb_add(&bar[XB_XCNT(b.x)], 1u);
    return b;
}
__device__ __forceinline__ void xcd_barrier_complete(unsigned* bar, unsigned x, unsigned& nloc, unsigned& nx) {
    const unsigned G = gridDim.x * gridDim.y * gridDim.z;
    unsigned sum, cnt, mine, sp = 0u;
    for (;;) {
        sum = 0u; cnt = 0u; mine = 0u;
#pragma unroll
        for (unsigned j = 0; j < 16; ++j) { const unsigned c = xb_ld(&bar[XB_XCNT(j)]); sum += c; cnt += (c > 0u) ? 1u : 0u; }
        mine = xb_ld(&bar[XB_XCNT(x)]);
        if (sum == G) { mine = xb_ld(&bar[XB_XCNT(x)]); break; }
        __builtin_amdgcn_s_sleep(1);
        if ((++sp & 255u) == 0u) { if (xb_ld(&bar[XB_TMO])) break; if (sp > XB_SPIN_CAP) { atomicAdd(&bar[XB_TMO], 1u); break; } }
    }
    nloc = mine > 0u ? mine : 1u; nx = cnt > 0u ? cnt : 1u;
}

__device__ __forceinline__ void xcd_barrier(const XcdBarrier& b, bool leader) {
    asm volatile("s_waitcnt vmcnt(0)" ::: "memory");
    __syncthreads();
    if (leader) {
        unsigned* bar = b.bar;
        __builtin_amdgcn_s_waitcnt(0);
        unsigned nloc = b.st[0], nx = b.st[1];
        if (nloc == 0u) { xcd_barrier_complete(bar, b.x, nloc, nx); b.st[0] = nloc; b.st[1] = nx; }
        const unsigned old = xb_add(&bar[XB_XSUB(b.x)], 1u);
        const unsigned gen = old / nloc;
        if (old + 1u == (gen + 1u) * nloc) {
            __builtin_amdgcn_fence(__ATOMIC_RELEASE, "agent");
            asm volatile("s_waitcnt vmcnt(0)" ::: "memory");
            const unsigned og = xb_add(&bar[XB_TOP], 1u);
            const unsigned tg = og / nx;
            if (og + 1u == (tg + 1u) * nx) xb_add(&bar[XB_TOPGEN], 1u);
            else XB_SPIN(xb_ld(&bar[XB_TOPGEN]) == tg, bar);
            __builtin_amdgcn_fence(__ATOMIC_ACQUIRE, "agent");
            xb_add(&bar[XB_XGEN(b.x)], 1u);
            asm volatile("s_waitcnt vmcnt(0)" ::: "memory");
        } else {
            XB_SPIN(xb_ld(&bar[XB_XGEN(b.x)]) == gen, bar);
            __builtin_amdgcn_fence(__ATOMIC_ACQUIRE, "agent");
            asm volatile("s_waitcnt vmcnt(0)" ::: "memory");
        }
    }
    __syncthreads();
}

constexpr int LDS_BYTES = 147456;
constexpr int LDS_MISC = 141312 + 320;
constexpr int LDS_XCH = 131072 + 2048;
constexpr int CW_BAR = 4096;
__global__ void __launch_bounds__(512, 2) mega_fwd(Params p) {
    extern __shared__ __attribute__((aligned(16))) char lds[];
    volatile LAS unsigned* MISC = (volatile LAS unsigned*)((LAS char*)lds + LDS_MISC);
    for (int u = threadIdx.x; u < (LDS_BYTES - 131072) / 4; u += 512) ((LAS unsigned*)((LAS char*)lds + 131072))[u] = 0u;
    __syncthreads();
    PG8_LAS unsigned char* GL = (PG8_LAS unsigned char*)lds;
    const int WV = __builtin_amdgcn_readfirstlane((int)threadIdx.x >> 6);
    XcdBarrier bar = xcd_barrier_post((unsigned*)(p.ws + WS_CTL) + CW_BAR, MISC + 8, ltid(WV) == 0);
#define GRID_BAR() do { XcdBarrier b2_ = bar; b2_.bar = (unsigned*)(wsp(p) + WS_CTL) + CW_BAR; b2_.x = xb_xcc_id(); xcd_barrier(b2_, ltid(WV) == 0); } while (0)
#define HBX ((bf16_t*)(wsp(p) + ((i & 1) ? WS_HB1 : WS_HB0)))
#define OB ((bf16_t*)outp(p))
#define HBY ((bf16_t*)(wsp(p) + ((i & 1) ? WS_HB0 : WS_HB1)))
#define SSQ(k) ((ssq_t*)(wsp(p) + WS_SSQ) + (size_t)(k) * MR)
#define WB(off) ((const bf16_t*)(wsp(p) + WS_W) + (off))
#define XCH ((pg8::lfloat*)(GL + LDS_XCH))
#define RUN_GEMM4(EPI, A_, B_, M_, N_, K_, ...) do { pg8::Gemm g_{A_, B_, M_, N_, K_}; pg8::StaticOrder S_; S_.init(M_, N_, gridDim.x, lbid(), 4); pg8::EPI E_{__VA_ARGS__}; \
        pg8::gemm_phase<pg8::EPI, pg8::StaticOrder, true, true>(WV, GL, g_, S_, E_); } while (0)
#define RUN_GEMM(EPI, A_, B_, M_, N_, K_, ...) do { pg8::Gemm g_{A_, B_, M_, N_, K_}; pg8::StaticOrder S_; S_.init(M_, N_, gridDim.x, lbid()); pg8::EPI E_{__VA_ARGS__}; \
        pg8::gemm_phase<pg8::EPI, pg8::StaticOrder, true, true>(WV, GL, g_, S_, E_); } while (0)
    ph_tables(p, WV); ph_convert_w(p, WV, lds); ph_init_h(p, WV); ph_caches(p, WV);
    GRID_BAR();
    for (int i = 0; i < 4; ++i) {
        const int j = i >> 1;
        if ((i & 1) == 0) {
            const size_t wm = (size_t)j * WE_MLA;
            RUN_GEMM(EpiMlaIn, HBX, WB(wm + WO_IN), MR, 1280, DM,
                     (bf16_t*)(wsp(p) + WS_CQ), (bf16_t*)(wsp(p) + WS_CKV), (bf16_t*)(wsp(p) + WS_KRB + (size_t)j * KRB_STRIDE), outp(p), j, SSQ(3 * i),
                     (ssq_t*)(wsp(p) + WS_SSQQ) + (size_t)j * MR, (ssq_t*)(wsp(p) + WS_SSQKV) + (size_t)j * MR, inp(p, 17) + j * 64, (const float*)(wsp(p) + WS_TABM));
            GRID_BAR();
            RUN_GEMM(EpiQup, (const bf16_t*)(wsp(p) + WS_CQ), WB(wm + WO_QUP), MR, NQUP, 512,
                     (bf16_t*)(wsp(p) + WS_Q), (const ssq_t*)(wsp(p) + WS_SSQQ) + (size_t)j * MR, inp(p, 14) + j * 128, inp(p, 15) + j * 64, (const float*)(wsp(p) + WS_TABM), XCH);
            { const int G_ = (int)gridDim.x, b_ = lbid(); pg8::Gemm g_{(const bf16_t*)(wsp(p) + WS_CKV), WB(wm + WO_KVF), MR, NKVUP, 512}; pg8::StaticOrder S_; S_.init(MR, NKVUP, G_, (b_ + G_ - (G_ >= 32 ? 16 : 0)) % G_);
              pg8::EpiKvup E_{(bf16_t*)(wsp(p) + WS_KV), (const ssq_t*)(wsp(p) + WS_SSQKV) + (size_t)j * MR, inp(p, 16) + j * 128, XCH}; pg8::gemm_phase<pg8::EpiKvup, pg8::StaticOrder, true, true>(WV, GL, g_, S_, E_); }
            RUN_GEMM(EpiKvup, (const bf16_t*)(wsp(p) + WS_LATC) + (size_t)j * 16384 * 512, WB(wm + WO_KVP), 16384, NKVUP, 512,
                     (bf16_t*)(wsp(p) + WS_KV), nullptr, inp(p, 16) + j * 128, XCH);
            { const int G_ = (int)gridDim.x, b_ = lbid(), lo_ = G_ >= 64 ? 32 : 0; if (b_ >= lo_) ph_lat_fix(p, WV, j, b_ - lo_, G_ - lo_); }
            GRID_BAR();
            ph_mla_attn(p, WV, (const bf16_t*)(wsp(p) + WS_KRB + (size_t)j * KRB_STRIDE), OB, lds);
            GRID_BAR();
            ph_ple_prep(p, WV, i);
            RUN_GEMM4(EpiResidF32, OB, WB(wm + WO_MOUT), NPR, DM, DM, HBX, HBY, SSQ(3 * i + 1));
            sg_resid<8>(p, WV, lds, OB + (size_t)NPR * DM, DM, WB(wm + WO_MOUT), HBX, HBY, SSQ(3 * i + 1), nullptr, nullptr);
            GRID_BAR();
        } else {
            const size_t wsw = WE_SWA0 + (size_t)j * WE_SWA;
            RUN_GEMM(EpiSwaQkv, HBX, WB(wsw + WO_QKV), MR, NQKV, DM,
                     (bf16_t*)(wsp(p) + WS_SQ), (bf16_t*)(wsp(p) + WS_SKB + (size_t)j * SKB_STRIDE), (bf16_t*)(wsp(p) + WS_SVB + (size_t)j * SKB_STRIDE), outp(p), j, SSQ(3 * i),
                     inp(p, 20) + j * 64, inp(p, 21) + j * 64, (const float*)(wsp(p) + WS_TABS));
            GRID_BAR();
            ph_swa_attn(p, WV, j, (const bf16_t*)(wsp(p) + WS_SKB + (size_t)j * SKB_STRIDE), (const bf16_t*)(wsp(p) + WS_SVB + (size_t)j * SKB_STRIDE), OB, lds);
            GRID_BAR();
            ph_ple_prep(p, WV, i);
            RUN_GEMM4(EpiResidF32, OB, WB(wsw + WO_SOUT), NPR, DM, DM, HBX, HBY, SSQ(3 * i + 1));
            sg_resid<8>(p, WV, lds, OB + (size_t)NPR * DM, DM, WB(wsw + WO_SOUT), HBX, HBY, SSQ(3 * i + 1), nullptr, nullptr);
            GRID_BAR();
        }
        const size_t wl = WE_L0 + (size_t)i * WE_L;
        RUN_GEMM(EpiSwigluBf16, HBY, WB(wl + WO_G), MR, 2 * DFF, DM, (bf16_t*)(wsp(p) + WS_ACT), DFF, SSQ(3 * i + 1));
        {
          const int G_ = (int)gridDim.x, nbusy_ = (65 * 44) % G_, b_ = lbid();
          if (b_ >= nbusy_) { pg8::Gemm g_{(const bf16_t*)(wsp(p) + WS_PB), WB(wl + WO_PP), MR, DM, PLE}; pg8::StaticOrder S_; S_.init(MR, DM, G_ - nbusy_, b_ - nbusy_);
              pg8::EpiStoreBf16 E_{(bf16_t*)(wsp(p) + WS_T32), DM}; pg8::gemm_phase<pg8::EpiStoreBf16, pg8::StaticOrder, true, true>(WV, GL, g_, S_, E_); } }
        GRID_BAR();
        { pg8::Gemm g_{(const bf16_t*)(wsp(p) + WS_ACT), WB(wl + WO_D), NPR, DM, DFF}; pg8::StaticOrder S_; S_.init(NPR, DM, gridDim.x, lbid(), 4);
          pg8::EpiResidF32 E_{HBY, HBX, SSQ(3 * i + 2)}; pg8::gemm_phase<pg8::EpiResidF32, pg8::StaticOrder, true, true>(WV, GL, g_, S_, E_); }
        sg_resid<11>(p, WV, lds, (const bf16_t*)(wsp(p) + WS_ACT) + (size_t)NPR * DFF, DFF, WB(wl + WO_D), HBY, HBX, SSQ(3 * i + 2), nullptr, nullptr);
        GRID_BAR();
        RUN_GEMM4(EpiPleF32, HBX, WB(wl + WO_PG), NPR, DM, DM, HBX, (const bf16_t*)(wsp(p) + WS_T32), HBY, SSQ(3 * i + 2), SSQ(3 * i + 3));
        sg_resid<8>(p, WV, lds, HBX + (size_t)NPR * DM, DM, WB(wl + WO_PG), HBX, HBY, SSQ(3 * i + 3), (const bf16_t*)(wsp(p) + WS_T32), SSQ(3 * i + 2));
        GRID_BAR();
    }
    ph_final(p, WV);
#undef GRID_BAR
#undef HBX
#undef OB
#undef HBY
#undef SSQ
#undef WB
#undef XCH
#undef RUN_GEMM
#undef RUN_GEMM4
}

__global__ void k_report(float* out, float v) { if (threadIdx.x == 0 && blockIdx.x == 0) out[0] = v; }

extern "C" void kernel_launch(void* const* d_in, const int* in_sizes, int n_in, void* d_out, int out_size, void* d_ws, size_t ws_size, hipStream_t stream) {
    if (n_in != 32 || (size_t)out_size != O_END || ws_size < WS_END) {
        fprintf(stderr, "kernel_launch: unexpected sizes n_in %d out %d ws %zu (need %zu)\n", n_in, out_size, ws_size, (size_t)WS_END);
        hipLaunchKernelGGL(k_report, dim3(1), dim3(64), 0, stream, (float*)d_out, (float)(ws_size >> 20));
        return;
    }
    Params p{};
    for (int k = 0; k < 32; ++k) p.in[k] = (const float*)d_in[k];
    p.out = (float*)d_out; p.ws = (unsigned char*)d_ws;
    static int grid = 0;
    if (grid == 0) {
        int dev = 0, cus = 0, per_cu = 0;
        if (hipGetDevice(&dev) != hipSuccess || hipDeviceGetAttribute(&cus, hipDeviceAttributeMultiprocessorCount, dev) != hipSuccess) { fprintf(stderr, "kernel_launch: device query failed\n"); grid = -1; return; }
        if (hipFuncSetAttribute((const void*)mega_fwd, hipFuncAttributeMaxDynamicSharedMemorySize, LDS_BYTES) != hipSuccess) { fprintf(stderr, "kernel_launch: hipFuncSetAttribute failed\n"); grid = -1; return; }
        if (hipOccupancyMaxActiveBlocksPerMultiprocessor(&per_cu, (const void*)mega_fwd, 512, LDS_BYTES) != hipSuccess || per_cu < 1) fprintf(stderr, "kernel_launch: occupancy query says %d\n", per_cu);
        (void)hipGetLastError();
        grid = cus;
    }
    if (grid < 0) return;
    (void)hipMemsetAsync((char*)d_ws + WS_CTL, 0, CTL_BYTES, stream);
    hipLaunchKernelGGL(mega_fwd, dim3(grid), dim3(512), LDS_BYTES, stream, p);
}
```

```cpp
#include <hip/hip_runtime.h>
#include <cstdint>
#include <cstdio>

#define LAS __attribute__((address_space(3)))
typedef unsigned short bf16_t;
typedef short bf16x8 __attribute__((ext_vector_type(8)));
typedef short s16x4 __attribute__((ext_vector_type(4)));
typedef float f32x4 __attribute__((ext_vector_type(4)));
typedef float f32x16 __attribute__((ext_vector_type(16)));
typedef unsigned u32x4 __attribute__((ext_vector_type(4)));
typedef unsigned u32x2 __attribute__((ext_vector_type(2)));

__device__ __forceinline__ int ltid(int wv) { int t = (wv << 6) | (int)__builtin_amdgcn_mbcnt_hi(~0u, __builtin_amdgcn_mbcnt_lo(~0u, 0u)); asm volatile("" : "+v"(t)); return t; }

constexpr int DM = 2048, SEQ = 4096, NPR = 4 * SEQ  , NSR = 256  , MR = NPR + NSR  ;
constexpr int PAST = 1024, DSEQ = 16, DBATCH = 16;
constexpr int KVPB = PAST + DSEQ;
constexpr int NKVR = NPR + DBATCH * KVPB;
constexpr int SWPB = 128 + DSEQ;
constexpr int NSKR = NPR + DBATCH * SWPB;
constexpr int DFF = 5632, PLE = 256;
constexpr int NIN_MLA = 1088, NQUP = 3072, NKVUP = 4096, NQKV = 2560;
constexpr float EPS = 1e-6f;
constexpr float LOG2E = 1.4426950408889634f;

constexpr size_t O_Y = 0;
constexpr size_t O_LATP = (size_t)MR * DM;
constexpr size_t O_KRP = O_LATP + (size_t)2 * NPR * 512;
constexpr size_t O_SKP = O_KRP + (size_t)2 * NPR * 64;
constexpr size_t O_SVP = O_SKP + (size_t)2 * 4 * 128 * 256;
constexpr size_t O_LATS = O_SVP + (size_t)2 * 4 * 128 * 256;
constexpr size_t O_KRS = O_LATS + (size_t)2 * NSR * 512;
constexpr size_t O_SKS = O_KRS + (size_t)2 * NSR * 64;
constexpr size_t O_SVS = O_SKS + (size_t)2 * 16 * 128 * 256;
constexpr size_t O_END = O_SVS + (size_t)2 * 16 * 128 * 256;
static_assert(O_END == 55869440, "output size");

constexpr size_t MiB = 1u << 20;
constexpr size_t al256(size_t x) { return (x + 255) & ~(size_t)255; }
constexpr size_t WS_CTL = 0, CTL_BYTES = 3 * MiB;
typedef unsigned long long ssq_t;
constexpr size_t WS_SSQ = 65536;
constexpr size_t WS_SSQQ = 2 * MiB, WS_SSQKV = WS_SSQQ + 2 * (size_t)MR * 8;
static_assert(WS_SSQ + 13 * (size_t)MR * 8 <= WS_SSQQ && WS_SSQKV + 2 * (size_t)MR * 8 <= CTL_BYTES, "ctl");
constexpr size_t WS_TABM = 3 * MiB, WS_TABS = 4 * MiB, WS_W = 5 * MiB;
constexpr size_t WO_IN = 0, WO_QUP = 2621440, WO_KVP = 4194304, WO_KVF = 6291456, WO_MOUT = 8388608, WE_MLA = 12582912;
constexpr size_t WO_QKV = 0, WO_SOUT = 5242880, WE_SWA = 9437184;
constexpr size_t WO_G = 0, WO_D = 23068672, WO_PG = 34603008, WO_PP = 38797312, WE_L = 39321600;
constexpr size_t WE_SWA0 = 2 * WE_MLA, WE_L0 = WE_SWA0 + 2 * WE_SWA, WE_END = WE_L0 + 4 * WE_L;
static_assert(WE_END == 201326592, "weights");
constexpr size_t WS_LATC = WS_W + WE_END * 2;
constexpr size_t WS_KRB = WS_LATC + 2 * (size_t)16384 * 512 * 2;
constexpr size_t KRB_STRIDE = al256((size_t)NKVR * 64 * 2);
constexpr size_t WS_SKB = WS_KRB + 2 * KRB_STRIDE;
constexpr size_t SKB_STRIDE = al256((size_t)NSKR * 256 * 2);
constexpr size_t WS_SVB = WS_SKB + 2 * SKB_STRIDE;
constexpr size_t HB_BYTES = (size_t)MR * DM * 2;
constexpr size_t WS_HB0 = al256(WS_SVB + 2 * SKB_STRIDE), WS_HB1 = WS_HB0 + HB_BYTES;
constexpr size_t WS_R = WS_HB1 + HB_BYTES;
constexpr size_t WS_CQ = WS_R, WS_CKV = WS_CQ + (size_t)MR * 512 * 2, WS_Q = WS_CKV + (size_t)MR * 512 * 2, WS_KV = WS_Q + (size_t)MR * NQUP * 2;
constexpr size_t WS_SQ = WS_R;
constexpr size_t WS_ACT = WS_R, WS_T32 = WS_ACT + (size_t)MR * DFF * 2, WS_PB = WS_T32 + (size_t)MR * DM * 4;
constexpr size_t WS_END = WS_KV + (size_t)NKVR * 4096 * 2;
static_assert(WS_PB + (size_t)MR * PLE * 2 <= WS_END, "ffn overlay");
static_assert(WS_END <= 984 * MiB, "ws budget (984 MiB was seen to be available)");
__device__ __forceinline__ float ssq_val(const ssq_t* q, size_t i) { return (float)((const __attribute__((address_space(1))) ssq_t*)q)[i] * (1.0f / 4096.0f); }
__device__ __forceinline__ void ssq_add(ssq_t* q, size_t i, float ss) { __hip_atomic_fetch_add((__attribute__((address_space(1))) ssq_t*)(q + i), (ssq_t)(ss * 4096.0f + 0.5f), __ATOMIC_RELAXED, __HIP_MEMORY_SCOPE_AGENT); }

struct Params {
    const float* in[32];
    float* out;
    unsigned char* ws;
};
__device__ __forceinline__ int opaque_i(int k) { asm volatile("" : "+v"(k)); return __builtin_amdgcn_readfirstlane(k); }
__device__ __forceinline__ int lbid() { int b = (int)blockIdx.x; asm volatile("" : "+s"(b)); return b; }
__device__ __forceinline__ const float* inp(const Params& p, int k) { return p.in[opaque_i(k)]; }
__device__ __forceinline__ unsigned long long opaque_u64(unsigned long long a) { unsigned lo = (unsigned)a, hi = (unsigned)(a >> 32); asm volatile("" : "+v"(lo), "+v"(hi));
    lo = __builtin_amdgcn_readfirstlane(lo); hi = __builtin_amdgcn_readfirstlane(hi); return ((unsigned long long)hi << 32) | lo; }
__device__ __forceinline__ unsigned char* wsp(const Params& p) { return (unsigned char*)opaque_u64((unsigned long long)p.ws); }
__device__ __forceinline__ float* outp(const Params& p) { return (float*)opaque_u64((unsigned long long)p.out); }

__device__ __forceinline__ float bf2f(bf16_t b) { return __uint_as_float(((unsigned)b) << 16); }
__device__ __forceinline__ unsigned f2bf(float f) { unsigned u = __float_as_uint(f); return (u + 0x7fffu + ((u >> 16) & 1u)) >> 16; }
__device__ __forceinline__ unsigned pk2(float lo, float hi) { return f2bf(lo) | (f2bf(hi) << 16); }
__device__ __forceinline__ float wave_sum(float v) {
#pragma unroll
    for (int o = 1; o < 64; o <<= 1) v += __shfl_xor(v, o);
    return v;
}
__device__ __forceinline__ int crow(int r, int hi) { return (r & 3) + 8 * (r >> 2) + 4 * hi; }
__device__ __forceinline__ int pos_of_row(int m) { return m < NPR ? (m & (SEQ - 1)) : PAST + ((m - NPR) & (DSEQ - 1)); }
__device__ __forceinline__ int latrow_of(int m) { return m < NPR ? m : NPR + ((m - NPR) >> 4) * KVPB + PAST + ((m - NPR) & 15); }
__device__ __forceinline__ int skrow_of(int m) { return m < NPR ? m : NPR + ((m - NPR) >> 4) * SWPB + 128 + ((m - NPR) & 15); }

typedef __attribute__((address_space(1))) float PG8_GASF; typedef __attribute__((address_space(1))) u32x4 PG8_GASU4;
__device__ __forceinline__ void ph_tables(const Params& p, int wv) {
    const int tix = ltid(wv);
    float* tm = (float*)(wsp(p) + WS_TABM); float* ts = (float*)(wsp(p) + WS_TABS);
    const int gt = lbid() * 512 + tix, ngt = gridDim.x * 512;
    for (int idx = gt; idx < 4096 * 32; idx += ngt) {
        const int pos = idx >> 5, i = idx & 31;
        const float inv = powf(10000.0f, -(float)i / 32.0f);
        const float ang = (float)pos * inv;
        tm[idx * 2] = cosf(ang); tm[idx * 2 + 1] = sinf(ang);
    }
    for (int idx = gt; idx < 4096 * 8; idx += ngt) {
        const int pos = idx >> 3, i = idx & 7;
        const float inv = powf(500000.0f, -(float)i / 8.0f);
        const float ang = (float)pos * inv;
        ts[idx * 2] = cosf(ang); ts[idx * 2 + 1] = sinf(ang);
    }
}

__device__ __forceinline__ int swa_dim(int bj, int i) { const int g = i >> 3, e = i & 7; return e < 2 ? 8 * bj + 2 * g + e : 16 + 24 * bj + 6 * g + (e - 2); }
struct WDesc { const float* src; const float* src2; bf16_t* dst; const float* gain; int K, Nsrc, Ndst, mode; };
__device__ __forceinline__ int wsrc_col(int mode, int r, bool& second) {
    second = false;
    if (mode == 1) { const int t = r >> 8, w = r & 255; second = w >= 128; return 128 * t + (w & 127); }
    if (mode == 3) { if (r < 1024) return r; const int w = r - 1024; return 1024 + 32 * ((w >> 7) & 1) + (w & 31); }
    if (mode == 4) { if (r < 2048) return (r >> 7) * 192 + (r & 127);
        const int w = r - 2048, t = w >> 8, bj = (w >> 7) & 1, wc = (w >> 5) & 3, i = w & 31; return (4 * t + wc) * 192 + 128 + 32 * bj + i; }
    if (mode == 5) { if (r >= 2304) return r;
        const int t = r >> 8, bj = (r >> 7) & 1, wc = (r >> 5) & 3, i = r & 31; return (t < 8 ? (4 * t + wc) * 64 : 2048 + wc * 64) + swa_dim(bj, i); }
    return r;
}
__device__ __forceinline__ WDesc wdesc(const Params& p, int idx) {
    bf16_t* W = (bf16_t*)(wsp(p) + WS_W); WDesc d; d.mode = 0; d.gain = nullptr; d.src2 = nullptr;
    if (idx < 10) { const int j = idx / 5, k = idx % 5; bf16_t* b = W + (size_t)j * WE_MLA;
        if (k == 0) { d.src = inp(p, 9) + (size_t)j * 2048 * NIN_MLA; d.dst = b + WO_IN; d.K = 2048; d.Nsrc = NIN_MLA; d.Ndst = 1280; d.mode = 3; d.gain = inp(p, 8) + (2 * j) * DM; }
        else if (k == 1) { d.src = inp(p, 11) + (size_t)j * 512 * NQUP; d.dst = b + WO_QUP; d.K = 512; d.Nsrc = NQUP; d.Ndst = NQUP; d.mode = 4; d.gain = inp(p, 10) + j * 512; }
        else if (k == 2) { d.src = inp(p, 13) + (size_t)j * 512 * NKVUP; d.dst = b + WO_KVP; d.K = 512; d.Nsrc = NKVUP; d.Ndst = NKVUP; }
        else if (k == 3) { d.src = inp(p, 13) + (size_t)j * 512 * NKVUP; d.dst = b + WO_KVF; d.K = 512; d.Nsrc = NKVUP; d.Ndst = NKVUP; d.gain = inp(p, 12) + j * 512; }
        else { d.src = inp(p, 18) + (size_t)j * 2048 * 2048; d.dst = b + WO_MOUT; d.K = 2048; d.Nsrc = 2048; d.Ndst = 2048; }
    } else if (idx < 14) { const int j = (idx - 10) >> 1, k = (idx - 10) & 1; bf16_t* b = W + WE_SWA0 + (size_t)j * WE_SWA;
        if (k == 0) { d.src = inp(p, 19) + (size_t)j * 2048 * NQKV; d.dst = b + WO_QKV; d.K = 2048; d.Nsrc = NQKV; d.Ndst = NQKV; d.mode = 5; d.gain = inp(p, 8) + (2 * j + 1) * DM; }
        else { d.src = inp(p, 23) + (size_t)j * 2048 * 2048; d.dst = b + WO_SOUT; d.K = 2048; d.Nsrc = 2048; d.Ndst = 2048; }
    } else { const int i = (idx - 14) >> 2, k = (idx - 14) & 3; bf16_t* b = W + WE_L0 + (size_t)i * WE_L;
        if (k == 0) { d.src = inp(p, 25) + (size_t)i * 2048 * DFF; d.src2 = inp(p, 26) + (size_t)i * 2048 * DFF; d.dst = b + WO_G; d.K = 2048; d.Nsrc = DFF; d.Ndst = 2 * DFF; d.mode = 1; d.gain = inp(p, 24) + i * DM; }
        else if (k == 1) { d.src = inp(p, 27) + (size_t)i * DFF * 2048; d.dst = b + WO_D; d.K = DFF; d.Nsrc = 2048; d.Ndst = 2048; }
        else if (k == 2) { d.src = inp(p, 29) + (size_t)i * 2048 * 2048; d.dst = b + WO_PG; d.K = 2048; d.Nsrc = 2048; d.Ndst = 2048; d.gain = inp(p, 28) + i * DM; }
        else { d.src = inp(p, 30) + (size_t)i * PLE * 2048; d.dst = b + WO_PP; d.K = PLE; d.Nsrc = 2048; d.Ndst = 2048; }
    }
    return d;
}
__device__ __forceinline__ void ph_convert_w(const Params& p, int wv, char* lds) {
    const int tid = ltid(wv), lane = tid & 63, wq = tid >> 6;
    LAS float* tile0 = (LAS float*)lds; int par = 0;
    const int G = (int)gridDim.x;
    float v[32], vn[32];
    int wn = 0, basen = 0; WDesc dn = wdesc(p, 0); int tnn = dn.Ndst / 64, ntn = tnn * (dn.K / 256);
#define CW_SEEK(T_) do { while (wn < 29 && (T_) >= basen + ntn) { basen += ntn; ++wn; dn = wdesc(p, wn); tnn = dn.Ndst / 64; ntn = tnn * (dn.K / 256); } } while (0)
#define CW_LOAD(dstv, t_) do { const int k0_ = ((t_) / tnn) * 256, n0_ = ((t_) % tnn) * 64; bool second_; const int sc_ = wsrc_col(dn.mode, n0_ + lane, second_); \
        const PG8_GASF* s_ = (const PG8_GASF*)(second_ ? dn.src2 : dn.src) + (size_t)k0_ * dn.Nsrc + sc_; \
        _Pragma("unroll") for (int i = 0; i < 32; ++i) dstv[i] = s_[(size_t)(wq + 8 * i) * dn.Nsrc]; } while (0)
    int ntot = 0;
    for (int w = 0; w < 30; ++w) { const WDesc t_ = wdesc(p, w); ntot += (t_.Ndst / 64) * (t_.K / 256); }
    int T = lbid();
    if (T < ntot) { CW_SEEK(T); CW_LOAD(vn, T - basen); }
    for (; T < ntot; T += G) {
        const WDesc d = dn; const int tn = tnn, tl = T - basen;
        const int k0 = (tl / tn) * 256, n0 = (tl % tn) * 64;
#pragma unroll
        for (int i = 0; i < 32; ++i) v[i] = vn[i];
        const int Tn = T + G;
        if (Tn < ntot) { CW_SEEK(Tn); CW_LOAD(vn, Tn - basen); }
        __builtin_amdgcn_sched_barrier(0);
        if (d.gain) {
#pragma unroll
            for (int i = 0; i < 32; ++i) v[i] *= ((const PG8_GASF*)d.gain)[k0 + wq + 8 * i];
        }
        LAS float* tile = tile0 + par * (256 * 65); par ^= 1;
#pragma unroll
        for (int i = 0; i < 32; ++i) tile[(wq + 8 * i) * 65 + lane] = v[i];
        __syncthreads();
#pragma unroll
        for (int q = 0; q < 4; ++q) { const int n = (tid >> 5) + 16 * q, k8 = (tid & 31) * 8; const LAS float* sp = tile + k8 * 65 + n;
            u32x4 o; o.x = pk2(sp[0], sp[65]); o.y = pk2(sp[2 * 65], sp[3 * 65]); o.z = pk2(sp[4 * 65], sp[5 * 65]); o.w = pk2(sp[6 * 65], sp[7 * 65]);
            *(PG8_GASU4*)(d.dst + (size_t)(n0 + n) * d.K + k0 + k8) = o; }
    }
#undef CW_LOAD
#undef CW_SEEK
}

__device__ __forceinline__ void ph_init_h(const Params& p, int wv) {
    const int tix = ltid(wv);
    bf16_t* hb = (bf16_t*)(wsp(p) + WS_HB0); ssq_t* ssq = (ssq_t*)(wsp(p) + WS_SSQ);
    const float* xp = inp(p, 0); const float* xs = inp(p, 1);
    const int lane = tix & 63, gw = lbid() * 8 + (tix >> 6), ngw = gridDim.x * 8;
    for (int m = gw; m < MR; m += ngw) {
        const f32x4* xr = (const f32x4*)(m < NPR ? xp + (size_t)m * DM : xs + (size_t)(m - NPR) * DM); float ss = 0.f;
        f32x4 v[8];
#pragma unroll
        for (int j = 0; j < 8; ++j) v[j] = xr[j * 64 + lane];
#pragma unroll
        for (int j = 0; j < 8; ++j) { ss += v[j].x * v[j].x + v[j].y * v[j].y + v[j].z * v[j].z + v[j].w * v[j].w;
            u32x2 o; o.x = pk2(v[j].x, v[j].y); o.y = pk2(v[j].z, v[j].w); *(u32x2*)(hb + (size_t)m * DM + (j * 64 + lane) * 4) = o; }
        ss = wave_sum(ss); if (lane == 0) ssq[m] = (ssq_t)(ss * 4096.0f + 0.5f);
    }
}

__device__ __forceinline__ void ph_caches(const Params& p, int wv) {
    const int tix = ltid(wv); const size_t gt = (size_t)lbid() * 512 + tix, ngt = (size_t)gridDim.x * 512;
    { const f32x4* src = (const f32x4*)inp(p, 4); bf16_t* dst = (bf16_t*)(wsp(p) + WS_LATC); const size_t n4 = (size_t)2 * 16384 * 512 / 4;
      for (size_t k = gt; k < n4; k += ngt) { const f32x4 v = src[k]; u32x2 o; o.x = pk2(v.x, v.y); o.y = pk2(v.z, v.w); *(u32x2*)(dst + k * 4) = o; } }
    { const f32x4* src = (const f32x4*)inp(p, 5); const size_t n4 = (size_t)2 * 16384 * 64 / 4;
      for (size_t k = gt; k < n4; k += ngt) { const f32x4 v = src[k]; const int c4 = (int)(k & 15), r = (int)((k >> 4) & 16383), j = (int)(k >> 18), b = r >> 10, t = r & 1023;
          bf16_t* dst = (bf16_t*)(wsp(p) + WS_KRB + (size_t)j * KRB_STRIDE) + ((size_t)NPR + b * KVPB + t) * 64 + c4 * 4;
          u32x2 o; o.x = pk2(v.x, v.y); o.y = pk2(v.z, v.w); *(u32x2*)dst = o; } }
    { const float* sk = inp(p, 6); const float* sv = inp(p, 7); float* out = outp(p); const size_t n = (size_t)2 * 16 * 128 * 256;
      for (size_t k = gt; k < n; k += ngt) { const int c = (int)(k & 255), i = (int)((k >> 8) & 127), b = (int)((k >> 15) & 15), j = (int)(k >> 19);
          const int g = c >> 6, w = c & 63, d = swa_dim(w >> 5, w & 31);
          const size_t row = ((size_t)j * 16 + b) * 128 + i; const float kx = sk[row * 256 + g * 64 + d], vx = sv[row * 256 + c], kt = sk[row * 256 + c];
          const size_t dr = (size_t)NPR + b * SWPB + i;
          ((bf16_t*)(wsp(p) + WS_SKB + (size_t)j * SKB_STRIDE))[dr * 256 + c] = (bf16_t)f2bf(kx);
          ((bf16_t*)(wsp(p) + WS_SVB + (size_t)j * SKB_STRIDE))[dr * 256 + c] = (bf16_t)f2bf(vx);
          if (i >= 16) { const size_t o = (((size_t)j * 16 + b) * 128 + (i - 16)) * 256 + c; out[O_SKS + o] = kt; out[O_SVS + o] = vx; } } }
}

__device__ __forceinline__ void ph_final(const Params& p, int wv) {
    const int tix = ltid(wv);
    float* y = outp(p); const bf16_t* hb = (const bf16_t*)(wsp(p) + WS_HB0); const ssq_t* ssq = (const ssq_t*)(wsp(p) + WS_SSQ) + 12 * MR; const float* g = inp(p, 31);
    const int lane = tix & 63, gw = lbid() * 8 + (tix >> 6), ngw = gridDim.x * 8;
    for (int m = gw; m < MR; m += ngw) {
        const float rstd = rsqrtf(ssq_val(ssq, m) * (1.0f / DM) + EPS); u32x4 v[4];
#pragma unroll
        for (int j = 0; j < 4; ++j) v[j] = *(const u32x4*)(hb + (size_t)m * DM + (j * 64 + lane) * 8);
#pragma unroll
        for (int j = 0; j < 4; ++j) { const int c = (j * 64 + lane) * 8; const f32x4 g0 = *(const f32x4*)(g + c), g1 = *(const f32x4*)(g + c + 4); f32x4 a, b;
            a[0] = __uint_as_float(v[j].x << 16); a[1] = __uint_as_float(v[j].x & 0xffff0000u); a[2] = __uint_as_float(v[j].y << 16); a[3] = __uint_as_float(v[j].y & 0xffff0000u);
            b[0] = __uint_as_float(v[j].z << 16); b[1] = __uint_as_float(v[j].z & 0xffff0000u); b[2] = __uint_as_float(v[j].w << 16); b[3] = __uint_as_float(v[j].w & 0xffff0000u);
            *(f32x4*)(y + (size_t)m * DM + c) = a * rstd * g0; *(f32x4*)(y + (size_t)m * DM + c + 4) = b * rstd * g1; }
    }
}

__device__ __forceinline__ void ph_lat_fix(const Params& p, int wv, int j, int c, int n  ) {
    const int tix = ltid(wv); const int lane = tix & 63, gw = c * 8 + (tix >> 6), ngw = n * 8;
    const ssq_t* ssq = (const ssq_t*)(wsp(p) + WS_SSQKV) + (size_t)j * MR; const float* g = inp(p, 12) + j * 512; float* out = outp(p);
    const f32x4 g0 = ((const f32x4*)g)[lane], g1 = ((const f32x4*)g)[64 + lane];
    for (int m = gw; m < MR; m += ngw) {
        f32x4* r = (f32x4*)(m < NPR ? out + O_LATP + ((size_t)j * NPR + m) * 512 : out + O_LATS + ((size_t)j * NSR + (m - NPR)) * 512);
        const float rs = rsqrtf(ssq_val(ssq, m) * (1.0f / 512) + EPS);
        const f32x4 a = r[lane], b = r[64 + lane]; r[lane] = a * rs * g0; r[64 + lane] = b * rs * g1;
    }
}

__device__ __forceinline__ void ph_ple_prep(const Params& p, int wv, int i) {
    const int tix = ltid(wv);
    bf16_t* PB = (bf16_t*)(wsp(p) + WS_PB);
    const f32x4* pp = (const f32x4*)(inp(p, 2) + (size_t)i * NPR * PLE); const f32x4* ps = (const f32x4*)(inp(p, 3) + (size_t)i * NSR * PLE);
    const size_t np4 = (size_t)NPR * PLE / 4, ns4 = (size_t)NSR * PLE / 4;
    const size_t gt = (size_t)lbid() * 512 + tix, ngt = (size_t)gridDim.x * 512;
    for (size_t k = gt; k < np4 + ns4; k += ngt) { const f32x4 v = k < np4 ? pp[k] : ps[k - np4]; u32x2 o; o.x = pk2(v.x, v.y); o.y = pk2(v.z, v.w); *(u32x2*)(PB + k * 4) = o; }
}

#define SBAR() __builtin_amdgcn_sched_barrier(0)
__device__ __forceinline__ unsigned cvtpk(float lo, float hi) { unsigned r; asm volatile("v_cvt_pk_bf16_f32 %0, %1, %2" : "=v"(r) : "v"(lo), "v"(hi)); return r; }
#define PK4(P, BASE, OUT) do { unsigned a0_ = cvtpk(P[BASE + 0], P[BASE + 1]), a1_ = cvtpk(P[BASE + 2], P[BASE + 3]);   \
    unsigned b0_ = cvtpk(P[BASE + 4], P[BASE + 5]), b1_ = cvtpk(P[BASE + 6], P[BASE + 7]);                              \
    auto r0_ = __builtin_amdgcn_permlane32_swap(a0_, b0_, false, false); auto r1_ = __builtin_amdgcn_permlane32_swap(a1_, b1_, false, false); \
    u32x4 w_ = {r0_[0], r1_[0], r0_[1], r1_[1]}; OUT = *reinterpret_cast<bf16x8*>(&w_); } while (0)
__device__ __forceinline__ float half_swap_max(float v) { auto rr = __builtin_amdgcn_permlane32_swap(__float_as_uint(v), __float_as_uint(v), false, false); return fmaxf(__uint_as_float(rr[0]), __uint_as_float(rr[1])); }
__device__ __forceinline__ float half_swap_sum(float v) { auto rr = __builtin_amdgcn_permlane32_swap(__float_as_uint(v), __float_as_uint(v), false, false); return __uint_as_float(rr[0]) + __uint_as_float(rr[1]); }
template <int NC> __device__ __forceinline__ int v_st(int k, int c) { const int kk = (k & ~0xC) | ((k & 4) << 1) | ((k & 8) >> 1); return ((kk >> 3) * (NC / 32) + (c >> 5)) * 512 + ((kk & 7) * 32 + (c & 31)) * 2; }
__device__ __forceinline__ int v_rd_base(int lane) { return ((lane & 3) << 3) | (((lane >> 2) & 3) << 6) | (((lane >> 4) & 1) << 5) | (((lane >> 5) & 1) << 8); }
template <int NC> constexpr int v_rd_off(int d0, int ks, int half) { return d0 * 512 + ks * (NC / 32) * 1024 + half * (NC / 32) * 512; }
template <int OFF> __device__ __forceinline__ s16x4 tr_read(int vb) { s16x4 r; asm volatile("ds_read_b64_tr_b16 %0, %1 offset:%2" : "=&v"(r) : "v"(vb), "i"(OFF) : "memory"); return r; }
#define PKV(L, H) (bf16x8){L[0], L[1], L[2], L[3], H[0], H[1], H[2], H[3]}
template <int NC, int D0> __device__ __forceinline__ void pv_one(f32x16& od, int vb, bf16x8 pa0, bf16x8 pa1, bf16x8 pa2, bf16x8 pa3) {
    const s16x4 l0 = tr_read<v_rd_off<NC>(D0, 0, 0)>(vb), h0 = tr_read<v_rd_off<NC>(D0, 0, 1)>(vb), l1 = tr_read<v_rd_off<NC>(D0, 1, 0)>(vb), h1 = tr_read<v_rd_off<NC>(D0, 1, 1)>(vb);
    const s16x4 l2 = tr_read<v_rd_off<NC>(D0, 2, 0)>(vb), h2 = tr_read<v_rd_off<NC>(D0, 2, 1)>(vb), l3 = tr_read<v_rd_off<NC>(D0, 3, 0)>(vb), h3 = tr_read<v_rd_off<NC>(D0, 3, 1)>(vb);
    asm volatile("s_waitcnt lgkmcnt(0)" ::: "memory"); SBAR();
    od = __builtin_amdgcn_mfma_f32_32x32x16_bf16(pa0, PKV(l0, h0), od, 0, 0, 0);
    od = __builtin_amdgcn_mfma_f32_32x32x16_bf16(pa1, PKV(l1, h1), od, 0, 0, 0);
    od = __builtin_amdgcn_mfma_f32_32x32x16_bf16(pa2, PKV(l2, h2), od, 0, 0, 0);
    od = __builtin_amdgcn_mfma_f32_32x32x16_bf16(pa3, PKV(l3, h3), od, 0, 0, 0);
}
#define TRD8(v, NC, D0, vb) do { v[0] = tr_read<v_rd_off<NC>(D0, 0, 0)>(vb); v[1] = tr_read<v_rd_off<NC>(D0, 0, 1)>(vb); v[2] = tr_read<v_rd_off<NC>(D0, 1, 0)>(vb); v[3] = tr_read<v_rd_off<NC>(D0, 1, 1)>(vb); \
        v[4] = tr_read<v_rd_off<NC>(D0, 2, 0)>(vb); v[5] = tr_read<v_rd_off<NC>(D0, 2, 1)>(vb); v[6] = tr_read<v_rd_off<NC>(D0, 3, 0)>(vb); v[7] = tr_read<v_rd_off<NC>(D0, 3, 1)>(vb); } while (0)
#define PVM4(od, v) do { od = __builtin_amdgcn_mfma_f32_32x32x16_bf16(pa0, PKV(v[0], v[1]), od, 0, 0, 0); od = __builtin_amdgcn_mfma_f32_32x32x16_bf16(pa1, PKV(v[2], v[3]), od, 0, 0, 0); \
        od = __builtin_amdgcn_mfma_f32_32x32x16_bf16(pa2, PKV(v[4], v[5]), od, 0, 0, 0); od = __builtin_amdgcn_mfma_f32_32x32x16_bf16(pa3, PKV(v[6], v[7]), od, 0, 0, 0); } while (0)
#define LGKM_WAIT(n) do { asm volatile("s_waitcnt lgkmcnt(" #n ")" ::: "memory"); SBAR(); } while (0)
#define KSWZ256(row, colB) ((row) * 256 + ((colB) ^ (((row) & 7) << 4)))
#define KSWZ128(row, colB) ((row) * 128 + ((colB) ^ (((row) & 7) << 4)))

constexpr int MLA_V = 0, MLA_K = 32768, MLA_KR = 65536, MLA_WS = 81920, MLA_LDS = 83968;
constexpr float MLA_C = 0.07216878364870322f * LOG2E;
__device__ __forceinline__ void mla_attn_unit(int wv, const bf16_t* Qh, int nq, const bf16_t* KVh, const bf16_t* KRb, int nkeys, int NT, int my_nt, bf16_t* Oh, char* lds) {
    const int tid = ltid(wv);
    const int wid = __builtin_amdgcn_readfirstlane(tid >> 6), lane = tid & 63, r32 = lane & 31, hi = lane >> 5;
    LAS char* L = (LAS char*)lds;
    LAS float* wsf = (LAS float*)(L + MLA_WS) + wid * 64;
    bf16x8 qr[12];
    { int qrow = wid * 32 + r32; if (qrow > nq - 1) qrow = nq - 1; const bf16_t* qp = Qh + (size_t)qrow * NQUP + hi * 8;
#pragma unroll
      for (int d0 = 0; d0 < 12; ++d0) qr[d0] = *(const bf16x8*)(qp + d0 * 16); }
    int kq[4];
#pragma unroll
    for (int q = 0; q < 4; ++q) kq[q] = ((q * 32 + hi * 16) ^ ((r32 & 7) << 4));
    const int krow256 = r32 * 256, krow128 = r32 * 128;
    const int sr = tid >> 4, sc = (tid & 15) * 8, vst0 = v_st<128>(sr, sc), vst1 = v_st<128>(32 + sr, sc);
    const int kst0 = KSWZ256(sr, sc * 2), kst1 = KSWZ256(32 + sr, sc * 2);
    const int krr = tid >> 3, krc = (tid & 7) * 8, krst = KSWZ128(krr, krc * 2);
    const int vb0 = (int)(uintptr_t)(lds + MLA_V) + v_rd_base(lane);
    typedef __attribute__((address_space(1))) bf16x8 gbf8_t;
    bf16x8 sk0, sk1, sv0, sv1, skr;
#define MLA_LOAD(t) do { int ra = (t) * 64 + sr, rb = ra + 32, rc = (t) * 64 + krr; if (ra > nkeys - 1) ra = nkeys - 1; if (rb > nkeys - 1) rb = nkeys - 1; if (rc > nkeys - 1) rc = nkeys - 1; \
        sk0 = *(const gbf8_t*)(KVh + (size_t)ra * NKVUP + sc); sk1 = *(const gbf8_t*)(KVh + (size_t)rb * NKVUP + sc); \
        sv0 = *(const gbf8_t*)(KVh + (size_t)ra * NKVUP + 128 + sc); sv1 = *(const gbf8_t*)(KVh + (size_t)rb * NKVUP + 128 + sc); \
        skr = *(const gbf8_t*)(KRb + (size_t)rc * 64 + krc); } while (0)
#define MLA_WRITE(b) do { \
        *(LAS bf16x8*)(L + MLA_V + (b) * 16384 + vst0) = sv0; *(LAS bf16x8*)(L + MLA_V + (b) * 16384 + vst1) = sv1; \
        *(LAS bf16x8*)(L + MLA_K + (b) * 16384 + kst0) = sk0; *(LAS bf16x8*)(L + MLA_K + (b) * 16384 + kst1) = sk1; \
        *(LAS bf16x8*)(L + MLA_KR + (b) * 8192 + krst) = skr; } while (0)
    float m_reg = -1e30f, l_reg = 0.f; f32x16 o[4] = {};
    MLA_LOAD(0); MLA_WRITE(0); __syncthreads();
    for (int j = 0; j < NT; ++j) {
        const int b = j & 1;
        if (j + 1 < NT) MLA_LOAD(j + 1);
        SBAR();
        if (j < my_nt) {
            f32x16 p0 = {}, p1 = {};
            const LAS char* Kb = L + MLA_K + b * 16384 + krow256; const LAS char* KRp = L + MLA_KR + b * 8192 + krow128;
            {
                bf16x8 kk[12][2];
#pragma unroll
                for (int d0 = 0; d0 < 8; ++d0) { kk[d0][0] = *(const LAS bf16x8*)(Kb + kq[d0 & 3] + (d0 >> 2) * 128); kk[d0][1] = *(const LAS bf16x8*)(Kb + kq[d0 & 3] + (d0 >> 2) * 128 + 8192); }
#pragma unroll
                for (int d0 = 0; d0 < 4; ++d0) { kk[8 + d0][0] = *(const LAS bf16x8*)(KRp + kq[d0]); kk[8 + d0][1] = *(const LAS bf16x8*)(KRp + kq[d0] + 4096); }
#pragma unroll
                for (int d0 = 0; d0 < 12; ++d0) { p0 = __builtin_amdgcn_mfma_f32_32x32x16_bf16(kk[d0][0], qr[d0], p0, 0, 0, 0); p1 = __builtin_amdgcn_mfma_f32_32x32x16_bf16(kk[d0][1], qr[d0], p1, 0, 0, 0); }
                __builtin_amdgcn_sched_group_barrier(0x100, 6, 0);
#pragma unroll
                for (int i = 0; i < 9; ++i) { __builtin_amdgcn_sched_group_barrier(0x008, 2, 0); __builtin_amdgcn_sched_group_barrier(0x100, 2, 0); }
                __builtin_amdgcn_sched_group_barrier(0x008, 6, 0);
                SBAR(); }
            const int vb = vb0 + b * 16384; s16x4 va[8], vc[8];
            TRD8(va, 128, 0, vb);
            if (j * 64 + 64 > nkeys) {
#pragma unroll
                for (int r = 0; r < 16; ++r) { const int kk = j * 64 + crow(r, hi); if (kk >= nkeys) p0[r] = -1e30f; if (kk + 32 >= nkeys) p1[r] = -1e30f; }
            }
            float pmax = p0[0];
#pragma unroll
            for (int r = 1; r < 16; ++r) pmax = fmaxf(pmax, p0[r]);
#pragma unroll
            for (int r = 0; r < 16; ++r) pmax = fmaxf(pmax, p1[r]);
            pmax = half_swap_max(pmax);
            const bool upd = !__all((pmax - m_reg) * MLA_C <= 8.0f);
            float alpha = 1.0f;
            if (upd) { const float mn = fmaxf(m_reg, pmax); alpha = __builtin_amdgcn_exp2f((m_reg - mn) * MLA_C); m_reg = mn; }
            const float mnC = -m_reg * MLA_C; float ps = 0.f;
#pragma unroll
            for (int r = 0; r < 16; ++r) { p0[r] = __builtin_amdgcn_exp2f(fmaf(p0[r], MLA_C, mnC)); p1[r] = __builtin_amdgcn_exp2f(fmaf(p1[r], MLA_C, mnC)); ps += p0[r] + p1[r]; }
            ps = half_swap_sum(ps);
            l_reg = l_reg * alpha + ps;
            bf16x8 pa0, pa1, pa2, pa3;
            PK4(p0, 0, pa0); PK4(p0, 8, pa1); PK4(p1, 0, pa2); PK4(p1, 8, pa3);
            if (upd) {
                if (hi == 0) wsf[r32] = alpha; asm volatile("s_waitcnt lgkmcnt(0)" ::: "memory");
#pragma unroll
                for (int r = 0; r < 16; ++r) { const float a = wsf[crow(r, hi)];
#pragma unroll
                    for (int d = 0; d < 4; ++d) o[d][r] *= a; }
                asm volatile("s_waitcnt lgkmcnt(0)" ::: "memory"); }
            TRD8(vc, 128, 1, vb); LGKM_WAIT(8); PVM4(o[0], va);
            TRD8(va, 128, 2, vb); LGKM_WAIT(8); PVM4(o[1], vc);
            TRD8(vc, 128, 3, vb); LGKM_WAIT(8); PVM4(o[2], va);
            LGKM_WAIT(0); PVM4(o[3], vc);
        }
        if (j + 1 < NT) MLA_WRITE(b ^ 1);
        __syncthreads();
    }
    if (hi == 0) wsf[32 + r32] = l_reg; asm volatile("s_waitcnt lgkmcnt(0)" ::: "memory");
    {
        LAS char* ot = L + wid * 8704;
#pragma unroll
        for (int r = 0; r < 16; ++r) { const float rl = __builtin_amdgcn_rcpf(wsf[32 + crow(r, hi)]); LAS unsigned short* rp = (LAS unsigned short*)(ot + crow(r, hi) * 272) + r32;
#pragma unroll
            for (int d = 0; d < 4; ++d) rp[d * 32] = (unsigned short)f2bf(o[d][r] * rl); }
        asm volatile("s_waitcnt lgkmcnt(0)" ::: "memory");
#pragma unroll
        for (int q = 0; q < 8; ++q) { const int ci = q * 64 + lane, row = ci >> 4, c16 = ci & 15, orow = wid * 32 + row;
            const u32x4 w = *(const LAS u32x4*)(ot + row * 272 + c16 * 16);
            if (orow < nq) *(u32x4*)(Oh + (size_t)orow * DM + c16 * 8) = w; }
    }
    __syncthreads();
#undef MLA_LOAD
#undef MLA_WRITE
}
__device__ __forceinline__ void ph_mla_attn(const Params& p, int wv, const bf16_t* KR, bf16_t* O, char* lds) {
    const int tix = ltid(wv);
    const bf16_t* Q = (const bf16_t*)(wsp(p) + WS_Q); const bf16_t* KV = (const bf16_t*)(wsp(p) + WS_KV);
    const int wid = tix >> 6, G = gridDim.x;
    const int npr = (512 + G - 1) / G, nsr = (DBATCH * 16 + G - 1) / G;
    for (int sl = 0; sl < 2 * npr + nsr; ++sl) {
        size_t row0, kr0; int h, nq, nkeys, NT, my_nt;
        if (sl < 2 * npr) {
            const int bb = lbid(), vb = (G & 7) ? bb : (bb & 7) * (G >> 3) + (bb >> 3);
            const int pi = vb + (sl >> 1) * G; if (pi >= 512) continue;
            const int bh = pi >> 3, s = pi & 7, b = bh >> 4, qb = (sl & 1) ? 15 - s : s; h = bh & 15;
            row0 = (size_t)b * SEQ + qb * 256; kr0 = (size_t)b * SEQ; nq = 256; nkeys = SEQ; NT = 4 * qb + 4; my_nt = 4 * qb + (wid >> 1) + 1;
        } else {
            const int u = lbid() + (sl - 2 * npr) * G; if (u >= DBATCH * 16) continue;
            const int b = u >> 4; h = u & 15;
            row0 = (size_t)NPR + b * 16; kr0 = (size_t)NPR + b * KVPB; nq = 16; nkeys = KVPB; NT = 17; my_nt = wid == 0 ? 17 : 0;
        }
        mla_attn_unit(wv, Q + row0 * NQUP + h * 192, nq, KV + kr0 * NKVUP + h * 256, KR + kr0 * 64, nkeys, NT, my_nt, O + row0 * DM + h * 128, lds);
    }
}

constexpr int SWA_K = 0, SWA_V = 24576, SWA_WS = 49152, SWA_LDS = 51200;
__device__ __forceinline__ void swa_attn_unit(int wv, const bf16_t* Qb, int nq, const bf16_t* Kb, const bf16_t* Vb, int nkeys, const float* sinks8, bf16_t* Ob, char* lds) {
    const int tid = ltid(wv);
    const int wid = __builtin_amdgcn_readfirstlane(tid >> 6), lane = tid & 63, r32 = lane & 31, hi = lane >> 5;
    LAS char* L = (LAS char*)lds; LAS float* wsf = (LAS float*)(L + SWA_WS) + wid * 64;
#pragma unroll
    for (int i = 0; i < 3; ++i) { const int idx = tid + i * 512, row = idx >> 3, ch = idx & 7; const bool valid = row < nkeys; const int rr = valid ? row : 0;
        bf16x8 kx = *(const bf16x8*)(Kb + (size_t)rr * 256 + ch * 8), vx = *(const bf16x8*)(Vb + (size_t)rr * 256 + ch * 8);
        if (!valid) { kx = (bf16x8){0, 0, 0, 0, 0, 0, 0, 0}; vx = kx; }
        *(LAS bf16x8*)(L + SWA_K + KSWZ128(row, ch * 16)) = kx;
        *(LAS bf16x8*)(L + SWA_V + (row >> 6) * 8192 + v_st<64>(row & 63, ch * 8)) = vx; }
    __syncthreads();
    const float sink2 = sinks8[wid] * LOG2E; const int vb0 = (int)(uintptr_t)(lds + SWA_V) + v_rd_base(lane);
    constexpr float SC = 0.125f * LOG2E;
    int kq[4];
#pragma unroll
    for (int q = 0; q < 4; ++q) kq[q] = r32 * 128 + ((q * 32 + hi * 16) ^ ((r32 & 7) << 4));
    const int ntile = (nkeys + 63) >> 6;
    for (int q2 = 0; q2 * 32 < nq; ++q2) {
        bf16x8 qr[4];
        { int qrow = q2 * 32 + r32; if (qrow > nq - 1) qrow = nq - 1; const bf16_t* qp = Qb + (size_t)qrow * DM + wid * 64 + hi * 8;
#pragma unroll
          for (int d0 = 0; d0 < 4; ++d0) qr[d0] = *(const bf16x8*)(qp + d0 * 16); }
        float m_reg = sink2, l_reg = 1.0f; f32x16 o0 = {}, o1 = {};
        for (int t = 0; t < ntile; ++t) {
            f32x16 p0 = {}, p1 = {};
            const LAS char* Kt = L + SWA_K + t * 8192;
#pragma unroll
            for (int d0 = 0; d0 < 4; ++d0) { const bf16x8 k0 = *(const LAS bf16x8*)(Kt + kq[d0]), k1 = *(const LAS bf16x8*)(Kt + kq[d0] + 4096);
                p0 = __builtin_amdgcn_mfma_f32_32x32x16_bf16(k0, qr[d0], p0, 0, 0, 0);
                p1 = __builtin_amdgcn_mfma_f32_32x32x16_bf16(k1, qr[d0], p1, 0, 0, 0); }
            if (t * 64 + 64 > nkeys) {
#pragma unroll
                for (int r = 0; r < 16; ++r) { const int kk = t * 64 + crow(r, hi); if (kk >= nkeys) p0[r] = -1e30f; if (kk + 32 >= nkeys) p1[r] = -1e30f; }
            }
            float pmax = p0[0];
#pragma unroll
            for (int r = 1; r < 16; ++r) pmax = fmaxf(pmax, p0[r]);
#pragma unroll
            for (int r = 0; r < 16; ++r) pmax = fmaxf(pmax, p1[r]);
            pmax = half_swap_max(pmax) * SC;
            const bool upd = !__all(pmax - m_reg <= 8.0f);
            float alpha = 1.0f;
            if (upd) { const float mn = fmaxf(m_reg, pmax); alpha = __builtin_amdgcn_exp2f(m_reg - mn); m_reg = mn; }
            const float mn = m_reg;
            float ps = 0.f;
#pragma unroll
            for (int r = 0; r < 16; ++r) { p0[r] = __builtin_amdgcn_exp2f(fmaf(p0[r], SC, -mn)); p1[r] = __builtin_amdgcn_exp2f(fmaf(p1[r], SC, -mn)); ps += p0[r] + p1[r]; }
            ps = half_swap_sum(ps);
            l_reg = l_reg * alpha + ps;
            bf16x8 pa0, pa1, pa2, pa3;
            PK4(p0, 0, pa0); PK4(p0, 8, pa1); PK4(p1, 0, pa2); PK4(p1, 8, pa3);
            if (upd) {
                if (hi == 0) wsf[r32] = alpha; asm volatile("s_waitcnt lgkmcnt(0)" ::: "memory");
#pragma unroll
                for (int r = 0; r < 16; ++r) { const float a = wsf[crow(r, hi)]; o0[r] *= a; o1[r] *= a; }
                asm volatile("s_waitcnt lgkmcnt(0)" ::: "memory"); }
            const int vb = vb0 + t * 8192;
            pv_one<64, 0>(o0, vb, pa0, pa1, pa2, pa3); pv_one<64, 1>(o1, vb, pa0, pa1, pa2, pa3);
        }
        if (hi == 0) wsf[32 + r32] = l_reg; asm volatile("s_waitcnt lgkmcnt(0)" ::: "memory");
        {
            LAS char* ot = L + SWA_LDS + wid * 4608;
#pragma unroll
            for (int r = 0; r < 16; ++r) { const float rl = __builtin_amdgcn_rcpf(wsf[32 + crow(r, hi)]); LAS unsigned short* rp = (LAS unsigned short*)(ot + crow(r, hi) * 144) + r32;
                rp[0] = (unsigned short)f2bf(o0[r] * rl); rp[32] = (unsigned short)f2bf(o1[r] * rl); }
            asm volatile("s_waitcnt lgkmcnt(0)" ::: "memory");
#pragma unroll
            for (int q = 0; q < 4; ++q) { const int ci = q * 64 + lane, row = ci >> 3, c16 = ci & 7, orow = q2 * 32 + row;
                const u32x4 w = *(const LAS u32x4*)(ot + row * 144 + c16 * 16);
                if (orow < nq) *(u32x4*)(Ob + (size_t)orow * DM + wid * 64 + c16 * 8) = w; }
            asm volatile("s_waitcnt lgkmcnt(0)" ::: "memory");
        }
    }
    __syncthreads();
}
__device__ __forceinline__ void ph_swa_attn(const Params& p, int wv, int j, const bf16_t* SK, const bf16_t* SV, bf16_t* O, char* lds) {
    const bf16_t* SQ = (const bf16_t*)(wsp(p) + WS_SQ);
    const float* sinks = inp(p, 22) + j * 32;
    const int bb_ = lbid(), G_ = (int)gridDim.x, vb_ = (G_ & 7) ? bb_ : (bb_ & 7) * (G_ >> 3) + (bb_ >> 3);
    for (int u = vb_; u < 1024 + DBATCH * 4; u += gridDim.x) {
        size_t qrow0, krow0; int g, nq, nk;
        if (u < 1024) { const int c = u & 63, b = u >> 8; g = (u >> 6) & 3; const int c0 = c >= 2 ? c - 2 : 0; nk = (c - c0 + 1) * 64; nq = 64;
            qrow0 = (size_t)b * SEQ + c * 64; krow0 = (size_t)b * SEQ + c0 * 64; }
        else { const int v = u - 1024, b = v >> 2; g = v & 3; nq = 16; nk = SWPB; qrow0 = (size_t)NPR + b * 16; krow0 = (size_t)NPR + b * SWPB; }
        swa_attn_unit(wv, SQ + qrow0 * DM + g * 512, nq, SK + krow0 * 256 + g * 64, SV + krow0 * 256 + g * 64, nk, sinks + g * 8, O + qrow0 * DM + g * 512, lds);
    }
}

namespace pg8 {
#define PG8_LAS __attribute__((address_space(3)))
typedef unsigned short bf16_t;
typedef short bf16x8 __attribute__((ext_vector_type(8)));
typedef float f32x4 __attribute__((ext_vector_type(4)));
typedef unsigned u32x4 __attribute__((ext_vector_type(4)));
constexpr int BM = 256, BK = 64, HALF = 128, HTB = HALF * BK * 2  , STAGE_BYTES = 8 * HTB, NXCD = 8, WGM = 8;

__host__ __device__ __forceinline__ int lds_byte(int r, int c) { const int st = (r >> 4) * 2 + (c >> 5), rr = r & 15, cc = c & 31, ob = rr * 64 + cc * 2; return st * 1024 + (ob ^ (((ob >> 9) & 1) << 5)); }
__host__ __device__ __forceinline__ void stage_rc(int b, int& R, int& C) { const int st = b / 1024, sb = b % 1024, swz = sb ^ (((sb >> 9) & 1) << 5); R = (st >> 1) * 16 + swz / 64; C = (st & 1) * 32 + (swz % 64) / 2; }
__host__ __device__ __forceinline__ int perm32(int rho) { const int n = rho >> 4, i = rho & 15; return 8 * (i >> 2) + 4 * n + (i & 3); }

struct Unit { int pm, pn; };
struct Gemm { const bf16_t* A; const bf16_t* Bt; int M, N, K; };

struct StaticOrder {
    int nM, nN, nwg, G, c, wgm;
    __host__ __device__ void init(int M, int N, int G_, int c_, int wgm_ = WGM) { nM = M / BM; nN = N / BM; nwg = nM * nN; G = G_; c = c_; wgm = wgm_; }
    __host__ __device__ bool next(int i, Unit& u) const {
        const int L = i * G + c; if (L >= nwg) return false;
        int wgid = L; { const int q = nwg / NXCD, r = nwg % NXCD, xcd = wgid % NXCD, off = wgid / NXCD; wgid = (xcd < r ? xcd * (q + 1) : r * (q + 1) + (xcd - r) * q) + off; }
        const int nig = wgm * nN, gid = wgid / nig, fm = gid * wgm, gsz = (nM - fm) < wgm ? (nM - fm) : wgm;
        u.pm = fm + ((wgid % nig) % gsz); u.pn = (wgid % nig) / gsz; return true;
    }
    __device__ __forceinline__ void a_ready(const Unit&) const {}
    __device__ __forceinline__ void done(const Unit&) const {}
};

__device__ __forceinline__ unsigned cvt_pk_bf16(float lo, float hi) { unsigned r; asm volatile("v_cvt_pk_bf16_f32 %0, %1, %2" : "=v"(r) : "v"(lo), "v"(hi)); return r; }
#define PG8_FOR_ROWS for (int ai = 0; ai < 2; ++ai) _Pragma("unroll") for (int m = 0; m < 4; ++m)
#define PG8_GAS __attribute__((address_space(1)))
typedef PG8_GAS f32x4 gf32x4; typedef PG8_GAS u32x4 gu32x4; typedef unsigned u32x2 __attribute__((ext_vector_type(2))); typedef PG8_GAS u32x2 gu32x2; typedef PG8_GAS float gfloat;
__device__ __forceinline__ float rstd_of(const ssq_t* ssq, int row) { return rsqrtf(ssq_val(ssq, row) * (1.0f / 2048) + 1e-6f); }
typedef PG8_LAS float lfloat; typedef PG8_LAS f32x4 lf32x4;
__device__ __forceinline__ void wg_bar() { asm volatile("s_waitcnt lgkmcnt(0)\n\ts_barrier" ::: "memory"); }
__device__ __forceinline__ float fq_sum(float v) {
    { auto r = __builtin_amdgcn_permlane16_swap(__float_as_uint(v), __float_as_uint(v), false, false); v = __uint_as_float(r[0]) + __uint_as_float(r[1]); }
    { auto r = __builtin_amdgcn_permlane32_swap(__float_as_uint(v), __float_as_uint(v), false, false); v = __uint_as_float(r[0]) + __uint_as_float(r[1]); }
    return v; }
__device__ __forceinline__ u32x4 pack8(const f32x4& a, const f32x4& b) { u32x4 w; w.x = cvt_pk_bf16(a[0], a[1]); w.y = cvt_pk_bf16(a[2], a[3]); w.z = cvt_pk_bf16(b[0], b[1]); w.w = cvt_pk_bf16(b[2], b[3]); return w; }

struct EpiStoreF32 {
    static constexpr bool PERM = false, AFTER_DRAIN = false;
    float* C; int ldc, ncols; const ssq_t* ssq;
    __device__ __forceinline__ void operator()(const f32x4 (&acc)[2][2][4][2], const Unit& u, int wr, int wc, int fr, int fq) const {
        { int l_ = (int)__builtin_amdgcn_mbcnt_hi(~0u, __builtin_amdgcn_mbcnt_lo(~0u, 0u)); asm volatile("" : "+v"(l_)); fr = l_ & 15; fq = l_ >> 4; }
        const int row0 = u.pm * BM + wr * 64 + fr, col0 = u.pn * BM + wc * 32 + 4 * fq;
        float rs[2][4];
#pragma unroll
        PG8_FOR_ROWS rs[ai][m] = ssq ? rstd_of(ssq, row0 + ai * HALF + m * 16) : 1.0f;
#pragma unroll
        PG8_FOR_ROWS { float* rowp = C + (size_t)(row0 + ai * HALF + m * 16) * ldc + col0;
#pragma unroll
            for (int bj = 0; bj < 2; ++bj)
#pragma unroll
                for (int n = 0; n < 2; ++n) if (col0 + bj * HALF + n * 16 < ncols) *(gf32x4*)(rowp + bj * HALF + n * 16) = acc[ai][bj][m][n] * rs[ai][m]; }
    }
};
__device__ __forceinline__ void unpack8(const u32x4& w, f32x4& a, f32x4& b) {
    a[0] = __uint_as_float(w.x << 16); a[1] = __uint_as_float(w.x & 0xffff0000u); a[2] = __uint_as_float(w.y << 16); a[3] = __uint_as_float(w.y & 0xffff0000u);
    b[0] = __uint_as_float(w.z << 16); b[1] = __uint_as_float(w.z & 0xffff0000u); b[2] = __uint_as_float(w.w << 16); b[3] = __uint_as_float(w.w & 0xffff0000u); }
struct EpiResidF32 {
    static constexpr bool PERM = true, AFTER_DRAIN = false;
    const bf16_t* hin; bf16_t* hout; ssq_t* ssq_out;
    __device__ __forceinline__ void operator()(const f32x4 (&acc)[2][2][4][2], const Unit& u, int wr, int wc, int fr, int fq) const {
        { int l_ = (int)__builtin_amdgcn_mbcnt_hi(~0u, __builtin_amdgcn_mbcnt_lo(~0u, 0u)); asm volatile("" : "+v"(l_)); fr = l_ & 15; fq = l_ >> 4; }
        const int row0 = u.pm * BM + wr * 64 + fr, col0 = u.pn * BM + wc * 32 + 8 * fq;
#pragma unroll
        for (int ai = 0; ai < 2; ++ai) {
            u32x4 v[4][2];
#pragma unroll
            for (int m = 0; m < 4; ++m)
#pragma unroll
                for (int bj = 0; bj < 2; ++bj) v[m][bj] = *(const gu32x4*)(hin + (size_t)(row0 + ai * HALF + m * 16) * 2048 + col0 + bj * HALF);
#pragma unroll
            for (int m = 0; m < 4; ++m) { const int row = row0 + ai * HALF + m * 16; const size_t off = (size_t)row * 2048 + col0; float ss = 0.f;
#pragma unroll
                for (int bj = 0; bj < 2; ++bj) { f32x4 h0, h1; unpack8(v[m][bj], h0, h1); const f32x4 o0 = h0 + acc[ai][bj][m][0], o1 = h1 + acc[ai][bj][m][1];
                    ss += o0[0] * o0[0] + o0[1] * o0[1] + o0[2] * o0[2] + o0[3] * o0[3] + o1[0] * o1[0] + o1[1] * o1[1] + o1[2] * o1[2] + o1[3] * o1[3];
                    *(gu32x4*)(hout + off + bj * HALF) = pack8(o0, o1); }
                ss = fq_sum(ss);
                if (fq == 0) ssq_add(ssq_out, row, ss); }
            asm volatile("" ::: "memory"); }
    }
};
struct EpiPleF32 {
    static constexpr bool PERM = true, AFTER_DRAIN = false;
    const bf16_t* hin; const bf16_t* t; bf16_t* hout; const ssq_t* ssq_in; ssq_t* ssq_out;
    __device__ __forceinline__ void operator()(const f32x4 (&acc)[2][2][4][2], const Unit& u, int wr, int wc, int fr, int fq) const {
        { int l_ = (int)__builtin_amdgcn_mbcnt_hi(~0u, __builtin_amdgcn_mbcnt_lo(~0u, 0u)); asm volatile("" : "+v"(l_)); fr = l_ & 15; fq = l_ >> 4; }
        const int row0 = u.pm * BM + wr * 64 + fr, col0 = u.pn * BM + wc * 32 + 8 * fq;
#pragma unroll
        for (int ai = 0; ai < 2; ++ai)
#pragma unroll
            for (int mp = 0; mp < 2; ++mp) {
                u32x4 hv[2][2], tv[2][2];
#pragma unroll
                for (int mm = 0; mm < 2; ++mm)
#pragma unroll
                    for (int bj = 0; bj < 2; ++bj) { const size_t o_ = (size_t)(row0 + ai * HALF + (mp * 2 + mm) * 16) * 2048 + col0 + bj * HALF; hv[mm][bj] = *(const gu32x4*)(hin + o_); tv[mm][bj] = *(const gu32x4*)(t + o_); }
#pragma unroll
                for (int mm = 0; mm < 2; ++mm) { const int m = mp * 2 + mm, row = row0 + ai * HALF + m * 16; const size_t off = (size_t)row * 2048 + col0; const float rs = rstd_of(ssq_in, row); float ss = 0.f;
#pragma unroll
                    for (int bj = 0; bj < 2; ++bj) { f32x4 h[2], tt[2], o[2]; unpack8(hv[mm][bj], h[0], h[1]); unpack8(tv[mm][bj], tt[0], tt[1]);
#pragma unroll
                        for (int n = 0; n < 2; ++n)
#pragma unroll
                            for (int e = 0; e < 4; ++e) { const float x = h[n][e] + tt[n][e] * __builtin_amdgcn_rcpf(1.0f + __expf(-acc[ai][bj][m][n][e] * rs)); o[n][e] = x; ss += x * x; }
                        *(gu32x4*)(hout + off + bj * HALF) = pack8(o[0], o[1]); }
                    ss = fq_sum(ss);
                    if (fq == 0) ssq_add(ssq_out, row, ss); }
                asm volatile("" ::: "memory"); }
    }
};
struct EpiStoreBf16 {
    static constexpr bool PERM = true, AFTER_DRAIN = false;
    bf16_t* O; int ldc;
    __device__ __forceinline__ void operator()(const f32x4 (&acc)[2][2][4][2], const Unit& u, int wr, int wc, int fr, int fq) const {
        { int l_ = (int)__builtin_amdgcn_mbcnt_hi(~0u, __builtin_amdgcn_mbcnt_lo(~0u, 0u)); asm volatile("" : "+v"(l_)); fr = l_ & 15; fq = l_ >> 4; }
        const int row0 = u.pm * BM + wr * 64 + fr, col0 = u.pn * BM + wc * 32 + 8 * fq;
#pragma unroll
        PG8_FOR_ROWS { bf16_t* rowp = O + (size_t)(row0 + ai * HALF + m * 16) * ldc + col0;
#pragma unroll
            for (int bj = 0; bj < 2; ++bj) { const f32x4 v0 = acc[ai][bj][m][0], v1 = acc[ai][bj][m][1];
                u32x4 w; w.x = cvt_pk_bf16(v0[0], v0[1]); w.y = cvt_pk_bf16(v0[2], v0[3]); w.z = cvt_pk_bf16(v1[0], v1[1]); w.w = cvt_pk_bf16(v1[2], v1[3]);
                *(gu32x4*)(rowp + bj * HALF) = w; } }
    }
};
struct EpiSwigluBf16 {
    static constexpr bool PERM = true, AFTER_DRAIN = false;
    bf16_t* act; int ldc; const ssq_t* ssq;
    __device__ __forceinline__ void operator()(const f32x4 (&acc)[2][2][4][2], const Unit& u, int wr, int wc, int fr, int fq) const {
        { int l_ = (int)__builtin_amdgcn_mbcnt_hi(~0u, __builtin_amdgcn_mbcnt_lo(~0u, 0u)); asm volatile("" : "+v"(l_)); fr = l_ & 15; fq = l_ >> 4; }
        const int row0 = u.pm * BM + wr * 64 + fr, ch0 = u.pn * HALF + wc * 32 + 8 * fq;
        float rs[2][4];
#pragma unroll
        PG8_FOR_ROWS rs[ai][m] = rstd_of(ssq, row0 + ai * HALF + m * 16);
#pragma unroll
        PG8_FOR_ROWS { bf16_t* rowp = act + (size_t)(row0 + ai * HALF + m * 16) * ldc + ch0; float o[8]; const float r_ = rs[ai][m];
#pragma unroll
            for (int n = 0; n < 2; ++n)
#pragma unroll
                for (int e = 0; e < 4; ++e) { const float g = acc[ai][0][m][n][e] * r_, up = acc[ai][1][m][n][e] * r_; o[n * 4 + e] = g * __builtin_amdgcn_rcpf(1.0f + __expf(-g)) * up; }
            u32x4 w; w.x = cvt_pk_bf16(o[0], o[1]); w.y = cvt_pk_bf16(o[2], o[3]); w.z = cvt_pk_bf16(o[4], o[5]); w.w = cvt_pk_bf16(o[6], o[7]);
            *(gu32x4*)rowp = w; }
    }
};
struct EpiMlaIn {
    static constexpr bool PERM = true, AFTER_DRAIN = false;
    bf16_t* CQ; bf16_t* CKV; bf16_t* KRB; float* out; int j; const ssq_t* ssq_h; ssq_t* ssq_q; ssq_t* ssq_kv; const float* gkr; const float* tm;
    __device__ __forceinline__ void operator()(const f32x4 (&acc)[2][2][4][2], const Unit& u, int wr, int wc, int fr, int fq) const {
        { int l_ = (int)__builtin_amdgcn_mbcnt_hi(~0u, __builtin_amdgcn_mbcnt_lo(~0u, 0u)); asm volatile("" : "+v"(l_)); fr = l_ & 15; fq = l_ >> 4; }
        const int row0 = u.pm * BM + wr * 64 + fr, cw = wc * 32 + 8 * fq;
        if (u.pn < 4) {
            const bool iskv = u.pn >= 2; bf16_t* dst = iskv ? CKV : CQ; ssq_t* sq = iskv ? ssq_kv : ssq_q; const int c0 = (u.pn & 1) * 256 + cw;
#pragma unroll
            PG8_FOR_ROWS { const int row = row0 + ai * HALF + m * 16; const float rs = rstd_of(ssq_h, row); float ss = 0.f;
                float* lo = iskv ? (row < NPR ? out + O_LATP + ((size_t)j * NPR + row) * 512 : out + O_LATS + ((size_t)j * NSR + (row - NPR)) * 512) + c0 : nullptr;
#pragma unroll
                for (int bj = 0; bj < 2; ++bj) { const f32x4 a = acc[ai][bj][m][0] * rs, b = acc[ai][bj][m][1] * rs;
                    ss += a[0] * a[0] + a[1] * a[1] + a[2] * a[2] + a[3] * a[3] + b[0] * b[0] + b[1] * b[1] + b[2] * b[2] + b[3] * b[3];
                    *(gu32x4*)(dst + (size_t)row * 512 + c0 + bj * HALF) = pack8(a, b);
                    if (iskv) { *(gf32x4*)(lo + bj * HALF) = a; *(gf32x4*)(lo + bj * HALF + 4) = b; } }
                ss = fq_sum(ss); if (fq == 0) ssq_add(sq, row, ss); }
        } else if (wc == 0) {
            f32x4 g[2][2];
#pragma unroll
            for (int bj = 0; bj < 2; ++bj)
#pragma unroll
                for (int n = 0; n < 2; ++n) g[bj][n] = *(const gf32x4*)(gkr + 32 * bj + 8 * fq + 4 * n);
#pragma unroll
            PG8_FOR_ROWS { const int row = row0 + ai * HALF + m * 16; const float rs = rstd_of(ssq_h, row); f32x4 x[2][2]; float ss = 0.f;
#pragma unroll
                for (int bj = 0; bj < 2; ++bj)
#pragma unroll
                    for (int n = 0; n < 2; ++n) { x[bj][n] = acc[ai][bj][m][n] * rs; ss += x[bj][n][0] * x[bj][n][0] + x[bj][n][1] * x[bj][n][1] + x[bj][n][2] * x[bj][n][2] + x[bj][n][3] * x[bj][n][3]; }
                const float r2 = rsqrtf(fq_sum(ss) * (1.0f / 64) + 1e-6f);
                const float* tp = tm + ((size_t)pos_of_row(row) * 32 + 8 * fq) * 2;
                f32x4 o[2][2];
#pragma unroll
                for (int n = 0; n < 2; ++n) { const f32x4 t0 = *(const gf32x4*)(tp + 8 * n), t1 = *(const gf32x4*)(tp + 8 * n + 4);
                    const float cs[4] = {t0[0], t0[2], t1[0], t1[2]}, sn[4] = {t0[1], t0[3], t1[1], t1[3]};
#pragma unroll
                    for (int e = 0; e < 4; ++e) { const float x1 = x[0][n][e] * r2 * g[0][n][e], x2 = x[1][n][e] * r2 * g[1][n][e]; o[0][n][e] = x1 * cs[e] - x2 * sn[e]; o[1][n][e] = x2 * cs[e] + x1 * sn[e]; } }
                float* ko = (row < NPR ? out + O_KRP + ((size_t)j * NPR + row) * 64 : out + O_KRS + ((size_t)j * NSR + (row - NPR)) * 64) + 8 * fq;
                bf16_t* kb = KRB + (size_t)latrow_of(row) * 64 + 8 * fq;
#pragma unroll
                for (int bj = 0; bj < 2; ++bj) { *(gf32x4*)(ko + 32 * bj) = o[bj][0]; *(gf32x4*)(ko + 32 * bj + 4) = o[bj][1]; *(gu32x4*)(kb + 32 * bj) = pack8(o[bj][0], o[bj][1]); } }
        }
    }
};

struct EpiQup {
    static constexpr bool PERM = true, AFTER_DRAIN = false;
    bf16_t* Q; const ssq_t* ssq_q; const float* gqn; const float* gqr; const float* tm; lfloat* xch;
    __device__ __forceinline__ void operator()(const f32x4 (&acc)[2][2][4][2], const Unit& u, int wr, int wc, int fr, int fq) const {
        { int l_ = (int)__builtin_amdgcn_mbcnt_hi(~0u, __builtin_amdgcn_mbcnt_lo(~0u, 0u)); asm volatile("" : "+v"(l_)); fr = l_ & 15; fq = l_ >> 4; }
        const int row0 = u.pm * BM + wr * 64 + fr, rl0 = wr * 64 + fr;
        float rs[2][4];
#pragma unroll
        PG8_FOR_ROWS rs[ai][m] = rsqrtf(ssq_val(ssq_q, row0 + ai * HALF + m * 16) * (1.0f / 512) + 1e-6f);
        if (u.pn < 8) {
#pragma unroll
            PG8_FOR_ROWS {
#pragma unroll
                for (int bj = 0; bj < 2; ++bj) { const f32x4 a = acc[ai][bj][m][0], b = acc[ai][bj][m][1];
                    float ss = a[0] * a[0] + a[1] * a[1] + a[2] * a[2] + a[3] * a[3] + b[0] * b[0] + b[1] * b[1] + b[2] * b[2] + b[3] * b[3];
                    ss = fq_sum(ss) * rs[ai][m] * rs[ai][m]; if (fq == 0) xch[((rl0 + ai * HALF + m * 16) * 2 + bj) * 4 + wc] = ss; } }
            wg_bar();
            const f32x4 g0 = *(const gf32x4*)(gqn + wc * 32 + 8 * fq), g1 = *(const gf32x4*)(gqn + wc * 32 + 8 * fq + 4);
#pragma unroll
            PG8_FOR_ROWS { const int row = row0 + ai * HALF + m * 16;
#pragma unroll
                for (int bj = 0; bj < 2; ++bj) { const f32x4 t = *(const lf32x4*)(xch + ((rl0 + ai * HALF + m * 16) * 2 + bj) * 4);
                    const float r2 = rsqrtf((t[0] + t[1] + t[2] + t[3]) * (1.0f / 128) + 1e-6f) * rs[ai][m];
                    *(gu32x4*)(Q + (size_t)row * NQUP + (2 * u.pn + bj) * 192 + wc * 32 + 8 * fq) = pack8(acc[ai][bj][m][0] * r2 * g0, acc[ai][bj][m][1] * r2 * g1); } }
        } else {
            const int hd = 4 * (u.pn - 8) + wc; f32x4 g[2][2];
#pragma unroll
            for (int bj = 0; bj < 2; ++bj)
#pragma unroll
                for (int n = 0; n < 2; ++n) g[bj][n] = *(const gf32x4*)(gqr + 32 * bj + 8 * fq + 4 * n);
#pragma unroll
            PG8_FOR_ROWS { const int row = row0 + ai * HALF + m * 16; f32x4 x[2][2]; float ss = 0.f;
#pragma unroll
                for (int bj = 0; bj < 2; ++bj)
#pragma unroll
                    for (int n = 0; n < 2; ++n) { x[bj][n] = acc[ai][bj][m][n] * rs[ai][m]; ss += x[bj][n][0] * x[bj][n][0] + x[bj][n][1] * x[bj][n][1] + x[bj][n][2] * x[bj][n][2] + x[bj][n][3] * x[bj][n][3]; }
                const float r2 = rsqrtf(fq_sum(ss) * (1.0f / 64) + 1e-6f);
                const float* tp = tm + ((size_t)pos_of_row(row) * 32 + 8 * fq) * 2;
                f32x4 o[2][2];
#pragma unroll
                for (int n = 0; n < 2; ++n) { const f32x4 t0 = *(const gf32x4*)(tp + 8 * n), t1 = *(const gf32x4*)(tp + 8 * n + 4);
                    const float cs[4] = {t0[0], t0[2], t1[0], t1[2]}, sn[4] = {t0[1], t0[3], t1[1], t1[3]};
#pragma unroll
                    for (int e = 0; e < 4; ++e) { const float x1 = x[0][n][e] * r2 * g[0][n][e], x2 = x[1][n][e] * r2 * g[1][n][e]; o[0][n][e] = x1 * cs[e] - x2 * sn[e]; o[1][n][e] = x2 * cs[e] + x1 * sn[e]; } }
                bf16_t* qp = Q + (size_t)row * NQUP + hd * 192 + 128 + 8 * fq;
#pragma unroll
                for (int bj = 0; bj < 2; ++bj) *(gu32x4*)(qp + 32 * bj) = pack8(o[bj][0], o[bj][1]); }
        }
    }
};

struct EpiKvup {
    static constexpr bool PERM = true, AFTER_DRAIN = false;
    bf16_t* KV; const ssq_t* ssq_kv; const float* gkn; lfloat* xch;
    __device__ __forceinline__ void operator()(const f32x4 (&acc)[2][2][4][2], const Unit& u, int wr, int wc, int fr, int fq) const {
        { int l_ = (int)__builtin_amdgcn_mbcnt_hi(~0u, __builtin_amdgcn_mbcnt_lo(~0u, 0u)); asm volatile("" : "+v"(l_)); fr = l_ & 15; fq = l_ >> 4; }
        const int row0 = u.pm * BM + wr * 64 + fr, rl0 = wr * 64 + fr;
        float rs[2][4];
#pragma unroll
        PG8_FOR_ROWS rs[ai][m] = ssq_kv ? rsqrtf(ssq_val(ssq_kv, row0 + ai * HALF + m * 16) * (1.0f / 512) + 1e-6f) : 1.0f;
#pragma unroll
        PG8_FOR_ROWS { const f32x4 a = acc[ai][0][m][0], b = acc[ai][0][m][1];
            float ss = a[0] * a[0] + a[1] * a[1] + a[2] * a[2] + a[3] * a[3] + b[0] * b[0] + b[1] * b[1] + b[2] * b[2] + b[3] * b[3];
            ss = fq_sum(ss) * rs[ai][m] * rs[ai][m]; if (fq == 0) xch[(rl0 + ai * HALF + m * 16) * 4 + wc] = ss; }
        wg_bar();
        const f32x4 g0 = *(const gf32x4*)(gkn + wc * 32 + 8 * fq), g1 = *(const gf32x4*)(gkn + wc * 32 + 8 * fq + 4);
#pragma unroll
        PG8_FOR_ROWS { const int row = row0 + ai * HALF + m * 16; const int orow = ssq_kv ? latrow_of(row) : NPR + (row >> 10) * KVPB + (row & 1023);
            const f32x4 t = *(const lf32x4*)(xch + (rl0 + ai * HALF + m * 16) * 4);
            const float r2 = rsqrtf((t[0] + t[1] + t[2] + t[3]) * (1.0f / 128) + 1e-6f) * rs[ai][m];
            bf16_t* kp = KV + (size_t)orow * NKVUP + u.pn * 256 + wc * 32 + 8 * fq;
            *(gu32x4*)kp = pack8(acc[ai][0][m][0] * r2 * g0, acc[ai][0][m][1] * r2 * g1);
            *(gu32x4*)(kp + HALF) = pack8(acc[ai][1][m][0] * rs[ai][m], acc[ai][1][m][1] * rs[ai][m]); }
    }
};

struct EpiSwaQkv {
    static constexpr bool PERM = true, AFTER_DRAIN = false;
    bf16_t* SQ; bf16_t* SK; bf16_t* SV; float* out; int j; const ssq_t* ssq_h; const float* gq; const float* gk; const float* ts;
    __device__ __forceinline__ float* state_out(int row, bool isk) const {
        if (row < NPR) { const int b = row >> 12, t = row & 4095; if (t < SEQ - 128) return nullptr; return out + (isk ? O_SKP : O_SVP) + (((size_t)j * 4 + b) * 128 + (t - (SEQ - 128))) * 256; }
        const int b = (row - NPR) >> 4, t = (row - NPR) & 15; return out + (isk ? O_SKS : O_SVS) + (((size_t)j * 16 + b) * 128 + 112 + t) * 256;
    }
    __device__ __forceinline__ void operator()(const f32x4 (&acc)[2][2][4][2], const Unit& u, int wr, int wc, int fr, int fq) const {
        { int l_ = (int)__builtin_amdgcn_mbcnt_hi(~0u, __builtin_amdgcn_mbcnt_lo(~0u, 0u)); asm volatile("" : "+v"(l_)); fr = l_ & 15; fq = l_ >> 4; }
        const int row0 = u.pm * BM + wr * 64 + fr;
        if (u.pn < 9) {
            const bool isk = u.pn == 8; const float* gg = isk ? gk : gq;
            typedef float f32x2_ __attribute__((ext_vector_type(2))); typedef PG8_GAS f32x2_ gf32x2_;
            f32x4 g[2][2];
#pragma unroll
            for (int bj = 0; bj < 2; ++bj) { const f32x2_ gr = *(const gf32x2_*)(gg + 8 * bj + 2 * fq); const float* gn = gg + 16 + 24 * bj + 6 * fq;
                const f32x2_ g0 = *(const gf32x2_*)gn, g1 = *(const gf32x2_*)(gn + 2), g2 = *(const gf32x2_*)(gn + 4);
                g[bj][0] = (f32x4){gr[0], gr[1], g0[0], g0[1]}; g[bj][1] = (f32x4){g1[0], g1[1], g2[0], g2[1]}; }
            f32x4 tb[2][4];
#pragma unroll
            PG8_FOR_ROWS tb[ai][m] = *(const gf32x4*)(ts + (size_t)pos_of_row(row0 + ai * HALF + m * 16) * 16 + 4 * fq);
#pragma unroll
            PG8_FOR_ROWS { const int row = row0 + ai * HALF + m * 16; const float rs = rstd_of(ssq_h, row); f32x4 x[2][2]; float ss = 0.f;
#pragma unroll
                for (int bj = 0; bj < 2; ++bj)
#pragma unroll
                    for (int n = 0; n < 2; ++n) { x[bj][n] = acc[ai][bj][m][n] * rs; ss += x[bj][n][0] * x[bj][n][0] + x[bj][n][1] * x[bj][n][1] + x[bj][n][2] * x[bj][n][2] + x[bj][n][3] * x[bj][n][3]; }
                const float r2 = rsqrtf(fq_sum(ss) * (1.0f / 64) + 1e-6f);
#pragma unroll
                for (int bj = 0; bj < 2; ++bj)
#pragma unroll
                    for (int n = 0; n < 2; ++n) x[bj][n] = x[bj][n] * r2 * g[bj][n];
                { const f32x4 t = tb[ai][m];
#pragma unroll
                    for (int e = 0; e < 2; ++e) { const float cs = t[2 * e], sn = t[2 * e + 1], x1 = x[0][0][e], x2 = x[1][0][e]; x[0][0][e] = x1 * cs - x2 * sn; x[1][0][e] = x2 * cs + x1 * sn; } }
                if (!isk) {
#pragma unroll
                    for (int bj = 0; bj < 2; ++bj) *(gu32x4*)(SQ + (size_t)row * DM + (4 * u.pn + wc) * 64 + 32 * bj + 8 * fq) = pack8(x[bj][0], x[bj][1]);
                } else { float* so = state_out(row, true);
#pragma unroll
                    for (int bj = 0; bj < 2; ++bj) { *(gu32x4*)(SK + (size_t)skrow_of(row) * 256 + wc * 64 + 32 * bj + 8 * fq) = pack8(x[bj][0], x[bj][1]);
                        if (so) { float* sr_ = so + wc * 64 + 8 * bj + 2 * fq; float* sn_ = so + wc * 64 + 16 + 24 * bj + 6 * fq;
                            *(gf32x2_*)sr_ = (f32x2_){x[bj][0][0], x[bj][0][1]}; *(gf32x2_*)sn_ = (f32x2_){x[bj][0][2], x[bj][0][3]};
                            *(gf32x2_*)(sn_ + 2) = (f32x2_){x[bj][1][0], x[bj][1][1]}; *(gf32x2_*)(sn_ + 4) = (f32x2_){x[bj][1][2], x[bj][1][3]}; } } }
            }
        } else {
#pragma unroll
            PG8_FOR_ROWS { const int row = row0 + ai * HALF + m * 16; const float rs = rstd_of(ssq_h, row); float* so = state_out(row, false);
#pragma unroll
                for (int bj = 0; bj < 2; ++bj) { const f32x4 a = acc[ai][bj][m][0] * rs, b = acc[ai][bj][m][1] * rs; const int c = bj * HALF + wc * 32 + 8 * fq;
                    *(gu32x4*)(SV + (size_t)skrow_of(row) * 256 + c) = pack8(a, b);
                    if (so) { *(gf32x4*)(so + c) = a; *(gf32x4*)(so + c + 4) = b; } } }
        }
    }
};
#undef PG8_FOR_ROWS

template <class Epi, class Sched, bool ALIGN_EPI = false, bool SP2 = false>
__device__ __forceinline__ void gemm_phase(int wv, PG8_LAS unsigned char* lds, const Gemm g, const Sched& S, const Epi& E) {
    const int tid = ltid(wv), wid = __builtin_amdgcn_readfirstlane(tid >> 6), lane = tid & 63, wr = wid >> 2, wc = wid & 3, fr = lane & 15, fq = lane >> 4;
    const int K = g.K, nt = K / BK;
    unsigned voffA[2], voffB[2];
#pragma unroll
    for (int i = 0; i < 2; ++i) { int R, C; stage_rc(tid * 16 + i * 8192, R, C); const int Rb = Epi::PERM ? ((R & ~31) + perm32(R & 31)) : R;
        voffA[i] = (unsigned)(R * K + C) * 2u; voffB[i] = (unsigned)(Rb * K + C) * 2u; }
    const size_t kstep = (size_t)(BK * 2);
    const size_t hstep = (size_t)HALF * K * 2;
    const size_t tstep = 2 * hstep;
    const unsigned ldsw = (unsigned)wid * 1024u;
    const int aoff = lds_byte(wr * 64 + fr, fq * 8), boff = lds_byte(wc * 32 + fr, fq * 8);
#define PG8_SA(b, h) (((b) * 2 + (h)) * HTB)
#define PG8_SB(b, h) ((4 + (b) * 2 + (h)) * HTB)
#define PG8_STAGE(bufoff, gbase, voff) do { _Pragma("unroll") for (int _i = 0; _i < 2; ++_i) \
        __builtin_amdgcn_global_load_lds((const unsigned*)((const char*)(gbase) + (voff)[_i]), (PG8_LAS unsigned*)(lds + (bufoff) + ldsw + _i * 8192), 16, 0, 0); } while (0)
#define PG8_LDA(dst, b, h) do { _Pragma("unroll") for (int m = 0; m < 4; ++m) _Pragma("unroll") for (int k = 0; k < 2; ++k) dst[m][k] = *(const PG8_LAS bf16x8*)(lds + PG8_SA(b, h) + aoff + m * 2048 + k * 1024); } while (0)
#define PG8_LDB(dst, b, h) do { _Pragma("unroll") for (int n = 0; n < 2; ++n) _Pragma("unroll") for (int k = 0; k < 2; ++k) dst[n][k] = *(const PG8_LAS bf16x8*)(lds + PG8_SB(b, h) + boff + n * 2048 + k * 1024); } while (0)
#define PG8_MMA(ai, bj, At, Bt) do { __builtin_amdgcn_s_setprio(1); _Pragma("unroll") for (int m = 0; m < 4; ++m) _Pragma("unroll") for (int n = 0; n < 2; ++n) _Pragma("unroll") for (int k = 0; k < 2; ++k) \
        acc[ai][bj][m][n] = __builtin_amdgcn_mfma_f32_16x16x32_bf16(Bt[n][k], At[m][k], acc[ai][bj][m][n], 0, 0, 0); __builtin_amdgcn_s_setprio(0); } while (0)
#define PG8_WAIT_V(n) asm volatile("s_waitcnt vmcnt(" #n ")" ::: "memory")
#define PG8_WAIT_L(n) asm volatile("s_waitcnt lgkmcnt(" #n ")" ::: "memory")
#define PG8_BAR __builtin_amdgcn_s_barrier()
#define PG8_SCHED __builtin_amdgcn_sched_barrier(0)
    Unit cur, nxt; int ui = 0;
    if (!S.next(0, cur)) return;
    f32x4 acc[2][2][4][2];
#pragma unroll
    for (int a = 0; a < 2; ++a)
#pragma unroll
        for (int b = 0; b < 2; ++b)
#pragma unroll
            for (int m = 0; m < 4; ++m)
#pragma unroll
                for (int n = 0; n < 2; ++n) acc[a][b][m][n] = (f32x4){0.f, 0.f, 0.f, 0.f};
    bf16x8 At[4][2], B0[2][2], B1[2][2];
    const char* cA = (const char*)g.A + (size_t)cur.pm * tstep; const char* cB = (const char*)g.Bt + (size_t)cur.pn * tstep;
    S.a_ready(cur);
    if constexpr (SP2) {
        PG8_STAGE(PG8_SB(0, 0), cB, voffB); PG8_STAGE(PG8_SB(0, 1), cB + hstep, voffB); PG8_STAGE(PG8_SA(0, 0), cA, voffA); PG8_STAGE(PG8_SA(0, 1), cA + hstep, voffA);
        if (wr == 1) PG8_BAR;
        PG8_WAIT_V(2); PG8_BAR;
        PG8_STAGE(PG8_SB(1, 0), cB + kstep, voffB); PG8_STAGE(PG8_SA(1, 0), cA + kstep, voffA); PG8_STAGE(PG8_SB(1, 1), cB + hstep + kstep, voffB);
        PG8_WAIT_V(6); PG8_BAR;
    } else {
        PG8_STAGE(PG8_SB(0, 0), cB, voffB); PG8_STAGE(PG8_SA(0, 0), cA, voffA); PG8_STAGE(PG8_SB(0, 1), cB + hstep, voffB); PG8_STAGE(PG8_SA(0, 1), cA + hstep, voffA);
        if (wr == 1) PG8_BAR;
        PG8_WAIT_V(4); PG8_BAR;
        PG8_STAGE(PG8_SB(1, 0), cB + kstep, voffB); PG8_STAGE(PG8_SA(1, 0), cA + kstep, voffA); PG8_STAGE(PG8_SB(1, 1), cB + hstep + kstep, voffB);
        PG8_WAIT_V(6); PG8_BAR;
    }
    for (;;) {
        const bool has_next = S.next(ui + 1, nxt);
        const char* nA = has_next ? (const char*)g.A + (size_t)nxt.pm * tstep : cA; const char* nB = has_next ? (const char*)g.Bt + (size_t)nxt.pn * tstep : cB;
        for (int t = 0; t < nt; t += 2) {
            const bool last = (t == nt - 2);
            const char* a1 = cA + (size_t)(t + 1) * kstep;
            const char* a2 = last ? nA : cA + (size_t)(t + 2) * kstep; const char* b2 = last ? nB : cB + (size_t)(t + 2) * kstep;
            const char* a3 = a2 + kstep; const char* b3 = b2 + kstep;
            if (last && has_next) S.a_ready(nxt);
            if constexpr (SP2) {
            PG8_LDB(B0, 0, 0); PG8_LDB(B1, 0, 1); PG8_SCHED; PG8_LDA(At, 0, 0); PG8_STAGE(PG8_SA(1, 1), a1 + hstep, voffA);
            PG8_WAIT_V(8); PG8_WAIT_L(0); PG8_BAR; PG8_MMA(0, 0, At, B0); PG8_MMA(0, 1, At, B1); PG8_BAR; PG8_SCHED;
            PG8_LDA(At, 0, 1); PG8_STAGE(PG8_SB(0, 0), b2, voffB); PG8_STAGE(PG8_SB(0, 1), b2 + hstep, voffB); PG8_STAGE(PG8_SA(0, 0), a2, voffA);
            PG8_WAIT_V(8); PG8_WAIT_L(0); PG8_BAR; PG8_MMA(1, 0, At, B0); PG8_MMA(1, 1, At, B1); PG8_BAR; PG8_SCHED;
            PG8_LDB(B0, 1, 0); PG8_LDB(B1, 1, 1); PG8_SCHED; PG8_LDA(At, 1, 0); PG8_STAGE(PG8_SA(0, 1), a2 + hstep, voffA);
            PG8_WAIT_V(8); PG8_WAIT_L(0); PG8_BAR; PG8_MMA(0, 0, At, B0); PG8_MMA(0, 1, At, B1); PG8_BAR; PG8_SCHED;
            PG8_LDA(At, 1, 1); PG8_STAGE(PG8_SB(1, 0), b3, voffB); PG8_STAGE(PG8_SB(1, 1), b3 + hstep, voffB); PG8_STAGE(PG8_SA(1, 0), a3, voffA);
            PG8_WAIT_V(8); PG8_WAIT_L(0); PG8_BAR; PG8_MMA(1, 0, At, B0); PG8_MMA(1, 1, At, B1); PG8_BAR; PG8_SCHED;
            } else {
            PG8_LDB(B0, 0, 0); PG8_SCHED; PG8_LDA(At, 0, 0); PG8_STAGE(PG8_SA(1, 1), a1 + hstep, voffA);
            PG8_WAIT_L(8); PG8_BAR; PG8_WAIT_L(0); PG8_MMA(0, 0, At, B0); PG8_BAR; PG8_SCHED;
            PG8_LDB(B1, 0, 1); PG8_STAGE(PG8_SB(0, 0), b2, voffB);
            PG8_BAR; PG8_WAIT_L(0); PG8_MMA(0, 1, At, B1); PG8_BAR;
            PG8_LDA(At, 0, 1); PG8_STAGE(PG8_SA(0, 0), a2, voffA);
            PG8_BAR; PG8_WAIT_L(0); PG8_MMA(1, 0, At, B0); PG8_BAR; PG8_SCHED;
            PG8_STAGE(PG8_SB(0, 1), b2 + hstep, voffB);
            PG8_WAIT_V(6); PG8_BAR; PG8_MMA(1, 1, At, B1); PG8_BAR;
            PG8_LDB(B0, 1, 0); PG8_SCHED; PG8_LDA(At, 1, 0); PG8_STAGE(PG8_SA(0, 1), a2 + hstep, voffA);
            PG8_WAIT_L(8); PG8_BAR; PG8_WAIT_L(0); PG8_MMA(0, 0, At, B0); PG8_BAR; PG8_SCHED;
            PG8_LDB(B1, 1, 1); PG8_STAGE(PG8_SB(1, 0), b3, voffB);
            PG8_BAR; PG8_WAIT_L(0); PG8_MMA(0, 1, At, B1); PG8_BAR;
            PG8_LDA(At, 1, 1); PG8_STAGE(PG8_SA(1, 0), a3, voffA);
            PG8_BAR; PG8_WAIT_L(0); PG8_MMA(1, 0, At, B0); PG8_BAR; PG8_SCHED;
            PG8_STAGE(PG8_SB(1, 1), b3 + hstep, voffB);
            PG8_WAIT_V(6); PG8_BAR; PG8_MMA(1, 1, At, B1); PG8_BAR;
            }
        }
        if constexpr (ALIGN_EPI) { if (wr == 0) PG8_BAR; }
        if constexpr (!Epi::AFTER_DRAIN) { E(acc, cur, wr, wc, fr, fq); S.done(cur); }
        if (!has_next) break;
#pragma unroll
        for (int a = 0; a < 2; ++a)
#pragma unroll
            for (int b = 0; b < 2; ++b)
#pragma unroll
                for (int m = 0; m < 4; ++m)
#pragma unroll
                    for (int n = 0; n < 2; ++n) acc[a][b][m][n] = (f32x4){0.f, 0.f, 0.f, 0.f};
        cur = nxt; cA = nA; cB = nB; ++ui;
        if constexpr (ALIGN_EPI) { if (wr == 1) PG8_BAR; }
    }
    PG8_WAIT_V(0);
    if constexpr (!ALIGN_EPI) { if (wr == 0) PG8_BAR; }
    PG8_BAR;
    if constexpr (Epi::AFTER_DRAIN) { E.fused(acc, cur, wr, wc, fr, fq, lds, wid, lane); S.done(cur); }
#undef PG8_SA
#undef PG8_SB
#undef PG8_STAGE
#undef PG8_LDA
#undef PG8_LDB
#undef PG8_MMA
#undef PG8_WAIT_V
#undef PG8_WAIT_L
#undef PG8_BAR
#undef PG8_SCHED
}
}

#define DPPF(v, ctrl) __uint_as_float((unsigned)__builtin_amdgcn_update_dpp(0, (int)__float_as_uint(v), (ctrl), 0xF, 0xF, true))
__device__ __forceinline__ float g16_sum(float v) { v += DPPF(v, 0xB1); v += DPPF(v, 0x4E); v += DPPF(v, 0x141); v += DPPF(v, 0x140); return v; }
__device__ __forceinline__ float x8_16(float v) { return DPPF(v, 0x128); }
template <int NB> struct SgB { const bf16_t* p[NB]; };
template <int NB, int U, class F>
__device__ __forceinline__ void sg_item(int wv, char* lds, const bf16_t* A  , int K, const SgB<NB>& B, const F& f) {
    constexpr int NBC = NB * 32, NV = NBC / 16;
    const int tid = ltid(wv), lane = tid & 63, r32 = lane & 31, hi = lane >> 5;
    LAS float* L = (LAS float*)lds;
    const int k0 = wv * (K >> 3), nst = K >> 7;
    const size_t lo = (size_t)r32 * K + k0 + hi * 8;
    typedef __attribute__((address_space(1))) bf16x8 gbf8;
    const gbf8* ap = (const gbf8*)(A + lo);
    const gbf8* bp[NB];
#pragma unroll
    for (int cb = 0; cb < NB; ++cb) bp[cb] = (const gbf8*)(B.p[cb] + lo);
    f32x16 acc[NB];
#pragma unroll
    for (int cb = 0; cb < NB; ++cb) acc[cb] = (f32x16){};
    for (int s0 = 0; s0 < nst; s0 += U) {
        bf16x8 a[U], b[NB][U];
#pragma unroll
        for (int u = 0; u < U; ++u) { a[u] = ap[(s0 + u) * 2];
#pragma unroll
            for (int cb = 0; cb < NB; ++cb) b[cb][u] = bp[cb][(s0 + u) * 2]; }
        SBAR();
#pragma unroll
        for (int u = 0; u < U; ++u)
#pragma unroll
            for (int cb = 0; cb < NB; ++cb) acc[cb] = __builtin_amdgcn_mfma_f32_32x32x16_bf16(a[u], b[cb][u], acc[cb], 0, 0, 0);
    }
#pragma unroll
    for (int cb = 0; cb < NB; ++cb)
#pragma unroll
        for (int r = 0; r < 16; ++r) L[(wv * 32 + crow(r, hi)) * NBC + cb * 32 + r32] = acc[cb][r];
    __syncthreads();
    const int row = 4 * wv + (lane >> 4), c0 = (lane & 15) * NV;
    float v[NV];
#pragma unroll
    for (int e = 0; e < NV; ++e) v[e] = 0.f;
#pragma unroll
    for (int q = 0; q < 8; ++q)
#pragma unroll
        for (int e4 = 0; e4 < NV / 4; ++e4) { const f32x4 t = *(const LAS f32x4*)(L + (q * 32 + row) * NBC + c0 + e4 * 4); v[e4 * 4] += t[0]; v[e4 * 4 + 1] += t[1]; v[e4 * 4 + 2] += t[2]; v[e4 * 4 + 3] += t[3]; }
    f(row, c0, lane & 15, v);
    __syncthreads();
}
template <int NB16, int U>
__device__ __forceinline__ void sg16_batch(f32x4 (&acc)[2][NB16], const __attribute__((address_space(1))) bf16x8* const (&ap)[2], const __attribute__((address_space(1))) bf16x8* const (&bp)[NB16], int s0) {
    bf16x8 a[U][2], b[U][NB16];
#pragma unroll
    for (int u = 0; u < U; ++u) {
#pragma unroll
        for (int ra = 0; ra < 2; ++ra) a[u][ra] = ap[ra][(s0 + u) * 4];
#pragma unroll
        for (int cb = 0; cb < NB16; ++cb) b[u][cb] = bp[cb][(s0 + u) * 4]; }
    SBAR();
#pragma unroll
    for (int u = 0; u < U; ++u)
#pragma unroll
        for (int ra = 0; ra < 2; ++ra)
#pragma unroll
            for (int cb = 0; cb < NB16; ++cb) acc[ra][cb] = __builtin_amdgcn_mfma_f32_16x16x32_bf16(a[u][ra], b[u][cb], acc[ra][cb], 0, 0, 0);
    SBAR();
}
template <int NB, class F>
__device__ __forceinline__ void sg_item16(int wv, char* lds, const bf16_t* A  , int K, const SgB<NB>& B, const F& f) {
    constexpr int NB16 = 2 * NB, NBC = NB * 32, NV = NBC / 16;
    const int tid = ltid(wv), lane = tid & 63, c16 = lane & 15, q = lane >> 4;
    LAS float* L = (LAS float*)lds;
    const int k0 = wv * (K >> 3), nst = K >> 8;
    typedef __attribute__((address_space(1))) bf16x8 gbf8;
    const size_t lo = (size_t)c16 * K + k0 + q * 8;
    const gbf8* ap[2]; const gbf8* bp[NB16];
#pragma unroll
    for (int ra = 0; ra < 2; ++ra) ap[ra] = (const gbf8*)(A + (size_t)(ra * 16) * K + lo);
#pragma unroll
    for (int cb = 0; cb < NB16; ++cb) bp[cb] = (const gbf8*)(B.p[cb >> 1] + (size_t)((cb & 1) * 16) * K + lo);
    f32x4 acc[2][NB16];
#pragma unroll
    for (int ra = 0; ra < 2; ++ra)
#pragma unroll
        for (int cb = 0; cb < NB16; ++cb) acc[ra][cb] = (f32x4){0.f, 0.f, 0.f, 0.f};
    int s0 = 0;
    for (; s0 + 4 <= nst; s0 += 4) sg16_batch<NB16, 4>(acc, ap, bp, s0);
    if (nst & 2) { sg16_batch<NB16, 2>(acc, ap, bp, s0); s0 += 2; }
    if (nst & 1) sg16_batch<NB16, 1>(acc, ap, bp, s0);
#pragma unroll
    for (int ra = 0; ra < 2; ++ra)
#pragma unroll
        for (int cb = 0; cb < NB16; ++cb)
#pragma unroll
            for (int r = 0; r < 4; ++r) L[(wv * 32 + ra * 16 + 4 * q + r) * NBC + cb * 16 + c16] = acc[ra][cb][r];
    __syncthreads();
    const int row = 4 * wv + (lane >> 4), c0 = (lane & 15) * NV;
    float v[NV];
#pragma unroll
    for (int e = 0; e < NV; ++e) v[e] = 0.f;
#pragma unroll
    for (int w = 0; w < 8; ++w)
#pragma unroll
        for (int e4 = 0; e4 < NV / 4; ++e4) { const f32x4 t = *(const LAS f32x4*)(L + (w * 32 + row) * NBC + c0 + e4 * 4); v[e4 * 4] += t[0]; v[e4 * 4 + 1] += t[1]; v[e4 * 4 + 2] += t[2]; v[e4 * 4 + 3] += t[3]; }
    f(row, c0, lane & 15, v);
    __syncthreads();
}
typedef __attribute__((address_space(1))) f32x4 gf4; typedef __attribute__((address_space(1))) u32x4 gu4; typedef __attribute__((address_space(1))) u32x2 gu2; typedef __attribute__((address_space(1))) float gf1;
__device__ __forceinline__ unsigned pkbf(float lo, float hi) { return cvtpk(lo, hi); }
#define SG_ROWS(it) const int rb = (it) & 7, cbk = (it) >> 3
__device__ __forceinline__ int sg_vb() { const int b = lbid(), G = (int)gridDim.x; return (G & 7) ? b : (b & 7) * (G >> 3) + (b >> 3); }
__device__ __forceinline__ void sg_rope64(float (&y)[4], int c0, int l16, const float* tab_row  ) {
#pragma unroll
    for (int e = 0; e < 4; ++e) { const float pr = x8_16(y[e]); const int i = (c0 + e) & 31; const float c = tab_row[2 * i], s = tab_row[2 * i + 1]; y[e] = l16 < 8 ? y[e] * c - pr * s : y[e] * c + pr * s; }
}

__device__ __forceinline__ void sg_mla_in(const Params& p, int wv, char* lds, const bf16_t* A, const bf16_t* Bt, int j, const ssq_t* ssq_h) {
    bf16_t* CQ = (bf16_t*)(wsp(p) + WS_CQ); bf16_t* CKV = (bf16_t*)(wsp(p) + WS_CKV); bf16_t* KRB = (bf16_t*)(wsp(p) + WS_KRB + (size_t)j * KRB_STRIDE);
    ssq_t* ssq_q = (ssq_t*)(wsp(p) + WS_SSQQ) + (size_t)j * MR; ssq_t* ssq_kv = (ssq_t*)(wsp(p) + WS_SSQKV) + (size_t)j * MR; float* out = outp(p);
    const float* gkr = inp(p, 17) + j * 64; const float* tm = (const float*)(wsp(p) + WS_TABM);
    for (int it = sg_vb(); it < 8 * 17; it += gridDim.x) { SG_ROWS(it); const int K = DM;
        SgB<2> B; if (cbk < 16) { B.p[0] = Bt + (size_t)(cbk * 64) * K; B.p[1] = B.p[0] + (size_t)32 * K; } else { B.p[0] = Bt + (size_t)1024 * K; B.p[1] = Bt + (size_t)1152 * K; }
        sg_item<2, 8>(wv, lds, A + (size_t)(rb * 32) * K, K, B, [&](int row, int c0, int l16, const float (&v)[4]) {
            const int m = NPR + rb * 32 + row; const float rs = rsqrtf(ssq_val(ssq_h, m) * (1.0f / DM) + EPS); float x[4];
#pragma unroll
            for (int e = 0; e < 4; ++e) x[e] = v[e] * rs;
            if (cbk < 16) { const bool iskv = cbk >= 8; const int c = (cbk & 7) * 64 + c0; const float ss = g16_sum(x[0] * x[0] + x[1] * x[1] + x[2] * x[2] + x[3] * x[3]);
                u32x2 w; w.x = pkbf(x[0], x[1]); w.y = pkbf(x[2], x[3]); *(gu2*)((iskv ? CKV : CQ) + (size_t)m * 512 + c) = w;
                if (iskv) *(gf4*)(out + O_LATS + ((size_t)j * NSR + (m - NPR)) * 512 + c) = (f32x4){x[0], x[1], x[2], x[3]};
                if (l16 == 0) ssq_add(iskv ? ssq_kv : ssq_q, m, ss);
            } else { const float r2 = rsqrtf(g16_sum(x[0] * x[0] + x[1] * x[1] + x[2] * x[2] + x[3] * x[3]) * (1.0f / 64) + EPS); float y[4];
#pragma unroll
                for (int e = 0; e < 4; ++e) y[e] = x[e] * r2 * gkr[c0 + e];
                sg_rope64(y, c0, l16, tm + (size_t)pos_of_row(m) * 64);
                *(gf4*)(out + O_KRS + ((size_t)j * NSR + (m - NPR)) * 64 + c0) = (f32x4){y[0], y[1], y[2], y[3]};
                u32x2 w; w.x = pkbf(y[0], y[1]); w.y = pkbf(y[2], y[3]); *(gu2*)(KRB + (size_t)latrow_of(m) * 64 + c0) = w; }
        });
    }
}
__device__ __forceinline__ void sg_mla_up(const Params& p, int wv, char* lds, const bf16_t* Wq, const bf16_t* Wkvf, int j) {
    const bf16_t* CQ = (const bf16_t*)(wsp(p) + WS_CQ) + (size_t)NPR * 512; const bf16_t* CKV = (const bf16_t*)(wsp(p) + WS_CKV) + (size_t)NPR * 512;
    bf16_t* Q = (bf16_t*)(wsp(p) + WS_Q); bf16_t* KV = (bf16_t*)(wsp(p) + WS_KV);
    const ssq_t* ssq_q = (const ssq_t*)(wsp(p) + WS_SSQQ) + (size_t)j * MR; const ssq_t* ssq_kv = (const ssq_t*)(wsp(p) + WS_SSQKV) + (size_t)j * MR;
    const float* gqn = inp(p, 14) + j * 128; const float* gqr = inp(p, 15) + j * 64; const float* gkn = inp(p, 16) + j * 128; const float* tm = (const float*)(wsp(p) + WS_TABM);
    const int K = 512;
    for (int it = sg_vb(); it < 8 * 64; it += gridDim.x) { SG_ROWS(it);
        if (cbk < 16 || cbk >= 32) {
            const int kind = cbk < 16 ? 0 : (cbk < 48 ? 1 : 2), hd = cbk & 15;
            const bf16_t* W0 = kind == 0 ? Wq + (size_t)(128 * hd) * K : Wkvf + (size_t)(256 * hd + (kind == 2 ? 128 : 0)) * K;
            SgB<4> B;
#pragma unroll
            for (int q = 0; q < 4; ++q) B.p[q] = W0 + (size_t)(32 * q) * K;
            sg_item<4, 4>(wv, lds, (kind == 0 ? CQ : CKV) + (size_t)(rb * 32) * K, K, B, [&](int row, int c0, int l16, const float (&v)[8]) {
                const int m = NPR + rb * 32 + row; const float rs = rsqrtf(ssq_val(kind == 0 ? ssq_q : ssq_kv, m) * (1.0f / 512) + EPS); float x[8], ss = 0.f;
#pragma unroll
                for (int e = 0; e < 8; ++e) { x[e] = v[e] * rs; ss += x[e] * x[e]; }
                if (kind != 2) { const float r2 = rsqrtf(g16_sum(ss) * (1.0f / 128) + EPS); const float* g = kind == 0 ? gqn : gkn;
#pragma unroll
                    for (int e = 0; e < 8; ++e) x[e] *= r2 * g[c0 + e]; }
                u32x4 w; w.x = pkbf(x[0], x[1]); w.y = pkbf(x[2], x[3]); w.z = pkbf(x[4], x[5]); w.w = pkbf(x[6], x[7]);
                bf16_t* dst = kind == 0 ? Q + (size_t)m * NQUP + hd * 192 + c0 : KV + (size_t)latrow_of(m) * NKVUP + hd * 256 + (kind == 2 ? 128 : 0) + c0;
                *(gu4*)dst = w;
            });
        } else {
            const int hd = cbk - 16, t = hd >> 2, wc = hd & 3; SgB<2> B; B.p[0] = Wq + (size_t)(2048 + 256 * t + 32 * wc) * K; B.p[1] = B.p[0] + (size_t)128 * K;
            sg_item<2, 4>(wv, lds, CQ + (size_t)(rb * 32) * K, K, B, [&](int row, int c0, int l16, const float (&v)[4]) {
                const int m = NPR + rb * 32 + row; const float rs = rsqrtf(ssq_val(ssq_q, m) * (1.0f / 512) + EPS); float y[4], ss = 0.f;
#pragma unroll
                for (int e = 0; e < 4; ++e) { y[e] = v[e] * rs; ss += y[e] * y[e]; }
                const float r2 = rsqrtf(g16_sum(ss) * (1.0f / 64) + EPS);
#pragma unroll
                for (int e = 0; e < 4; ++e) y[e] *= r2 * gqr[c0 + e];
                sg_rope64(y, c0, l16, tm + (size_t)pos_of_row(m) * 64);
                u32x2 w; w.x = pkbf(y[0], y[1]); w.y = pkbf(y[2], y[3]); *(gu2*)(Q + (size_t)m * NQUP + hd * 192 + 128 + c0) = w;
            });
        }
    }
}
template <int U>
__device__ __forceinline__ void sg_resid(const Params& p, int wv, char* lds, const bf16_t* A, int K, const bf16_t* Bt, const bf16_t* hin, bf16_t* hout, ssq_t* ssq_out, const bf16_t* t, const ssq_t* ssq_in) {
    for (int it = sg_vb(); it < 8 * 32; it += gridDim.x) { SG_ROWS(it);
        SgB<2> B; B.p[0] = Bt + (size_t)(cbk * 64) * K; B.p[1] = B.p[0] + (size_t)32 * K;
        sg_item16<2>(wv, lds, A + (size_t)(rb * 32) * K, K, B, [&](int row, int c0, int l16, const float (&v)[4]) {
            const int m = NPR + rb * 32 + row; const size_t off = (size_t)m * DM + cbk * 64 + c0; const u32x2 hw = *(const gu2*)(hin + off); float o[4];
            const float hv[4] = {__uint_as_float(hw.x << 16), __uint_as_float(hw.x & 0xffff0000u), __uint_as_float(hw.y << 16), __uint_as_float(hw.y & 0xffff0000u)};
            if (t) { const float rs = rsqrtf(ssq_val(ssq_in, m) * (1.0f / DM) + EPS); const u32x2 tw = *(const gu2*)(t + off);
                const float tf[4] = {__uint_as_float(tw.x << 16), __uint_as_float(tw.x & 0xffff0000u), __uint_as_float(tw.y << 16), __uint_as_float(tw.y & 0xffff0000u)};
#pragma unroll
                for (int e = 0; e < 4; ++e) o[e] = hv[e] + tf[e] * __builtin_amdgcn_rcpf(1.0f + __expf(-v[e] * rs));
            } else {
#pragma unroll
                for (int e = 0; e < 4; ++e) o[e] = hv[e] + v[e]; }
            u32x2 w; w.x = pkbf(o[0], o[1]); w.y = pkbf(o[2], o[3]); *(gu2*)(hout + off) = w;
            const float ss = g16_sum(o[0] * o[0] + o[1] * o[1] + o[2] * o[2] + o[3] * o[3]);
            if (l16 == 0) ssq_add(ssq_out, m, ss);
        });
    }
}
__device__ __forceinline__ void sg_ffn_up(const Params& p, int wv, char* lds, const bf16_t* A, const bf16_t* Wgu, const ssq_t* ssq_in) {
    bf16_t* act = (bf16_t*)(wsp(p) + WS_ACT); const int K = DM;
    for (int it = sg_vb(); it < 8 * (DFF / 64); it += gridDim.x) { SG_ROWS(it); const int tl = cbk >> 1, hf = (cbk & 1) * 64;
        SgB<4> B; B.p[0] = Wgu + (size_t)(256 * tl + hf) * K; B.p[1] = B.p[0] + (size_t)32 * K; B.p[2] = B.p[0] + (size_t)128 * K; B.p[3] = B.p[2] + (size_t)32 * K;
        sg_item<4, 4>(wv, lds, A + (size_t)(rb * 32) * K, K, B, [&](int row, int c0, int l16, const float (&v)[8]) {
            const int m = NPR + rb * 32 + row; const float rs = rsqrtf(ssq_val(ssq_in, m) * (1.0f / DM) + EPS); float o[8];
#pragma unroll
            for (int e = 0; e < 8; ++e) { const float mine = v[e] * rs, other = x8_16(mine); o[e] = mine * __builtin_amdgcn_rcpf(1.0f + __expf(-mine)) * other; }
            if (l16 < 8) { u32x4 w; w.x = pkbf(o[0], o[1]); w.y = pkbf(o[2], o[3]); w.z = pkbf(o[4], o[5]); w.w = pkbf(o[6], o[7]);
                *(gu4*)(act + (size_t)m * DFF + 128 * tl + hf + c0) = w; }
        });
    }
}
__device__ __forceinline__ void sg_store_bf16(const Params& p, int wv, char* lds, const bf16_t* A, int K, const bf16_t* Bt, bf16_t* C, int ldc, int ncb) {
    for (int it = sg_vb(); it < 8 * ncb; it += gridDim.x) { SG_ROWS(it);
        SgB<2> B; B.p[0] = Bt + (size_t)(cbk * 64) * K; B.p[1] = B.p[0] + (size_t)32 * K;
        sg_item<2, 2>(wv, lds, A + (size_t)(rb * 32) * K, K, B, [&](int row, int c0, int l16, const float (&v)[4]) {
            const int m = NPR + rb * 32 + row; u32x2 w; w.x = pkbf(v[0], v[1]); w.y = pkbf(v[2], v[3]); *(gu2*)(C + (size_t)m * ldc + cbk * 64 + c0) = w; });
    }
}
__device__ __forceinline__ void sg_swa_qkv(const Params& p, int wv, char* lds, const bf16_t* A, const bf16_t* Bt, int j, const ssq_t* ssq_h) {
    bf16_t* SQ = (bf16_t*)(wsp(p) + WS_SQ); bf16_t* SK = (bf16_t*)(wsp(p) + WS_SKB + (size_t)j * SKB_STRIDE); bf16_t* SV = (bf16_t*)(wsp(p) + WS_SVB + (size_t)j * SKB_STRIDE);
    const float* gq = inp(p, 20) + j * 64; const float* gk = inp(p, 21) + j * 64; const float* ts = (const float*)(wsp(p) + WS_TABS); float* out = outp(p); const int K = DM;
    for (int it = sg_vb(); it < 8 * 40; it += gridDim.x) { SG_ROWS(it);
        SgB<2> B;
        if (cbk < 36) { const int t = cbk >> 2, wc = cbk & 3; B.p[0] = Bt + (size_t)(256 * t + 32 * wc) * K; B.p[1] = B.p[0] + (size_t)128 * K; }
        else { B.p[0] = Bt + (size_t)(2304 + 64 * (cbk - 36)) * K; B.p[1] = B.p[0] + (size_t)32 * K; }
        sg_item<2, 8>(wv, lds, A + (size_t)(rb * 32) * K, K, B, [&](int row, int c0, int l16, const float (&v)[4]) {
            const int m = NPR + rb * 32 + row, b = (m - NPR) >> 4, tt = (m - NPR) & 15; const float rs = rsqrtf(ssq_val(ssq_h, m) * (1.0f / DM) + EPS); float x[4];
#pragma unroll
            for (int e = 0; e < 4; ++e) x[e] = v[e] * rs;
            const size_t so = (((size_t)j * 16 + b) * 128 + 112 + tt) * 256;
            if (cbk < 36) { const bool isk = cbk >= 32; const int bj = c0 >> 5, i0 = c0 & 31, d0 = swa_dim(bj, i0);
                const float r2 = rsqrtf(g16_sum(x[0] * x[0] + x[1] * x[1] + x[2] * x[2] + x[3] * x[3]) * (1.0f / 64) + EPS); const float* g = isk ? gk : gq;
#pragma unroll
                for (int e = 0; e < 4; ++e) x[e] *= r2 * g[d0 + e];
                const float* tp = ts + (size_t)pos_of_row(m) * 16;
#pragma unroll
                for (int e = 0; e < 4; ++e) { const float pr = x8_16(x[e]); const int d = (i0 + e) & 7; const float c = tp[2 * d], s = tp[2 * d + 1];
                    if (i0 < 8) x[e] = bj == 0 ? x[e] * c - pr * s : x[e] * c + pr * s; }
                u32x2 w; w.x = pkbf(x[0], x[1]); w.y = pkbf(x[2], x[3]);
                if (!isk) *(gu2*)(SQ + (size_t)m * DM + cbk * 64 + c0) = w;
                else { const int g4 = cbk - 32; *(gu2*)(SK + (size_t)skrow_of(m) * 256 + g4 * 64 + c0) = w; *(gf4*)(out + O_SKS + so + g4 * 64 + d0) = (f32x4){x[0], x[1], x[2], x[3]}; }
            } else { const int c = (cbk - 36) * 64 + c0; u32x2 w; w.x = pkbf(x[0], x[1]); w.y = pkbf(x[2], x[3]);
                *(gu2*)(SV + (size_t)skrow_of(m) * 256 + c) = w; *(gf4*)(out + O_SVS + so + c) = (f32x4){x[0], x[1], x[2], x[3]}; }
        });
    }
}

#define XB_TMO      128
#define XB_XCNT(j)  (256  + 64 * (j))
#define XB_XSUB(j)  (1280 + 64 * (j))
#define XB_XGEN(j)  (2304 + 64 * (j))
#define XB_TOP      3328
#define XB_TOPGEN   3392
#define XCD_BAR_WORDS 3456
#define XB_SPIN_CAP (1u << 18)

__device__ __forceinline__ unsigned xb_ld(unsigned* p)              { return __hip_atomic_load(p, __ATOMIC_RELAXED, __HIP_MEMORY_SCOPE_AGENT); }
__device__ __forceinline__ unsigned xb_add(unsigned* p, unsigned v) { return __hip_atomic_fetch_add(p, v, __ATOMIC_RELAXED, __HIP_MEMORY_SCOPE_AGENT); }
__device__ __forceinline__ unsigned xb_xcc_id() { return (unsigned)__builtin_amdgcn_s_getreg((3 << 11) | 20) & 0xFu; }
#define XB_SPIN(cond, bar) do { unsigned _sp = 0; while (cond) { __builtin_amdgcn_s_sleep(1); \
    if ((++_sp & 255u) == 0u) { if (xb_ld(&(bar)[XB_TMO])) break; if (_sp > XB_SPIN_CAP) { atomicAdd(&(bar)[XB_TMO], 1u); break; } } } } while (0)

struct XcdBarrier {
    unsigned* bar; unsigned x;
    volatile LAS unsigned* st;
};

__device__ __forceinline__ XcdBarrier xcd_barrier_post(unsigned* bar, volatile LAS unsigned* st, bool leader  ) {
    XcdBarrier b; b.bar = bar; b.x = xb_xcc_id(); b.st = st;
    if (leader) (void)xb_add(&bar[XB_XCNT(b.x)], 1u);
    return b;
}
__device__ __forceinline__ void xcd_barrier_complete(unsigned* bar, unsigned x, unsigned& nloc, unsigned& nx) {
    const unsigned G = gridDim.x * gridDim.y * gridDim.z;
    unsigned sum, cnt, mine, sp = 0u;
    for (;;) {
        sum = 0u; cnt = 0u; mine = 0u;
#pragma unroll
        for (unsigned j = 0; j < 16; ++j) { const unsigned c = xb_ld(&bar[XB_XCNT(j)]); sum += c; cnt += (c > 0u) ? 1u : 0u; }
        mine = xb_ld(&bar[XB_XCNT(x)]);
        if (sum == G) { mine = xb_ld(&bar[XB_XCNT(x)]); break; }
        __builtin_amdgcn_s_sleep(1);
        if ((++sp & 255u) == 0u) { if (xb_ld(&bar[XB_TMO])) break; if (sp > XB_SPIN_CAP) { atomicAdd(&bar[XB_TMO], 1u); break; } }
    }
    nloc = mine > 0u ? mine : 1u; nx = cnt > 0u ? cnt : 1u;
}

__device__ __forceinline__ void xcd_barrier(const XcdBarrier& b, bool leader) {
    asm volatile("s_waitcnt vmcnt(0)" ::: "memory");
    __syncthreads();
    if (leader) {
        unsigned* bar = b.bar;
        __builtin_amdgcn_s_waitcnt(0);
        unsigned nloc = b.st[0], nx = b.st[1];
        if (nloc == 0u) { xcd_barrier_complete(bar, b.x, nloc, nx); b.st[0] = nloc; b.st[1] = nx; }
        const unsigned old = xb_add(&bar[XB_XSUB(b.x)], 1u);
        const unsigned gen = old / nloc;
        if (old + 1u == (gen + 1u) * nloc) {
            __builtin_amdgcn_fence(__ATOMIC_RELEASE, "agent");
            asm volatile("s_waitcnt vmcnt(0)" ::: "memory");
            const unsigned og = xb_add(&bar[XB_TOP], 1u);
            const unsigned tg = og / nx;
            if (og + 1u == (tg + 1u) * nx) xb_add(&bar[XB_TOPGEN], 1u);
            else XB_SPIN(xb_ld(&bar[XB_TOPGEN]) == tg, bar);
            __builtin_amdgcn_fence(__ATOMIC_ACQUIRE, "agent");
            xb_add(&bar[XB_XGEN(b.x)], 1u);
            asm volatile("s_waitcnt vmcnt(0)" ::: "memory");
        } else {
            XB_SPIN(xb_ld(&bar[XB_XGEN(b.x)]) == gen, bar);
            __builtin_amdgcn_fence(__ATOMIC_ACQUIRE, "agent");
            asm volatile("s_waitcnt vmcnt(0)" ::: "memory");
        }
    }
    __syncthreads();
}

constexpr int LDS_BYTES = 147456;
constexpr int LDS_MISC = 141312 + 320;
constexpr int LDS_XCH = 131072 + 2048;
constexpr int CW_BAR = 4096;
__global__ void __launch_bounds__(512, 2) mega_fwd(Params p) {
    extern __shared__ __attribute__((aligned(16))) char lds[];
    volatile LAS unsigned* MISC = (volatile LAS unsigned*)((LAS char*)lds + LDS_MISC);
    for (int u = threadIdx.x; u < (LDS_BYTES - 131072) / 4; u += 512) ((LAS unsigned*)((LAS char*)lds + 131072))[u] = 0u;
    __syncthreads();
    PG8_LAS unsigned char* GL = (PG8_LAS unsigned char*)lds;
    const int WV = __builtin_amdgcn_readfirstlane((int)threadIdx.x >> 6);
    XcdBarrier bar = xcd_barrier_post((unsigned*)(p.ws + WS_CTL) + CW_BAR, MISC + 8, ltid(WV) == 0);
#define GRID_BAR() do { XcdBarrier b2_ = bar; b2_.bar = (unsigned*)(wsp(p) + WS_CTL) + CW_BAR; b2_.x = xb_xcc_id(); xcd_barrier(b2_, ltid(WV) == 0); } while (0)
#define HBX ((bf16_t*)(wsp(p) + ((i & 1) ? WS_HB1 : WS_HB0)))
#define OB ((bf16_t*)outp(p))
#define HBY ((bf16_t*)(wsp(p) + ((i & 1) ? WS_HB0 : WS_HB1)))
#define SSQ(k) ((ssq_t*)(wsp(p) + WS_SSQ) + (size_t)(k) * MR)
#define WB(off) ((const bf16_t*)(wsp(p) + WS_W) + (off))
#define XCH ((pg8::lfloat*)(GL + LDS_XCH))
#define RUN_GEMM4(EPI, A_, B_, M_, N_, K_, ...) do { pg8::Gemm g_{A_, B_, M_, N_, K_}; pg8::StaticOrder S_; S_.init(M_, N_, gridDim.x, lbid(), 4); pg8::EPI E_{__VA_ARGS__}; \
        pg8::gemm_phase<pg8::EPI, pg8::StaticOrder, true, true>(WV, GL, g_, S_, E_); } while (0)
#define RUN_GEMM(EPI, A_, B_, M_, N_, K_, ...) do { pg8::Gemm g_{A_, B_, M_, N_, K_}; pg8::StaticOrder S_; S_.init(M_, N_, gridDim.x, lbid()); pg8::EPI E_{__VA_ARGS__}; \
        pg8::gemm_phase<pg8::EPI, pg8::StaticOrder, true, true>(WV, GL, g_, S_, E_); } while (0)
    ph_tables(p, WV); ph_convert_w(p, WV, lds); ph_init_h(p, WV); ph_caches(p, WV);
    GRID_BAR();
    for (int i = 0; i < 4; ++i) {
        const int j = i >> 1;
        if ((i & 1) == 0) {
            const size_t wm = (size_t)j * WE_MLA;
            RUN_GEMM(EpiMlaIn, HBX, WB(wm + WO_IN), MR, 1280, DM,
                     (bf16_t*)(wsp(p) + WS_CQ), (bf16_t*)(wsp(p) + WS_CKV), (bf16_t*)(wsp(p) + WS_KRB + (size_t)j * KRB_STRIDE), outp(p), j, SSQ(3 * i),
                     (ssq_t*)(wsp(p) + WS_SSQQ) + (size_t)j * MR, (ssq_t*)(wsp(p) + WS_SSQKV) + (size_t)j * MR, inp(p, 17) + j * 64, (const float*)(wsp(p) + WS_TABM));
            GRID_BAR();
            RUN_GEMM(EpiQup, (const bf16_t*)(wsp(p) + WS_CQ), WB(wm + WO_QUP), MR, NQUP, 512,
                     (bf16_t*)(wsp(p) + WS_Q), (const ssq_t*)(wsp(p) + WS_SSQQ) + (size_t)j * MR, inp(p, 14) + j * 128, inp(p, 15) + j * 64, (const float*)(wsp(p) + WS_TABM), XCH);
            { const int G_ = (int)gridDim.x, b_ = lbid(); pg8::Gemm g_{(const bf16_t*)(wsp(p) + WS_CKV), WB(wm + WO_KVF), MR, NKVUP, 512}; pg8::StaticOrder S_; S_.init(MR, NKVUP, G_, (b_ + G_ - (G_ >= 32 ? 16 : 0)) % G_);
              pg8::EpiKvup E_{(bf16_t*)(wsp(p) + WS_KV), (const ssq_t*)(wsp(p) + WS_SSQKV) + (size_t)j * MR, inp(p, 16) + j * 128, XCH}; pg8::gemm_phase<pg8::EpiKvup, pg8::StaticOrder, true, true>(WV, GL, g_, S_, E_); }
            RUN_GEMM(EpiKvup, (const bf16_t*)(wsp(p) + WS_LATC) + (size_t)j * 16384 * 512, WB(wm + WO_KVP), 16384, NKVUP, 512,
                     (bf16_t*)(wsp(p) + WS_KV), nullptr, inp(p, 16) + j * 128, XCH);
            { const int G_ = (int)gridDim.x, b_ = lbid(), lo_ = G_ >= 64 ? 32 : 0; if (b_ >= lo_) ph_lat_fix(p, WV, j, b_ - lo_, G_ - lo_); }
            GRID_BAR();
            ph_mla_attn(p, WV, (const bf16_t*)(wsp(p) + WS_KRB + (size_t)j * KRB_STRIDE), OB, lds);
            GRID_BAR();
            ph_ple_prep(p, WV, i);
            RUN_GEMM4(EpiResidF32, OB, WB(wm + WO_MOUT), NPR, DM, DM, HBX, HBY, SSQ(3 * i + 1));
            sg_resid<8>(p, WV, lds, OB + (size_t)NPR * DM, DM, WB(wm + WO_MOUT), HBX, HBY, SSQ(3 * i + 1), nullptr, nullptr);
            GRID_BAR();
        } else {
            const size_t wsw = WE_SWA0 + (size_t)j * WE_SWA;
            RUN_GEMM(EpiSwaQkv, HBX, WB(wsw + WO_QKV), MR, NQKV, DM,
                     (bf16_t*)(wsp(p) + WS_SQ), (bf16_t*)(wsp(p) + WS_SKB + (size_t)j * SKB_STRIDE), (bf16_t*)(wsp(p) + WS_SVB + (size_t)j * SKB_STRIDE), outp(p), j, SSQ(3 * i),
                     inp(p, 20) + j * 64, inp(p, 21) + j * 64, (const float*)(wsp(p) + WS_TABS));
            GRID_BAR();
            ph_swa_attn(p, WV, j, (const bf16_t*)(wsp(p) + WS_SKB + (size_t)j * SKB_STRIDE), (const bf16_t*)(wsp(p) + WS_SVB + (size_t)j * SKB_STRIDE), OB, lds);
            GRID_BAR();
            ph_ple_prep(p, WV, i);
            RUN_GEMM4(EpiResidF32, OB, WB(wsw + WO_SOUT), NPR, DM, DM, HBX, HBY, SSQ(3 * i + 1));
            sg_resid<8>(p, WV, lds, OB + (size_t)NPR * DM, DM, WB(wsw + WO_SOUT), HBX, HBY, SSQ(3 * i + 1), nullptr, nullptr);
            GRID_BAR();
        }
        const size_t wl = WE_L0 + (size_t)i * WE_L;
        RUN_GEMM(EpiSwigluBf16, HBY, WB(wl + WO_G), MR, 2 * DFF, DM, (bf16_t*)(wsp(p) + WS_ACT), DFF, SSQ(3 * i + 1));
        {
          const int G_ = (int)gridDim.x, nbusy_ = (65 * 44) % G_, b_ = lbid();
          if (b_ >= nbusy_) { pg8::Gemm g_{(const bf16_t*)(wsp(p) + WS_PB), WB(wl + WO_PP), MR, DM, PLE}; pg8::StaticOrder S_; S_.init(MR, DM, G_ - nbusy_, b_ - nbusy_);
              pg8::EpiStoreBf16 E_{(bf16_t*)(wsp(p) + WS_T32), DM}; pg8::gemm_phase<pg8::EpiStoreBf16, pg8::StaticOrder, true, true>(WV, GL, g_, S_, E_); } }
        GRID_BAR();
        { pg8::Gemm g_{(const bf16_t*)(wsp(p) + WS_ACT), WB(wl + WO_D), NPR, DM, DFF}; pg8::StaticOrder S_; S_.init(NPR, DM, gridDim.x, lbid(), 4);
          pg8::EpiResidF32 E_{HBY, HBX, SSQ(3 * i + 2)}; pg8::gemm_phase<pg8::EpiResidF32, pg8::StaticOrder, true, true>(WV, GL, g_, S_, E_); }
        sg_resid<11>(p, WV, lds, (const bf16_t*)(wsp(p) + WS_ACT) + (size_t)NPR * DFF, DFF, WB(wl + WO_D), HBY, HBX, SSQ(3 * i + 2), nullptr, nullptr);
        GRID_BAR();
        RUN_GEMM4(EpiPleF32, HBX, WB(wl + WO_PG), NPR, DM, DM, HBX, (const bf16_t*)(wsp(p) + WS_T32), HBY, SSQ(3 * i + 2), SSQ(3 * i + 3));
        sg_resid<8>(p, WV, lds, HBX + (size_t)NPR * DM, DM, WB(wl + WO_PG), HBX, HBY, SSQ(3 * i + 3), (const bf16_t*)(wsp(p) + WS_T32), SSQ(3 * i + 2));
        GRID_BAR();
    }
    ph_final(p, WV);
#undef GRID_BAR
#undef HBX
#undef OB
#undef HBY
#undef SSQ
#undef WB
#undef XCH
#undef RUN_GEMM
#undef RUN_GEMM4
}

__global__ void k_report(float* out, float v) { if (threadIdx.x == 0 && blockIdx.x == 0) out[0] = v; }

extern "C" void kernel_launch(void* const* d_in, const int* in_sizes, int n_in, void* d_out, int out_size, void* d_ws, size_t ws_size, hipStream_t stream) {
    if (n_in != 32 || (size_t)out_size != O_END || ws_size < WS_END) {
        fprintf(stderr, "kernel_launch: unexpected sizes n_in %d out %d ws %zu (need %zu)\n", n_in, out_size, ws_size, (size_t)WS_END);
        hipLaunchKernelGGL(k_report, dim3(1), dim3(64), 0, stream, (float*)d_out, (float)(ws_size >> 20));
        return;
    }
    Params p{};
    for (int k = 0; k < 32; ++k) p.in[k] = (const float*)d_in[k];
    p.out = (float*)d_out; p.ws = (unsigned char*)d_ws;
    static int grid = 0;
    if (grid == 0) {
        int dev = 0, cus = 0, per_cu = 0;
        if (hipGetDevice(&dev) != hipSuccess || hipDeviceGetAttribute(&cus, hipDeviceAttributeMultiprocessorCount, dev) != hipSuccess) { fprintf(stderr, "kernel_launch: device query failed\n"); grid = -1; return; }
        if (hipFuncSetAttribute((const void*)mega_fwd, hipFuncAttributeMaxDynamicSharedMemorySize, LDS_BYTES) != hipSuccess) { fprintf(stderr, "kernel_launch: hipFuncSetAttribute failed\n"); grid = -1; return; }
        if (hipOccupancyMaxActiveBlocksPerMultiprocessor(&per_cu, (const void*)mega_fwd, 512, LDS_BYTES) != hipSuccess || per_cu < 1) fprintf(stderr, "kernel_launch: occupancy query says %d\n", per_cu);
        (void)hipGetLastError();
        grid = cus;
    }
    if (grid < 0) return;
    (void)hipMemsetAsync((char*)d_ws + WS_CTL, 0, CTL_BYTES, stream);
    hipLaunchKernelGGL(mega_fwd, dim3(grid), dim3(512), LDS_BYTES, stream, p);
}
```

```cpp
#include <hip/hip_runtime.h>
#include <cstdint>
#include <cstdio>

#define LAS __attribute__((address_space(3)))
typedef unsigned short bf16_t;
typedef short bf16x8 __attribute__((ext_vector_type(8)));
typedef short s16x4 __attribute__((ext_vector_type(4)));
typedef float f32x4 __attribute__((ext_vector_type(4)));
typedef float f32x16 __attribute__((ext_vector_type(16)));
typedef unsigned u32x4 __attribute__((ext_vector_type(4)));
typedef unsigned u32x2 __attribute__((ext_vector_type(2)));

__device__ __forceinline__ int ltid(int wv) { int t = (wv << 6) | (int)__builtin_amdgcn_mbcnt_hi(~0u, __builtin_amdgcn_mbcnt_lo(~0u, 0u)); asm volatile("" : "+v"(t)); return t; }

constexpr int DM = 2048, SEQ = 4096, NPR = 4 * SEQ  , NSR = 256  , MR = NPR + NSR  ;
constexpr int PAST = 1024, DSEQ = 16, DBATCH = 16;
constexpr int KVPB = PAST + DSEQ;
constexpr int NKVR = NPR + DBATCH * KVPB;
constexpr int SWPB = 128 + DSEQ;
constexpr int NSKR = NPR + DBATCH * SWPB;
constexpr int DFF = 5632, PLE = 256;
constexpr int NIN_MLA = 1088, NQUP = 3072, NKVUP = 4096, NQKV = 2560;
constexpr float EPS = 1e-6f;
constexpr float LOG2E = 1.4426950408889634f;

constexpr size_t O_Y = 0;
constexpr size_t O_LATP = (size_t)MR * DM;
constexpr size_t O_KRP = O_LATP + (size_t)2 * NPR * 512;
constexpr size_t O_SKP = O_KRP + (size_t)2 * NPR * 64;
constexpr size_t O_SVP = O_SKP + (size_t)2 * 4 * 128 * 256;
constexpr size_t O_LATS = O_SVP + (size_t)2 * 4 * 128 * 256;
constexpr size_t O_KRS = O_LATS + (size_t)2 * NSR * 512;
constexpr size_t O_SKS = O_KRS + (size_t)2 * NSR * 64;
constexpr size_t O_SVS = O_SKS + (size_t)2 * 16 * 128 * 256;
constexpr size_t O_END = O_SVS + (size_t)2 * 16 * 128 * 256;
static_assert(O_END == 55869440, "output size");

constexpr size_t MiB = 1u << 20;
constexpr size_t al256(size_t x) { return (x + 255) & ~(size_t)255; }
constexpr size_t WS_CTL = 0, CTL_BYTES = 3 * MiB;
typedef unsigned long long ssq_t;
constexpr size_t WS_SSQ = 65536;
constexpr size_t WS_SSQQ = 2 * MiB, WS_SSQKV = WS_SSQQ + 2 * (size_t)MR * 8;
static_assert(WS_SSQ + 13 * (size_t)MR * 8 <= WS_SSQQ && WS_SSQKV + 2 * (size_t)MR * 8 <= CTL_BYTES, "ctl");
constexpr size_t WS_TABM = 3 * MiB, WS_TABS = 4 * MiB, WS_W = 5 * MiB;
constexpr size_t WO_IN = 0, WO_QUP = 2621440, WO_KVP = 4194304, WO_KVF = 6291456, WO_MOUT = 8388608, WE_MLA = 12582912;
constexpr size_t WO_QKV = 0, WO_SOUT = 5242880, WE_SWA = 9437184;
constexpr size_t WO_G = 0, WO_D = 23068672, WO_PG = 34603008, WO_PP = 38797312, WE_L = 39321600;
constexpr size_t WE_SWA0 = 2 * WE_MLA, WE_L0 = WE_SWA0 + 2 * WE_SWA, WE_END = WE_L0 + 4 * WE_L;
static_assert(WE_END == 201326592, "weights");
constexpr size_t WS_LATC = WS_W + WE_END * 2;
constexpr size_t WS_KRB = WS_LATC + 2 * (size_t)16384 * 512 * 2;
constexpr size_t KRB_STRIDE = al256((size_t)NKVR * 64 * 2);
constexpr size_t WS_SKB = WS_KRB + 2 * KRB_STRIDE;
constexpr size_t SKB_STRIDE = al256((size_t)NSKR * 256 * 2);
constexpr size_t WS_SVB = WS_SKB + 2 * SKB_STRIDE;
constexpr size_t HB_BYTES = (size_t)MR * DM * 2;
constexpr size_t WS_HB0 = al256(WS_SVB + 2 * SKB_STRIDE), WS_HB1 = WS_HB0 + HB_BYTES;
constexpr size_t WS_R = WS_HB1 + HB_BYTES;
constexpr size_t WS_CQ = WS_R, WS_CKV = WS_CQ + (size_t)MR * 512 * 2, WS_Q = WS_CKV + (size_t)MR * 512 * 2, WS_KV = WS_Q + (size_t)MR * NQUP * 2;
constexpr size_t WS_SQ = WS_R;
constexpr size_t WS_ACT = WS_R, WS_T32 = WS_ACT + (size_t)MR * DFF * 2, WS_PB = WS_T32 + (size_t)MR * DM * 4;
constexpr size_t WS_END = WS_KV + (size_t)NKVR * 4096 * 2;
static_assert(WS_PB + (size_t)MR * PLE * 2 <= WS_END, "ffn overlay");
static_assert(WS_END <= 984 * MiB, "ws budget (984 MiB was seen to be available)");
__device__ __forceinline__ float ssq_val(const ssq_t* q, size_t i) { return (float)((const __attribute__((address_space(1))) ssq_t*)q)[i] * (1.0f / 4096.0f); }
__device__ __forceinline__ void ssq_add(ssq_t* q, size_t i, float ss) { __hip_atomic_fetch_add((__attribute__((address_space(1))) ssq_t*)(q + i), (ssq_t)(ss * 4096.0f + 0.5f), __ATOMIC_RELAXED, __HIP_MEMORY_SCOPE_AGENT); }

struct Params {
    const float* in[32];
    float* out;
    unsigned char* ws;
};
__device__ __forceinline__ int opaque_i(int k) { asm volatile("" : "+v"(k)); return __builtin_amdgcn_readfirstlane(k); }
__device__ __forceinline__ int lbid() { int b = (int)blockIdx.x; asm volatile("" : "+s"(b)); return b; }
__device__ __forceinline__ const float* inp(const Params& p, int k) { return p.in[opaque_i(k)]; }
__device__ __forceinline__ unsigned long long opaque_u64(unsigned long long a) { unsigned lo = (unsigned)a, hi = (unsigned)(a >> 32); asm volatile("" : "+v"(lo), "+v"(hi));
    lo = __builtin_amdgcn_readfirstlane(lo); hi = __builtin_amdgcn_readfirstlane(hi); return ((unsigned long long)hi << 32) | lo; }
__device__ __forceinline__ unsigned char* wsp(const Params& p) { return (unsigned char*)opaque_u64((unsigned long long)p.ws); }
__device__ __forceinline__ float* outp(const Params& p) { return (float*)opaque_u64((unsigned long long)p.out); }

__device__ __forceinline__ float bf2f(bf16_t b) { return __uint_as_float(((unsigned)b) << 16); }
__device__ __forceinline__ unsigned f2bf(float f) { unsigned u = __float_as_uint(f); return (u + 0x7fffu + ((u >> 16) & 1u)) >> 16; }
__device__ __forceinline__ unsigned pk2(float lo, float hi) { return f2bf(lo) | (f2bf(hi) << 16); }
__device__ __forceinline__ float wave_sum(float v) {
#pragma unroll
    for (int o = 1; o < 64; o <<= 1) v += __shfl_xor(v, o);
    return v;
}
__device__ __forceinline__ int crow(int r, int hi) { return (r & 3) + 8 * (r >> 2) + 4 * hi; }
__device__ __forceinline__ int pos_of_row(int m) { return m < NPR ? (m & (SEQ - 1)) : PAST + ((m - NPR) & (DSEQ - 1)); }
__device__ __forceinline__ int latrow_of(int m) { return m < NPR ? m : NPR + ((m - NPR) >> 4) * KVPB + PAST + ((m - NPR) & 15); }
__device__ __forceinline__ int skrow_of(int m) { return m < NPR ? m : NPR + ((m - NPR) >> 4) * SWPB + 128 + ((m - NPR) & 15); }

typedef __attribute__((address_space(1))) float PG8_GASF; typedef __attribute__((address_space(1))) u32x4 PG8_GASU4;
__device__ __forceinline__ void ph_tables(const Params& p, int wv) {
    const int tix = ltid(wv);
    float* tm = (float*)(wsp(p) + WS_TABM); float* ts = (float*)(wsp(p) + WS_TABS);
    const int gt = lbid() * 512 + tix, ngt = gridDim.x * 512;
    for (int idx = gt; idx < 4096 * 32; idx += ngt) {
        const int pos = idx >> 5, i = idx & 31;
        const float inv = powf(10000.0f, -(float)i / 32.0f);
        const float ang = (float)pos * inv;
        tm[idx * 2] = cosf(ang); tm[idx * 2 + 1] = sinf(ang);
    }
    for (int idx = gt; idx < 4096 * 8; idx += ngt) {
        const int pos = idx >> 3, i = idx & 7;
        const float inv = powf(500000.0f, -(float)i / 8.0f);
        const float ang = (float)pos * inv;
        ts[idx * 2] = cosf(ang); ts[idx * 2 + 1] = sinf(ang);
    }
}

__device__ __forceinline__ int swa_dim(int bj, int i) { const int g = i >> 3, e = i & 7; return e < 2 ? 8 * bj + 2 * g + e : 16 + 24 * bj + 6 * g + (e - 2); }
struct WDesc { const float* src; const float* src2; bf16_t* dst; const float* gain; int K, Nsrc, Ndst, mode; };
__device__ __forceinline__ int wsrc_col(int mode, int r, bool& second) {
    second = false;
    if (mode == 1) { const int t = r >> 8, w = r & 255; second = w >= 128; return 128 * t + (w & 127); }
    if (mode == 3) { if (r < 1024) return r; const int w = r - 1024; return 1024 + 32 * ((w >> 7) & 1) + (w & 31); }
    if (mode == 4) { if (r < 2048) return (r >> 7) * 192 + (r & 127);
        const int w = r - 2048, t = w >> 8, bj = (w >> 7) & 1, wc = (w >> 5) & 3, i = w & 31; return (4 * t + wc) * 192 + 128 + 32 * bj + i; }
    if (mode == 5) { if (r >= 2304) return r;
        const int t = r >> 8, bj = (r >> 7) & 1, wc = (r >> 5) & 3, i = r & 31; return (t < 8 ? (4 * t + wc) * 64 : 2048 + wc * 64) + swa_dim(bj, i); }
    return r;
}
__device__ __forceinline__ WDesc wdesc(const Params& p, int idx) {
    bf16_t* W = (bf16_t*)(wsp(p) + WS_W); WDesc d; d.mode = 0; d.gain = nullptr; d.src2 = nullptr;
    if (idx < 10) { const int j = idx / 5, k = idx % 5; bf16_t* b = W + (size_t)j * WE_MLA;
        if (k == 0) { d.src = inp(p, 9) + (size_t)j * 2048 * NIN_MLA; d.dst = b + WO_IN; d.K = 2048; d.Nsrc = NIN_MLA; d.Ndst = 1280; d.mode = 3; d.gain = inp(p, 8) + (2 * j) * DM; }
        else if (k == 1) { d.src = inp(p, 11) + (size_t)j * 512 * NQUP; d.dst = b + WO_QUP; d.K = 512; d.Nsrc = NQUP; d.Ndst = NQUP; d.mode = 4; d.gain = inp(p, 10) + j * 512; }
        else if (k == 2) { d.src = inp(p, 13) + (size_t)j * 512 * NKVUP; d.dst = b + WO_KVP; d.K = 512; d.Nsrc = NKVUP; d.Ndst = NKVUP; }
        else if (k == 3) { d.src = inp(p, 13) + (size_t)j * 512 * NKVUP; d.dst = b + WO_KVF; d.K = 512; d.Nsrc = NKVUP; d.Ndst = NKVUP; d.gain = inp(p, 12) + j * 512; }
        else { d.src = inp(p, 18) + (size_t)j * 2048 * 2048; d.dst = b + WO_MOUT; d.K = 2048; d.Nsrc = 2048; d.Ndst = 2048; }
    } else if (idx < 14) { const int j = (idx - 10) >> 1, k = (idx - 10) & 1; bf16_t* b = W + WE_SWA0 + (size_t)j * WE_SWA;
        if (k == 0) { d.src = inp(p, 19) + (size_t)j * 2048 * NQKV; d.dst = b + WO_QKV; d.K = 2048; d.Nsrc = NQKV; d.Ndst = NQKV; d.mode = 5; d.gain = inp(p, 8) + (2 * j + 1) * DM; }
        else { d.src = inp(p, 23) + (size_t)j * 2048 * 2048; d.dst = b + WO_SOUT; d.K = 2048; d.Nsrc = 2048; d.Ndst = 2048; }
    } else { const int i = (idx - 14) >> 2, k = (idx - 14) & 3; bf16_t* b = W + WE_L0 + (size_t)i * WE_L;
        if (k == 0) { d.src = inp(p, 25) + (size_t)i * 2048 * DFF; d.src2 = inp(p, 26) + (size_t)i * 2048 * DFF; d.dst = b + WO_G; d.K = 2048; d.Nsrc = DFF; d.Ndst = 2 * DFF; d.mode = 1; d.gain = inp(p, 24) + i * DM; }
        else if (k == 1) { d.src = inp(p, 27) + (size_t)i * DFF * 2048; d.dst = b + WO_D; d.K = DFF; d.Nsrc = 2048; d.Ndst = 2048; }
        else if (k == 2) { d.src = inp(p, 29) + (size_t)i * 2048 * 2048; d.dst = b + WO_PG; d.K = 2048; d.Nsrc = 2048; d.Ndst = 2048; d.gain = inp(p, 28) + i * DM; }
        else { d.src = inp(p, 30) + (size_t)i * PLE * 2048; d.dst = b + WO_PP; d.K = PLE; d.Nsrc = 2048; d.Ndst = 2048; }
    }
    return d;
}
__device__ __forceinline__ void ph_convert_w(const Params& p, int wv, char* lds) {
    const int tid = ltid(wv), lane = tid & 63, wq = tid >> 6;
    LAS float* tile0 = (LAS float*)lds; int par = 0;
    const int G = (int)gridDim.x;
    float v[32], vn[32];
    int wn = 0, basen = 0; WDesc dn = wdesc(p, 0); int tnn = dn.Ndst / 64, ntn = tnn * (dn.K / 256);
#define CW_SEEK(T_) do { while (wn < 29 && (T_) >= basen + ntn) { basen += ntn; ++wn; dn = wdesc(p, wn); tnn = dn.Ndst / 64; ntn = tnn * (dn.K / 256); } } while (0)
#define CW_LOAD(dstv, t_) do { const int k0_ = ((t_) / tnn) * 256, n0_ = ((t_) % tnn) * 64; bool second_; const int sc_ = wsrc_col(dn.mode, n0_ + lane, second_); \
        const PG8_GASF* s_ = (const PG8_GASF*)(second_ ? dn.src2 : dn.src) + (size_t)k0_ * dn.Nsrc + sc_; \
        _Pragma("unroll") for (int i = 0; i < 32; ++i) dstv[i] = s_[(size_t)(wq + 8 * i) * dn.Nsrc]; } while (0)
    int ntot = 0;
    for (int w = 0; w < 30; ++w) { const WDesc t_ = wdesc(p, w); ntot += (t_.Ndst / 64) * (t_.K / 256); }
    int T = lbid();
    if (T < ntot) { CW_SEEK(T); CW_LOAD(vn, T - basen); }
    for (; T < ntot; T += G) {
        const WDesc d = dn; const int tn = tnn, tl = T - basen;
        const int k0 = (tl / tn) * 256, n0 = (tl % tn) * 64;
#pragma unroll
        for (int i = 0; i < 32; ++i) v[i] = vn[i];
        const int Tn = T + G;
        if (Tn < ntot) { CW_SEEK(Tn); CW_LOAD(vn, Tn - basen); }
        __builtin_amdgcn_sched_barrier(0);
        if (d.gain) {
#pragma unroll
            for (int i = 0; i < 32; ++i) v[i] *= ((const PG8_GASF*)d.gain)[k0 + wq + 8 * i];
        }
        LAS float* tile = tile0 + par * (256 * 65); par ^= 1;
#pragma unroll
        for (int i = 0; i < 32; ++i) tile[(wq + 8 * i) * 65 + lane] = v[i];
        __syncthreads();
#pragma unroll
        for (int q = 0; q < 4; ++q) { const int n = (tid >> 5) + 16 * q, k8 = (tid & 31) * 8; const LAS float* sp = tile + k8 * 65 + n;
            u32x4 o; o.x = pk2(sp[0], sp[65]); o.y = pk2(sp[2 * 65], sp[3 * 65]); o.z = pk2(sp[4 * 65], sp[5 * 65]); o.w = pk2(sp[6 * 65], sp[7 * 65]);
            *(PG8_GASU4*)(d.dst + (size_t)(n0 + n) * d.K + k0 + k8) = o; }
    }
#undef CW_LOAD
#undef CW_SEEK
}

__device__ __forceinline__ void ph_init_h(const Params& p, int wv) {
    const int tix = ltid(wv);
    bf16_t* hb = (bf16_t*)(wsp(p) + WS_HB0); ssq_t* ssq = (ssq_t*)(wsp(p) + WS_SSQ);
    const float* xp = inp(p, 0); const float* xs = inp(p, 1);
    const int lane = tix & 63, gw = lbid() * 8 + (tix >> 6), ngw = gridDim.x * 8;
    for (int m = gw; m < MR; m += ngw) {
        const f32x4* xr = (const f32x4*)(m < NPR ? xp + (size_t)m * DM : xs + (size_t)(m - NPR) * DM); float ss = 0.f;
        f32x4 v[8];
#pragma unroll
        for (int j = 0; j < 8; ++j) v[j] = xr[j * 64 + lane];
#pragma unroll
        for (int j = 0; j < 8; ++j) { ss += v[j].x * v[j].x + v[j].y * v[j].y + v[j].z * v[j].z + v[j].w * v[j].w;
            u32x2 o; o.x = pk2(v[j].x, v[j].y); o.y = pk2(v[j].z, v[j].w); *(u32x2*)(hb + (size_t)m * DM + (j * 64 + lane) * 4) = o; }
        ss = wave_sum(ss); if (lane == 0) ssq[m] = (ssq_t)(ss * 4096.0f + 0.5f);
    }
}

__device__ __forceinline__ void ph_caches(const Params& p, int wv) {
    const int tix = ltid(wv); const size_t gt = (size_t)lbid() * 512 + tix, ngt = (size_t)gridDim.x * 512;
    { const f32x4* src = (const f32x4*)inp(p, 4); bf16_t* dst = (bf16_t*)(wsp(p) + WS_LATC); const size_t n4 = (size_t)2 * 16384 * 512 / 4;
      for (size_t k = gt; k < n4; k += ngt) { const f32x4 v = src[k]; u32x2 o; o.x = pk2(v.x, v.y); o.y = pk2(v.z, v.w); *(u32x2*)(dst + k * 4) = o; } }
    { const f32x4* src = (const f32x4*)inp(p, 5); const size_t n4 = (size_t)2 * 16384 * 64 / 4;
      for (size_t k = gt; k < n4; k += ngt) { const f32x4 v = src[k]; const int c4 = (int)(k & 15), r = (int)((k >> 4) & 16383), j = (int)(k >> 18), b = r >> 10, t = r & 1023;
          bf16_t* dst = (bf16_t*)(wsp(p) + WS_KRB + (size_t)j * KRB_STRIDE) + ((size_t)NPR + b * KVPB + t) * 64 + c4 * 4;
          u32x2 o; o.x = pk2(v.x, v.y); o.y = pk2(v.z, v.w); *(u32x2*)dst = o; } }
    { const float* sk = inp(p, 6); const float* sv = inp(p, 7); float* out = outp(p); const size_t n = (size_t)2 * 16 * 128 * 256;
      for (size_t k = gt; k < n; k += ngt) { const int c = (int)(k & 255), i = (int)((k >> 8) & 127), b = (int)((k >> 15) & 15), j = (int)(k >> 19);
          const int g = c >> 6, w = c & 63, d = swa_dim(w >> 5, w & 31);
          const size_t row = ((size_t)j * 16 + b) * 128 + i; const float kx = sk[row * 256 + g * 64 + d], vx = sv[row * 256 + c], kt = sk[row * 256 + c];
          const size_t dr = (size_t)NPR + b * SWPB + i;
          ((bf16_t*)(wsp(p) + WS_SKB + (size_t)j * SKB_STRIDE))[dr * 256 + c] = (bf16_t)f2bf(kx);
          ((bf16_t*)(wsp(p) + WS_SVB + (size_t)j * SKB_STRIDE))[dr * 256 + c] = (bf16_t)f2bf(vx);
          if (i >= 16) { const size_t o = (((size_t)j * 16 + b) * 128 + (i - 16)) * 256 + c; out[O_SKS + o] = kt; out[O_SVS + o] = vx; } } }
}

__device__ __forceinline__ void ph_final(const Params& p, int wv) {
    const int tix = ltid(wv);
    float* y = outp(p); const bf16_t* hb = (const bf16_t*)(wsp(p) + WS_HB0); const ssq_t* ssq = (const ssq_t*)(wsp(p) + WS_SSQ) + 12 * MR; const float* g = inp(p, 31);
    const int lane = tix & 63, gw = lbid() * 8 + (tix >> 6), ngw = gridDim.x * 8;
    for (int m = gw; m < MR; m += ngw) {
        const float rstd = rsqrtf(ssq_val(ssq, m) * (1.0f / DM) + EPS); u32x4 v[4];
#pragma unroll
        for (int j = 0; j < 4; ++j) v[j] = *(const u32x4*)(hb + (size_t)m * DM + (j * 64 + lane) * 8);
#pragma unroll
        for (int j = 0; j < 4; ++j) { const int c = (j * 64 + lane) * 8; const f32x4 g0 = *(const f32x4*)(g + c), g1 = *(const f32x4*)(g + c + 4); f32x4 a, b;
            a[0] = __uint_as_float(v[j].x << 16); a[1] = __uint_as_float(v[j].x & 0xffff0000u); a[2] = __uint_as_float(v[j].y << 16); a[3] = __uint_as_float(v[j].y & 0xffff0000u);
            b[0] = __uint_as_float(v[j].z << 16); b[1] = __uint_as_float(v[j].z & 0xffff0000u); b[2] = __uint_as_float(v[j].w << 16); b[3] = __uint_as_float(v[j].w & 0xffff0000u);
            *(f32x4*)(y + (size_t)m * DM + c) = a * rstd * g0; *(f32x4*)(y + (size_t)m * DM + c + 4) = b * rstd * g1; }
    }
}

__device__ __forceinline__ void ph_lat_fix(const Params& p, int wv, int j, int c, int n  ) {
    const int tix = ltid(wv); const int lane = tix & 63, gw = c * 8 + (tix >> 6), ngw = n * 8;
    const ssq_t* ssq = (const ssq_t*)(wsp(p) + WS_SSQKV) + (size_t)j * MR; const float* g = inp(p, 12) + j * 512; float* out = outp(p);
    const f32x4 g0 = ((const f32x4*)g)[lane], g1 = ((const f32x4*)g)[64 + lane];
    for (int m = gw; m < MR; m += ngw) {
        f32x4* r = (f32x4*)(m < NPR ? out + O_LATP + ((size_t)j * NPR + m) * 512 : out + O_LATS + ((size_t)j * NSR + (m - NPR)) * 512);
        const float rs = rsqrtf(ssq_val(ssq, m) * (1.0f / 512) + EPS);
        const f32x4 a = r[lane], b = r[64 + lane]; r[lane] = a * rs * g0; r[64 + lane] = b * rs * g1;
    }
}

__device__ __forceinline__ void ph_ple_prep(const Params& p, int wv, int i) {
    const int tix = ltid(wv);
    bf16_t* PB = (bf16_t*)(wsp(p) + WS_PB);
    const f32x4* pp = (const f32x4*)(inp(p, 2) + (size_t)i * NPR * PLE); const f32x4* ps = (const f32x4*)(inp(p, 3) + (size_t)i * NSR * PLE);
    const size_t np4 = (size_t)NPR * PLE / 4, ns4 = (size_t)NSR * PLE / 4;
    const size_t gt = (size_t)lbid() * 512 + tix, ngt = (size_t)gridDim.x * 512;
    for (size_t k = gt; k < np4 + ns4; k += ngt) { const f32x4 v = k < np4 ? pp[k] : ps[k - np4]; u32x2 o; o.x = pk2(v.x, v.y); o.y = pk2(v.z, v.w); *(u32x2*)(PB + k * 4) = o; }
}

#define SBAR() __builtin_amdgcn_sched_barrier(0)
__device__ __forceinline__ unsigned cvtpk(float lo, float hi) { unsigned r; asm volatile("v_cvt_pk_bf16_f32 %0, %1, %2" : "=v"(r) : "v"(lo), "v"(hi)); return r; }
#define PK4(P, BASE, OUT) do { unsigned a0_ = cvtpk(P[BASE + 0], P[BASE + 1]), a1_ = cvtpk(P[BASE + 2], P[BASE + 3]);   \
    unsigned b0_ = cvtpk(P[BASE + 4], P[BASE + 5]), b1_ = cvtpk(P[BASE + 6], P[BASE + 7]);                              \
    auto r0_ = __builtin_amdgcn_permlane32_swap(a0_, b0_, false, false); auto r1_ = __builtin_amdgcn_permlane32_swap(a1_, b1_, false, false); \
    u32x4 w_ = {r0_[0], r1_[0], r0_[1], r1_[1]}; OUT = *reinterpret_cast<bf16x8*>(&w_); } while (0)
__device__ __forceinline__ float half_swap_max(float v) { auto rr = __builtin_amdgcn_permlane32_swap(__float_as_uint(v), __float_as_uint(v), false, false); return fmaxf(__uint_as_float(rr[0]), __uint_as_float(rr[1])); }
__device__ __forceinline__ float half_swap_sum(float v) { auto rr = __builtin_amdgcn_permlane32_swap(__float_as_uint(v), __float_as_uint(v), false, false); return __uint_as_float(rr[0]) + __uint_as_float(rr[1]); }
template <int NC> __device__ __forceinline__ int v_st(int k, int c) { const int kk = (k & ~0xC) | ((k & 4) << 1) | ((k & 8) >> 1); return ((kk >> 3) * (NC / 32) + (c >> 5)) * 512 + ((kk & 7) * 32 + (c & 31)) * 2; }
__device__ __forceinline__ int v_rd_base(int lane) { return ((lane & 3) << 3) | (((lane >> 2) & 3) << 6) | (((lane >> 4) & 1) << 5) | (((lane >> 5) & 1) << 8); }
template <int NC> constexpr int v_rd_off(int d0, int ks, int half) { return d0 * 512 + ks * (NC / 32) * 1024 + half * (NC / 32) * 512; }
template <int OFF> __device__ __forceinline__ s16x4 tr_read(int vb) { s16x4 r; asm volatile("ds_read_b64_tr_b16 %0, %1 offset:%2" : "=&v"(r) : "v"(vb), "i"(OFF) : "memory"); return r; }
#define PKV(L, H) (bf16x8){L[0], L[1], L[2], L[3], H[0], H[1], H[2], H[3]}
template <int NC, int D0> __device__ __forceinline__ void pv_one(f32x16& od, int vb, bf16x8 pa0, bf16x8 pa1, bf16x8 pa2, bf16x8 pa3) {
    const s16x4 l0 = tr_read<v_rd_off<NC>(D0, 0, 0)>(vb), h0 = tr_read<v_rd_off<NC>(D0, 0, 1)>(vb), l1 = tr_read<v_rd_off<NC>(D0, 1, 0)>(vb), h1 = tr_read<v_rd_off<NC>(D0, 1, 1)>(vb);
    const s16x4 l2 = tr_read<v_rd_off<NC>(D0, 2, 0)>(vb), h2 = tr_read<v_rd_off<NC>(D0, 2, 1)>(vb), l3 = tr_read<v_rd_off<NC>(D0, 3, 0)>(vb), h3 = tr_read<v_rd_off<NC>(D0, 3, 1)>(vb);
    asm volatile("s_waitcnt lgkmcnt(0)" ::: "memory"); SBAR();
    od = __builtin_amdgcn_mfma_f32_32x32x16_bf16(pa0, PKV(l0, h0), od, 0, 0, 0);
    od = __builtin_amdgcn_mfma_f32_32x32x16_bf16(pa1, PKV(l1, h1), od, 0, 0, 0);
    od = __builtin_amdgcn_mfma_f32_32x32x16_bf16(pa2, PKV(l2, h2), od, 0, 0, 0);
    od = __builtin_amdgcn_mfma_f32_32x32x16_bf16(pa3, PKV(l3, h3), od, 0, 0, 0);
}
#define TRD8(v, NC, D0, vb) do { v[0] = tr_read<v_rd_off<NC>(D0, 0, 0)>(vb); v[1] = tr_read<v_rd_off<NC>(D0, 0, 1)>(vb); v[2] = tr_read<v_rd_off<NC>(D0, 1, 0)>(vb); v[3] = tr_read<v_rd_off<NC>(D0, 1, 1)>(vb); \
        v[4] = tr_read<v_rd_off<NC>(D0, 2, 0)>(vb); v[5] = tr_read<v_rd_off<NC>(D0, 2, 1)>(vb); v[6] = tr_read<v_rd_off<NC>(D0, 3, 0)>(vb); v[7] = tr_read<v_rd_off<NC>(D0, 3, 1)>(vb); } while (0)
#define PVM4(od, v) do { od = __builtin_amdgcn_mfma_f32_32x32x16_bf16(pa0, PKV(v[0], v[1]), od, 0, 0, 0); od = __builtin_amdgcn_mfma_f32_32x32x16_bf16(pa1, PKV(v[2], v[3]), od, 0, 0, 0); \
        od = __builtin_amdgcn_mfma_f32_32x32x16_bf16(pa2, PKV(v[4], v[5]), od, 0, 0, 0); od = __builtin_amdgcn_mfma_f32_32x32x16_bf16(pa3, PKV(v[6], v[7]), od, 0, 0, 0); } while (0)
#define LGKM_WAIT(n) do { asm volatile("s_waitcnt lgkmcnt(" #n ")" ::: "memory"); SBAR(); } while (0)
#define KSWZ256(row, colB) ((row) * 256 + ((colB) ^ (((row) & 7) << 4)))
#define KSWZ128(row, colB) ((row) * 128 + ((colB) ^ (((row) & 7) << 4)))

constexpr int MLA_V = 0, MLA_K = 32768, MLA_KR = 65536, MLA_WS = 81920, MLA_LDS = 83968;
constexpr float MLA_C = 0.07216878364870322f * LOG2E;
__device__ __forceinline__ void mla_attn_unit(int wv, const bf16_t* Qh, int nq, const bf16_t* KVh, const bf16_t* KRb, int nkeys, int NT, int my_nt, bf16_t* Oh, char* lds) {
    const int tid = ltid(wv);
    const int wid = __builtin_amdgcn_readfirstlane(tid >> 6), lane = tid & 63, r32 = lane & 31, hi = lane >> 5;
    LAS char* L = (LAS char*)lds;
    LAS float* wsf = (LAS float*)(L + MLA_WS) + wid * 64;
    bf16x8 qr[12];
    { int qrow = wid * 32 + r32; if (qrow > nq - 1) qrow = nq - 1; const bf16_t* qp = Qh + (size_t)qrow * NQUP + hi * 8;
#pragma unroll
      for (int d0 = 0; d0 < 12; ++d0) qr[d0] = *(const bf16x8*)(qp + d0 * 16); }
    int kq[4];
#pragma unroll
    for (int q = 0; q < 4; ++q) kq[q] = ((q * 32 + hi * 16) ^ ((r32 & 7) << 4));
    const int krow256 = r32 * 256, krow128 = r32 * 128;
    const int sr = tid >> 4, sc = (tid & 15) * 8, vst0 = v_st<128>(sr, sc), vst1 = v_st<128>(32 + sr, sc);
    const int kst0 = KSWZ256(sr, sc * 2), kst1 = KSWZ256(32 + sr, sc * 2);
    const int krr = tid >> 3, krc = (tid & 7) * 8, krst = KSWZ128(krr, krc * 2);
    const int vb0 = (int)(uintptr_t)(lds + MLA_V) + v_rd_base(lane);
    typedef __attribute__((address_space(1))) bf16x8 gbf8_t;
    bf16x8 sk0, sk1, sv0, sv1, skr;
#define MLA_LOAD(t) do { int ra = (t) * 64 + sr, rb = ra + 32, rc = (t) * 64 + krr; if (ra > nkeys - 1) ra = nkeys - 1; if (rb > nkeys - 1) rb = nkeys - 1; if (rc > nkeys - 1) rc = nkeys - 1; \
        sk0 = *(const gbf8_t*)(KVh + (size_t)ra * NKVUP + sc); sk1 = *(const gbf8_t*)(KVh + (size_t)rb * NKVUP + sc); \
        sv0 = *(const gbf8_t*)(KVh + (size_t)ra * NKVUP + 128 + sc); sv1 = *(const gbf8_t*)(KVh + (size_t)rb * NKVUP + 128 + sc); \
        skr = *(const gbf8_t*)(KRb + (size_t)rc * 64 + krc); } while (0)
#define MLA_WRITE(b) do { \
        *(LAS bf16x8*)(L + MLA_V + (b) * 16384 + vst0) = sv0; *(LAS bf16x8*)(L + MLA_V + (b) * 16384 + vst1) = sv1; \
        *(LAS bf16x8*)(L + MLA_K + (b) * 16384 + kst0) = sk0; *(LAS bf16x8*)(L + MLA_K + (b) * 16384 + kst1) = sk1; \
        *(LAS bf16x8*)(L + MLA_KR + (b) * 8192 + krst) = skr; } while (0)
    float m_reg = -1e30f, l_reg = 0.f; f32x16 o[4] = {};
    MLA_LOAD(0); MLA_WRITE(0); __syncthreads();
    for (int j = 0; j < NT; ++j) {
        const int b = j & 1;
        if (j + 1 < NT) MLA_LOAD(j + 1);
        SBAR();
        if (j < my_nt) {
            f32x16 p0 = {}, p1 = {};
            const LAS char* Kb = L + MLA_K + b * 16384 + krow256; const LAS char* KRp = L + MLA_KR + b * 8192 + krow128;
            {
                bf16x8 kk[12][2];
#pragma unroll
                for (int d0 = 0; d0 < 8; ++d0) { kk[d0][0] = *(const LAS bf16x8*)(Kb + kq[d0 & 3] + (d0 >> 2) * 128); kk[d0][1] = *(const LAS bf16x8*)(Kb + kq[d0 & 3] + (d0 >> 2) * 128 + 8192); }
#pragma unroll
                for (int d0 = 0; d0 < 4; ++d0) { kk[8 + d0][0] = *(const LAS bf16x8*)(KRp + kq[d0]); kk[8 + d0][1] = *(const LAS bf16x8*)(KRp + kq[d0] + 4096); }
#pragma unroll
                for (int d0 = 0; d0 < 12; ++d0) { p0 = __builtin_amdgcn_mfma_f32_32x32x16_bf16(kk[d0][0], qr[d0], p0, 0, 0, 0); p1 = __builtin_amdgcn_mfma_f32_32x32x16_bf16(kk[d0][1], qr[d0], p1, 0, 0, 0); }
                __builtin_amdgcn_sched_group_barrier(0x100, 6, 0);
#pragma unroll
                for (int i = 0; i < 9; ++i) { __builtin_amdgcn_sched_group_barrier(0x008, 2, 0); __builtin_amdgcn_sched_group_barrier(0x100, 2, 0); }
                __builtin_amdgcn_sched_group_barrier(0x008, 6, 0);
                SBAR(); }
            const int vb = vb0 + b * 16384; s16x4 va[8], vc[8];
            TRD8(va, 128, 0, vb);
            if (j * 64 + 64 > nkeys) {
#pragma unroll
                for (int r = 0; r < 16; ++r) { const int kk = j * 64 + crow(r, hi); if (kk >= nkeys) p0[r] = -1e30f; if (kk + 32 >= nkeys) p1[r] = -1e30f; }
            }
            float pmax = p0[0];
#pragma unroll
            for (int r = 1; r < 16; ++r) pmax = fmaxf(pmax, p0[r]);
#pragma unroll
            for (int r = 0; r < 16; ++r) pmax = fmaxf(pmax, p1[r]);
            pmax = half_swap_max(pmax);
            const bool upd = !__all((pmax - m_reg) * MLA_C <= 8.0f);
            float alpha = 1.0f;
            if (upd) { const float mn = fmaxf(m_reg, pmax); alpha = __builtin_amdgcn_exp2f((m_reg - mn) * MLA_C); m_reg = mn; }
            const float mnC = -m_reg * MLA_C; float ps = 0.f;
#pragma unroll
            for (int r = 0; r < 16; ++r) { p0[r] = __builtin_amdgcn_exp2f(fmaf(p0[r], MLA_C, mnC)); p1[r] = __builtin_amdgcn_exp2f(fmaf(p1[r], MLA_C, mnC)); ps += p0[r] + p1[r]; }
            ps = half_swap_sum(ps);
            l_reg = l_reg * alpha + ps;
            bf16x8 pa0, pa1, pa2, pa3;
            PK4(p0, 0, pa0); PK4(p0, 8, pa1); PK4(p1, 0, pa2); PK4(p1, 8, pa3);
            if (upd) {
                if (hi == 0) wsf[r32] = alpha; asm volatile("s_waitcnt lgkmcnt(0)" ::: "memory");
#pragma unroll
                for (int r = 0; r < 16; ++r) { const float a = wsf[crow(r, hi)];
#pragma unroll
                    for (int d = 0; d < 4; ++d) o[d][r] *= a; }
                asm volatile("s_waitcnt lgkmcnt(0)" ::: "memory"); }
            TRD8(vc, 128, 1, vb); LGKM_WAIT(8); PVM4(o[0], va);
            TRD8(va, 128, 2, vb); LGKM_WAIT(8); PVM4(o[1], vc);
            TRD8(vc, 128, 3, vb); LGKM_WAIT(8); PVM4(o[2], va);
            LGKM_WAIT(0); PVM4(o[3], vc);
        }
        if (j + 1 < NT) MLA_WRITE(b ^ 1);
        __syncthreads();
    }
    if (hi == 0) wsf[32 + r32] = l_reg; asm volatile("s_waitcnt lgkmcnt(0)" ::: "memory");
    {
        LAS char* ot = L + wid * 8704;
#pragma unroll
        for (int r = 0; r < 16; ++r) { const float rl = __builtin_amdgcn_rcpf(wsf[32 + crow(r, hi)]); LAS unsigned short* rp = (LAS unsigned short*)(ot + crow(r, hi) * 272) + r32;
#pragma unroll
            for (int d = 0; d < 4; ++d) rp[d * 32] = (unsigned short)f2bf(o[d][r] * rl); }
        asm volatile("s_waitcnt lgkmcnt(0)" ::: "memory");
#pragma unroll
        for (int q = 0; q < 8; ++q) { const int ci = q * 64 + lane, row = ci >> 4, c16 = ci & 15, orow = wid * 32 + row;
            const u32x4 w = *(const LAS u32x4*)(ot + row * 272 + c16 * 16);
            if (orow < nq) *(u32x4*)(Oh + (size_t)orow * DM + c16 * 8) = w; }
    }
    __syncthreads();
#undef MLA_LOAD
#undef MLA_WRITE
}
__device__ __forceinline__ void ph_mla_attn(const Params& p, int wv, const bf16_t* KR, bf16_t* O, char* lds) {
    const int tix = ltid(wv);
    const bf16_t* Q = (const bf16_t*)(wsp(p) + WS_Q); const bf16_t* KV = (const bf16_t*)(wsp(p) + WS_KV);
    const int wid = tix >> 6, G = gridDim.x;
    const int npr = (512 + G - 1) / G, nsr = (DBATCH * 16 + G - 1) / G;
    for (int sl = 0; sl < 2 * npr + nsr; ++sl) {
        size_t row0, kr0; int h, nq, nkeys, NT, my_nt;
        if (sl < 2 * npr) {
            const int bb = lbid(), vb = (G & 7) ? bb : (bb & 7) * (G >> 3) + (bb >> 3);
            const int pi = vb + (sl >> 1) * G; if (pi >= 512) continue;
            const int bh = pi >> 3, s = pi & 7, b = bh >> 4, qb = (sl & 1) ? 15 - s : s; h = bh & 15;
            row0 = (size_t)b * SEQ + qb * 256; kr0 = (size_t)b * SEQ; nq = 256; nkeys = SEQ; NT = 4 * qb + 4; my_nt = 4 * qb + (wid >> 1) + 1;
        } else {
            const int u = lbid() + (sl - 2 * npr) * G; if (u >= DBATCH * 16) continue;
            const int b = u >> 4; h = u & 15;
            row0 = (size_t)NPR + b * 16; kr0 = (size_t)NPR + b * KVPB; nq = 16; nkeys = KVPB; NT = 17; my_nt = wid == 0 ? 17 : 0;
        }
        mla_attn_unit(wv, Q + row0 * NQUP + h * 192, nq, KV + kr0 * NKVUP + h * 256, KR + kr0 * 64, nkeys, NT, my_nt, O + row0 * DM + h * 128, lds);
    }
}

constexpr int SWA_K = 0, SWA_V = 24576, SWA_WS = 49152, SWA_LDS = 51200;
__device__ __forceinline__ void swa_attn_unit(int wv, const bf16_t* Qb, int nq, const bf16_t* Kb, const bf16_t* Vb, int nkeys, const float* sinks8, bf16_t* Ob, char* lds) {
    const int tid = ltid(wv);
    const int wid = __builtin_amdgcn_readfirstlane(tid >> 6), lane = tid & 63, r32 = lane & 31, hi = lane >> 5;
    LAS char* L = (LAS char*)lds; LAS float* wsf = (LAS float*)(L + SWA_WS) + wid * 64;
#pragma unroll
    for (int i = 0; i < 3; ++i) { const int idx = tid + i * 512, row = idx >> 3, ch = idx & 7; const bool valid = row < nkeys; const int rr = valid ? row : 0;
        bf16x8 kx = *(const bf16x8*)(Kb + (size_t)rr * 256 + ch * 8), vx = *(const bf16x8*)(Vb + (size_t)rr * 256 + ch * 8);
        if (!valid) { kx = (bf16x8){0, 0, 0, 0, 0, 0, 0, 0}; vx = kx; }
        *(LAS bf16x8*)(L + SWA_K + KSWZ128(row, ch * 16)) = kx;
        *(LAS bf16x8*)(L + SWA_V + (row >> 6) * 8192 + v_st<64>(row & 63, ch * 8)) = vx; }
    __syncthreads();
    const float sink2 = sinks8[wid] * LOG2E; const int vb0 = (int)(uintptr_t)(lds + SWA_V) + v_rd_base(lane);
    constexpr float SC = 0.125f * LOG2E;
    int kq[4];
#pragma unroll
    for (int q = 0; q < 4; ++q) kq[q] = r32 * 128 + ((q * 32 + hi * 16) ^ ((r32 & 7) << 4));
    const int ntile = (nkeys + 63) >> 6;
    for (int q2 = 0; q2 * 32 < nq; ++q2) {
        bf16x8 qr[4];
        { int qrow = q2 * 32 + r32; if (qrow > nq - 1) qrow = nq - 1; const bf16_t* qp = Qb + (size_t)qrow * DM + wid * 64 + hi * 8;
#pragma unroll
          for (int d0 = 0; d0 < 4; ++d0) qr[d0] = *(const bf16x8*)(qp + d0 * 16); }
        float m_reg = sink2, l_reg = 1.0f; f32x16 o0 = {}, o1 = {};
        for (int t = 0; t < ntile; ++t) {
            f32x16 p0 = {}, p1 = {};
            const LAS char* Kt = L + SWA_K + t * 8192;
#pragma unroll
            for (int d0 = 0; d0 < 4; ++d0) { const bf16x8 k0 = *(const LAS bf16x8*)(Kt + kq[d0]), k1 = *(const LAS bf16x8*)(Kt + kq[d0] + 4096);
                p0 = __builtin_amdgcn_mfma_f32_32x32x16_bf16(k0, qr[d0], p0, 0, 0, 0);
                p1 = __builtin_amdgcn_mfma_f32_32x32x16_bf16(k1, qr[d0], p1, 0, 0, 0); }
            if (t * 64 + 64 > nkeys) {
#pragma unroll
                for (int r = 0; r < 16; ++r) { const int kk = t * 64 + crow(r, hi); if (kk >= nkeys) p0[r] = -1e30f; if (kk + 32 >= nkeys) p1[r] = -1e30f; }
            }
            float pmax = p0[0];
#pragma unroll
            for (int r = 1; r < 16; ++r) pmax = fmaxf(pmax, p0[r]);
#pragma unroll
            for (int r = 0; r < 16; ++r) pmax = fmaxf(pmax, p1[r]);
            pmax = half_swap_max(pmax) * SC;
            const bool upd = !__all(pmax - m_reg <= 8.0f);
            float alpha = 1.0f;
            if (upd) { const float mn = fmaxf(m_reg, pmax); alpha = __builtin_amdgcn_exp2f(m_reg - mn); m_reg = mn; }
            const float mn = m_reg;
            float ps = 0.f;
#pragma unroll
            for (int r = 0; r < 16; ++r) { p0[r] = __builtin_amdgcn_exp2f(fmaf(p0[r], SC, -mn)); p1[r] = __builtin_amdgcn_exp2f(fmaf(p1[r], SC, -mn)); ps += p0[r] + p1[r]; }
            ps = half_swap_sum(ps);
            l_reg = l_reg * alpha + ps;
            bf16x8 pa0, pa1, pa2, pa3;
            PK4(p0, 0, pa0); PK4(p0, 8, pa1); PK4(p1, 0, pa2); PK4(p1, 8, pa3);
            if (upd) {
                if (hi == 0) wsf[r32] = alpha; asm volatile("s_waitcnt lgkmcnt(0)" ::: "memory");
#pragma unroll
                for (int r = 0; r < 16; ++r) { const float a = wsf[crow(r, hi)]; o0[r] *= a; o1[r] *= a; }
                asm volatile("s_waitcnt lgkmcnt(0)" ::: "memory"); }
            const int vb = vb0 + t * 8192;
            pv_one<64, 0>(o0, vb, pa0, pa1, pa2, pa3); pv_one<64, 1>(o1, vb, pa0, pa1, pa2, pa3);
        }
        if (hi == 0) wsf[32 + r32] = l_reg; asm volatile("s_waitcnt lgkmcnt(0)" ::: "memory");
        {
            LAS char* ot = L + SWA_LDS + wid * 4608;
#pragma unroll
            for (int r = 0; r < 16; ++r) { const float rl = __builtin_amdgcn_rcpf(wsf[32 + crow(r, hi)]); LAS unsigned short* rp = (LAS unsigned short*)(ot + crow(r, hi) * 144) + r32;
                rp[0] = (unsigned short)f2bf(o0[r] * rl); rp[32] = (unsigned short)f2bf(o1[r] * rl); }
            asm volatile("s_waitcnt lgkmcnt(0)" ::: "memory");
#pragma unroll
            for (int q = 0; q < 4; ++q) { const int ci = q * 64 + lane, row = ci >> 3, c16 = ci & 7, orow = q2 * 32 + row;
                const u32x4 w = *(const LAS u32x4*)(ot + row * 144 + c16 * 16);
                if (orow < nq) *(u32x4*)(Ob + (size_t)orow * DM + wid * 64 + c16 * 8) = w; }
            asm volatile("s_waitcnt lgkmcnt(0)" ::: "memory");
        }
    }
    __syncthreads();
}
__device__ __forceinline__ void ph_swa_attn(const Params& p, int wv, int j, const bf16_t* SK, const bf16_t* SV, bf16_t* O, char* lds) {
    const bf16_t* SQ = (const bf16_t*)(wsp(p) + WS_SQ);
    const float* sinks = inp(p, 22) + j * 32;
    const int bb_ = lbid(), G_ = (int)gridDim.x, vb_ = (G_ & 7) ? bb_ : (bb_ & 7) * (G_ >> 3) + (bb_ >> 3);
    for (int u = vb_; u < 1024 + DBATCH * 4; u += gridDim.x) {
        size_t qrow0, krow0; int g, nq, nk;
        if (u < 1024) { const int c = u & 63, b = u >> 8; g = (u >> 6) & 3; const int c0 = c >= 2 ? c - 2 : 0; nk = (c - c0 + 1) * 64; nq = 64;
            qrow0 = (size_t)b * SEQ + c * 64; krow0 = (size_t)b * SEQ + c0 * 64; }
        else { const int v = u - 1024, b = v >> 2; g = v & 3; nq = 16; nk = SWPB; qrow0 = (size_t)NPR + b * 16; krow0 = (size_t)NPR + b * SWPB; }
        swa_attn_unit(wv, SQ + qrow0 * DM + g * 512, nq, SK + krow0 * 256 + g * 64, SV + krow0 * 256 + g * 64, nk, sinks + g * 8, O + qrow0 * DM + g * 512, lds);
    }
}

namespace pg8 {
#define PG8_LAS __attribute__((address_space(3)))
typedef unsigned short bf16_t;
typedef short bf16x8 __attribute__((ext_vector_type(8)));
typedef float f32x4 __attribute__((ext_vector_type(4)));
typedef unsigned u32x4 __attribute__((ext_vector_type(4)));
constexpr int BM = 256, BK = 64, HALF = 128, HTB = HALF * BK * 2  , STAGE_BYTES = 8 * HTB, NXCD = 8, WGM = 8;

__host__ __device__ __forceinline__ int lds_byte(int r, int c) { const int st = (r >> 4) * 2 + (c >> 5), rr = r & 15, cc = c & 31, ob = rr * 64 + cc * 2; return st * 1024 + (ob ^ (((ob >> 9) & 1) << 5)); }
__host__ __device__ __forceinline__ void stage_rc(int b, int& R, int& C) { const int st = b / 1024, sb = b % 1024, swz = sb ^ (((sb >> 9) & 1) << 5); R = (st >> 1) * 16 + swz / 64; C = (st & 1) * 32 + (swz % 64) / 2; }
__host__ __device__ __forceinline__ int perm32(int rho) { const int n = rho >> 4, i = rho & 15; return 8 * (i >> 2) + 4 * n + (i & 3); }

struct Unit { int pm, pn; };
struct Gemm { const bf16_t* A; const bf16_t* Bt; int M, N, K; };

struct StaticOrder {
    int nM, nN, nwg, G, c, wgm;
    __host__ __device__ void init(int M, int N, int G_, int c_, int wgm_ = WGM) { nM = M / BM; nN = N / BM; nwg = nM * nN; G = G_; c = c_; wgm = wgm_; }
    __host__ __device__ bool next(int i, Unit& u) const {
        const int L = i * G + c; if (L >= nwg) return false;
        int wgid = L; { const int q = nwg / NXCD, r = nwg % NXCD, xcd = wgid % NXCD, off = wgid / NXCD; wgid = (xcd < r ? xcd * (q + 1) : r * (q + 1) + (xcd - r) * q) + off; }
        const int nig = wgm * nN, gid = wgid / nig, fm = gid * wgm, gsz = (nM - fm) < wgm ? (nM - fm) : wgm;
        u.pm = fm + ((wgid % nig) % gsz); u.pn = (wgid % nig) / gsz; return true;
    }
    __device__ __forceinline__ void a_ready(const Unit&) const {}
    __device__ __forceinline__ void done(const Unit&) const {}
};

__device__ __forceinline__ unsigned cvt_pk_bf16(float lo, float hi) { unsigned r; asm volatile("v_cvt_pk_bf16_f32 %0, %1, %2" : "=v"(r) : "v"(lo), "v"(hi)); return r; }
#define PG8_FOR_ROWS for (int ai = 0; ai < 2; ++ai) _Pragma("unroll") for (int m = 0; m < 4; ++m)
#define PG8_GAS __attribute__((address_space(1)))
typedef PG8_GAS f32x4 gf32x4; typedef PG8_GAS u32x4 gu32x4; typedef unsigned u32x2 __attribute__((ext_vector_type(2))); typedef PG8_GAS u32x2 gu32x2; typedef PG8_GAS float gfloat;
__device__ __forceinline__ float rstd_of(const ssq_t* ssq, int row) { return rsqrtf(ssq_val(ssq, row) * (1.0f / 2048) + 1e-6f); }
typedef PG8_LAS float lfloat; typedef PG8_LAS f32x4 lf32x4;
__device__ __forceinline__ void wg_bar() { asm volatile("s_waitcnt lgkmcnt(0)\n\ts_barrier" ::: "memory"); }
__device__ __forceinline__ float fq_sum(float v) {
    { auto r = __builtin_amdgcn_permlane16_swap(__float_as_uint(v), __float_as_uint(v), false, false); v = __uint_as_float(r[0]) + __uint_as_float(r[1]); }
    { auto r = __builtin_amdgcn_permlane32_swap(__float_as_uint(v), __float_as_uint(v), false, false); v = __uint_as_float(r[0]) + __uint_as_float(r[1]); }
    return v; }
__device__ __forceinline__ u32x4 pack8(const f32x4& a, const f32x4& b) { u32x4 w; w.x = cvt_pk_bf16(a[0], a[1]); w.y = cvt_pk_bf16(a[2], a[3]); w.z = cvt_pk_bf16(b[0], b[1]); w.w = cvt_pk_bf16(b[2], b[3]); return w; }

struct EpiStoreF32 {
    static constexpr bool PERM = false, AFTER_DRAIN = false;
    float* C; int ldc, ncols; const ssq_t* ssq;
    __device__ __forceinline__ void operator()(const f32x4 (&acc)[2][2][4][2], const Unit& u, int wr, int wc, int fr, int fq) const {
        { int l_ = (int)__builtin_amdgcn_mbcnt_hi(~0u, __builtin_amdgcn_mbcnt_lo(~0u, 0u)); asm volatile("" : "+v"(l_)); fr = l_ & 15; fq = l_ >> 4; }
        const int row0 = u.pm * BM + wr * 64 + fr, col0 = u.pn * BM + wc * 32 + 4 * fq;
        float rs[2][4];
#pragma unroll
        PG8_FOR_ROWS rs[ai][m] = ssq ? rstd_of(ssq, row0 + ai * HALF + m * 16) : 1.0f;
#pragma unroll
        PG8_FOR_ROWS { float* rowp = C + (size_t)(row0 + ai * HALF + m * 16) * ldc + col0;
#pragma unroll
            for (int bj = 0; bj < 2; ++bj)
#pragma unroll
                for (int n = 0; n < 2; ++n) if (col0 + bj * HALF + n * 16 < ncols) *(gf32x4*)(rowp + bj * HALF + n * 16) = acc[ai][bj][m][n] * rs[ai][m]; }
    }
};
__device__ __forceinline__ void unpack8(const u32x4& w, f32x4& a, f32x4& b) {
    a[0] = __uint_as_float(w.x << 16); a[1] = __uint_as_float(w.x & 0xffff0000u); a[2] = __uint_as_float(w.y << 16); a[3] = __uint_as_float(w.y & 0xffff0000u);
    b[0] = __uint_as_float(w.z << 16); b[1] = __uint_as_float(w.z & 0xffff0000u); b[2] = __uint_as_float(w.w << 16); b[3] = __uint_as_float(w.w & 0xffff0000u); }
struct EpiResidF32 {
    static constexpr bool PERM = true, AFTER_DRAIN = false;
    const bf16_t* hin; bf16_t* hout; ssq_t* ssq_out;
    __device__ __forceinline__ void operator()(const f32x4 (&acc)[2][2][4][2], const Unit& u, int wr, int wc, int fr, int fq) const {
        { int l_ = (int)__builtin_amdgcn_mbcnt_hi(~0u, __builtin_amdgcn_mbcnt_lo(~0u, 0u)); asm volatile("" : "+v"(l_)); fr = l_ & 15; fq = l_ >> 4; }
        const int row0 = u.pm * BM + wr * 64 + fr, col0 = u.pn * BM + wc * 32 + 8 * fq;
#pragma unroll
        for (int ai = 0; ai < 2; ++ai) {
            u32x4 v[4][2];
#pragma unroll
            for (int m = 0; m < 4; ++m)
#pragma unroll
                for (int bj = 0; bj < 2; ++bj) v[m][bj] = *(const gu32x4*)(hin + (size_t)(row0 + ai * HALF + m * 16) * 2048 + col0 + bj * HALF);
#pragma unroll
            for (int m = 0; m < 4; ++m) { const int row = row0 + ai * HALF + m * 16; const size_t off = (size_t)row * 2048 + col0; float ss = 0.f;
#pragma unroll
                for (int bj = 0; bj < 2; ++bj) { f32x4 h0, h1; unpack8(v[m][bj], h0, h1); const f32x4 o0 = h0 + acc[ai][bj][m][0], o1 = h1 + acc[ai][bj][m][1];
                    ss += o0[0] * o0[0] + o0[1] * o0[1] + o0[2] * o0[2] + o0[3] * o0[3] + o1[0] * o1[0] + o1[1] * o1[1] + o1[2] * o1[2] + o1[3] * o1[3];
                    *(gu32x4*)(hout + off + bj * HALF) = pack8(o0, o1); }
                ss = fq_sum(ss);
                if (fq == 0) ssq_add(ssq_out, row, ss); }
            asm volatile("" ::: "memory"); }
    }
};
struct EpiPleF32 {
    static constexpr bool PERM = true, AFTER_DRAIN = false;
    const bf16_t* hin; const bf16_t* t; bf16_t* hout; const ssq_t* ssq_in; ssq_t* ssq_out;
    __device__ __forceinline__ void operator()(const f32x4 (&acc)[2][2][4][2], const Unit& u, int wr, int wc, int fr, int fq) const {
        { int l_ = (int)__builtin_amdgcn_mbcnt_hi(~0u, __builtin_amdgcn_mbcnt_lo(~0u, 0u)); asm volatile("" : "+v"(l_)); fr = l_ & 15; fq = l_ >> 4; }
        const int row0 = u.pm * BM + wr * 64 + fr, col0 = u.pn * BM + wc * 32 + 8 * fq;
#pragma unroll
        for (int ai = 0; ai < 2; ++ai)
#pragma unroll
            for (int mp = 0; mp < 2; ++mp) {
                u32x4 hv[2][2], tv[2][2];
#pragma unroll
                for (int mm = 0; mm < 2; ++mm)
#pragma unroll
                    for (int bj = 0; bj < 2; ++bj) { const size_t o_ = (size_t)(row0 + ai * HALF + (mp * 2 + mm) * 16) * 2048 + col0 + bj * HALF; hv[mm][bj] = *(const gu32x4*)(hin + o_); tv[mm][bj] = *(const gu32x4*)(t + o_); }
#pragma unroll
                for (int mm = 0; mm < 2; ++mm) { const int m = mp * 2 + mm, row = row0 + ai * HALF + m * 16; const size_t off = (size_t)row * 2048 + col0; const float rs = rstd_of(ssq_in, row); float ss = 0.f;
#pragma unroll
                    for (int bj = 0; bj < 2; ++bj) { f32x4 h[2], tt[2], o[2]; unpack8(hv[mm][bj], h[0], h[1]); unpack8(tv[mm][bj], tt[0], tt[1]);
#pragma unroll
                        for (int n = 0; n < 2; ++n)
#pragma unroll
                            for (int e = 0; e < 4; ++e) { const float x = h[n][e] + tt[n][e] * __builtin_amdgcn_rcpf(1.0f + __expf(-acc[ai][bj][m][n][e] * rs)); o[n][e] = x; ss += x * x; }
                        *(gu32x4*)(hout + off + bj * HALF) = pack8(o[0], o[1]); }
                    ss = fq_sum(ss);
                    if (fq == 0) ssq_add(ssq_out, row, ss); }
                asm volatile("" ::: "memory"); }
    }
};
struct EpiStoreBf16 {
    static constexpr bool PERM = true, AFTER_DRAIN = false;
    bf16_t* O; int ldc;
    __device__ __forceinline__ void operator()(const f32x4 (&acc)[2][2][4][2], const Unit& u, int wr, int wc, int fr, int fq) const {
        { int l_ = (int)__builtin_amdgcn_mbcnt_hi(~0u, __builtin_amdgcn_mbcnt_lo(~0u, 0u)); asm volatile("" : "+v"(l_)); fr = l_ & 15; fq = l_ >> 4; }
        const int row0 = u.pm * BM + wr * 64 + fr, col0 = u.pn * BM + wc * 32 + 8 * fq;
#pragma unroll
        PG8_FOR_ROWS { bf16_t* rowp = O + (size_t)(row0 + ai * HALF + m * 16) * ldc + col0;
#pragma unroll
            for (int bj = 0; bj < 2; ++bj) { const f32x4 v0 = acc[ai][bj][m][0], v1 = acc[ai][bj][m][1];
                u32x4 w; w.x = cvt_pk_bf16(v0[0], v0[1]); w.y = cvt_pk_bf16(v0[2], v0[3]); w.z = cvt_pk_bf16(v1[0], v1[1]); w.w = cvt_pk_bf16(v1[2], v1[3]);
                *(gu32x4*)(rowp + bj * HALF) = w; } }
    }
};
struct EpiSwigluBf16 {
    static constexpr bool PERM = true, AFTER_DRAIN = false;
    bf16_t* act; int ldc; const ssq_t* ssq;
    __device__ __forceinline__ void operator()(const f32x4 (&acc)[2][2][4][2], const Unit& u, int wr, int wc, int fr, int fq) const {
        { int l_ = (int)__builtin_amdgcn_mbcnt_hi(~0u, __builtin_amdgcn_mbcnt_lo(~0u, 0u)); asm volatile("" : "+v"(l_)); fr = l_ & 15; fq = l_ >> 4; }
        const int row0 = u.pm * BM + wr * 64 + fr, ch0 = u.pn * HALF + wc * 32 + 8 * fq;
        float rs[2][4];
#pragma unroll
        PG8_FOR_ROWS rs[ai][m] = rstd_of(ssq, row0 + ai * HALF + m * 16);
#pragma unroll
        PG8_FOR_ROWS { bf16_t* rowp = act + (size_t)(row0 + ai * HALF + m * 16) * ldc + ch0; float o[8]; const float r_ = rs[ai][m];
#pragma unroll
            for (int n = 0; n < 2; ++n)
#pragma unroll
                for (int e = 0; e < 4; ++e) { const float g = acc[ai][0][m][n][e] * r_, up = acc[ai][1][m][n][e] * r_; o[n * 4 + e] = g * __builtin_amdgcn_rcpf(1.0f + __expf(-g)) * up; }
            u32x4 w; w.x = cvt_pk_bf16(o[0], o[1]); w.y = cvt_pk_bf16(o[2], o[3]); w.z = cvt_pk_bf16(o[4], o[5]); w.w = cvt_pk_bf16(o[6], o[7]);
            *(gu32x4*)rowp = w; }
    }
};
struct EpiMlaIn {
    static constexpr bool PERM = true, AFTER_DRAIN = false;
    bf16_t* CQ; bf16_t* CKV; bf16_t* KRB; float* out; int j; const ssq_t* ssq_h; ssq_t* ssq_q; ssq_t* ssq_kv; const float* gkr; const float* tm;
    __device__ __forceinline__ void operator()(const f32x4 (&acc)[2][2][4][2], const Unit& u, int wr, int wc, int fr, int fq) const {
        { int l_ = (int)__builtin_amdgcn_mbcnt_hi(~0u, __builtin_amdgcn_mbcnt_lo(~0u, 0u)); asm volatile("" : "+v"(l_)); fr = l_ & 15; fq = l_ >> 4; }
        const int row0 = u.pm * BM + wr * 64 + fr, cw = wc * 32 + 8 * fq;
        if (u.pn < 4) {
            const bool iskv = u.pn >= 2; bf16_t* dst = iskv ? CKV : CQ; ssq_t* sq = iskv ? ssq_kv : ssq_q; const int c0 = (u.pn & 1) * 256 + cw;
#pragma unroll
            PG8_FOR_ROWS { const int row = row0 + ai * HALF + m * 16; const float rs = rstd_of(ssq_h, row); float ss = 0.f;
                float* lo = iskv ? (row < NPR ? out + O_LATP + ((size_t)j * NPR + row) * 512 : out + O_LATS + ((size_t)j * NSR + (row - NPR)) * 512) + c0 : nullptr;
#pragma unroll
                for (int bj = 0; bj < 2; ++bj) { const f32x4 a = acc[ai][bj][m][0] * rs, b = acc[ai][bj][m][1] * rs;
                    ss += a[0] * a[0] + a[1] * a[1] + a[2] * a[2] + a[3] * a[3] + b[0] * b[0] + b[1] * b[1] + b[2] * b[2] + b[3] * b[3];
                    *(gu32x4*)(dst + (size_t)row * 512 + c0 + bj * HALF) = pack8(a, b);
                    if (iskv) { *(gf32x4*)(lo + bj * HALF) = a; *(gf32x4*)(lo + bj * HALF + 4) = b; } }
                ss = fq_sum(ss); if (fq == 0) ssq_add(sq, row, ss); }
        } else if (wc == 0) {
            f32x4 g[2][2];
#pragma unroll
            for (int bj = 0; bj < 2; ++bj)
#pragma unroll
                for (int n = 0; n < 2; ++n) g[bj][n] = *(const gf32x4*)(gkr + 32 * bj + 8 * fq + 4 * n);
#pragma unroll
            PG8_FOR_ROWS { const int row = row0 + ai * HALF + m * 16; const float rs = rstd_of(ssq_h, row); f32x4 x[2][2]; float ss = 0.f;
#pragma unroll
                for (int bj = 0; bj < 2; ++bj)
#pragma unroll
                    for (int n = 0; n < 2; ++n) { x[bj][n] = acc[ai][bj][m][n] * rs; ss += x[bj][n][0] * x[bj][n][0] + x[bj][n][1] * x[bj][n][1] + x[bj][n][2] * x[bj][n][2] + x[bj][n][3] * x[bj][n][3]; }
                const float r2 = rsqrtf(fq_sum(ss) * (1.0f / 64) + 1e-6f);
                const float* tp = tm + ((size_t)pos_of_row(row) * 32 + 8 * fq) * 2;
                f32x4 o[2][2];
#pragma unroll
                for (int n = 0; n < 2; ++n) { const f32x4 t0 = *(const gf32x4*)(tp + 8 * n), t1 = *(const gf32x4*)(tp + 8 * n + 4);
                    const float cs[4] = {t0[0], t0[2], t1[0], t1[2]}, sn[4] = {t0[1], t0[3], t1[1], t1[3]};
#pragma unroll
                    for (int e = 0; e < 4; ++e) { const float x1 = x[0][n][e] * r2 * g[0][n][e], x2 = x[1][n][e] * r2 * g[1][n][e]; o[0][n][e] = x1 * cs[e] - x2 * sn[e]; o[1][n][e] = x2 * cs[e] + x1 * sn[e]; } }
                float* ko = (row < NPR ? out + O_KRP + ((size_t)j * NPR + row) * 64 : out + O_KRS + ((size_t)j * NSR + (row - NPR)) * 64) + 8 * fq;
                bf16_t* kb = KRB + (size_t)latrow_of(row) * 64 + 8 * fq;
#pragma unroll
                for (int bj = 0; bj < 2; ++bj) { *(gf32x4*)(ko + 32 * bj) = o[bj][0]; *(gf32x4*)(ko + 32 * bj + 4) = o[bj][1]; *(gu32x4*)(kb + 32 * bj) = pack8(o[bj][0], o[bj][1]); } }
        }
    }
};

struct EpiQup {
    static constexpr bool PERM = true, AFTER_DRAIN = false;
    bf16_t* Q; const ssq_t* ssq_q; const float* gqn; const float* gqr; const float* tm; lfloat* xch;
    __device__ __forceinline__ void operator()(const f32x4 (&acc)[2][2][4][2], const Unit& u, int wr, int wc, int fr, int fq) const {
        { int l_ = (int)__builtin_amdgcn_mbcnt_hi(~0u, __builtin_amdgcn_mbcnt_lo(~0u, 0u)); asm volatile("" : "+v"(l_)); fr = l_ & 15; fq = l_ >> 4; }
        const int row0 = u.pm * BM + wr * 64 + fr, rl0 = wr * 64 + fr;
        float rs[2][4];
#pragma unroll
        PG8_FOR_ROWS rs[ai][m] = rsqrtf(ssq_val(ssq_q, row0 + ai * HALF + m * 16) * (1.0f / 512) + 1e-6f);
        if (u.pn < 8) {
#pragma unroll
            PG8_FOR_ROWS {
#pragma unroll
                for (int bj = 0; bj < 2; ++bj) { const f32x4 a = acc[ai][bj][m][0], b = acc[ai][bj][m][1];
                    float ss = a[0] * a[0] + a[1] * a[1] + a[2] * a[2] + a[3] * a[3] + b[0] * b[0] + b[1] * b[1] + b[2] * b[2] + b[3] * b[3];
                    ss = fq_sum(ss) * rs[ai][m] * rs[ai][m]; if (fq == 0) xch[((rl0 + ai * HALF + m * 16) * 2 + bj) * 4 + wc] = ss; } }
            wg_bar();
            const f32x4 g0 = *(const gf32x4*)(gqn + wc * 32 + 8 * fq), g1 = *(const gf32x4*)(gqn + wc * 32 + 8 * fq + 4);
#pragma unroll
            PG8_FOR_ROWS { const int row = row0 + ai * HALF + m * 16;
#pragma unroll
                for (int bj = 0; bj < 2; ++bj) { const f32x4 t = *(const lf32x4*)(xch + ((rl0 + ai * HALF + m * 16) * 2 + bj) * 4);
                    const float r2 = rsqrtf((t[0] + t[1] + t[2] + t[3]) * (1.0f / 128) + 1e-6f) * rs[ai][m];
                    *(gu32x4*)(Q + (size_t)row * NQUP + (2 * u.pn + bj) * 192 + wc * 32 + 8 * fq) = pack8(acc[ai][bj][m][0] * r2 * g0, acc[ai][bj][m][1] * r2 * g1); } }
        } else {
            const int hd = 4 * (u.pn - 8) + wc; f32x4 g[2][2];
#pragma unroll
            for (int bj = 0; bj < 2; ++bj)
#pragma unroll
                for (int n = 0; n < 2; ++n) g[bj][n] = *(const gf32x4*)(gqr + 32 * bj + 8 * fq + 4 * n);
#pragma unroll
            PG8_FOR_ROWS { const int row = row0 + ai * HALF + m * 16; f32x4 x[2][2]; float ss = 0.f;
#pragma unroll
                for (int bj = 0; bj < 2; ++bj)
#pragma unroll
                    for (int n = 0; n < 2; ++n) { x[bj][n] = acc[ai][bj][m][n] * rs[ai][m]; ss += x[bj][n][0] * x[bj][n][0] + x[bj][n][1] * x[bj][n][1] + x[bj][n][2] * x[bj][n][2] + x[bj][n][3] * x[bj][n][3]; }
                const float r2 = rsqrtf(fq_sum(ss) * (1.0f / 64) + 1e-6f);
                const float* tp = tm + ((size_t)pos_of_row(row) * 32 + 8 * fq) * 2;
                f32x4 o[2][2];
#pragma unroll
                for (int n = 0; n < 2; ++n) { const f32x4 t0 = *(const gf32x4*)(tp + 8 * n), t1 = *(const gf32x4*)(tp + 8 * n + 4);
                    const float cs[4] = {t0[0], t0[2], t1[0], t1[2]}, sn[4] = {t0[1], t0[3], t1[1], t1[3]};
#pragma unroll
                    for (int e = 0; e < 4; ++e) { const float x1 = x[0][n][e] * r2 * g[0][n][e], x2 = x[1][n][e] * r2 * g[1][n][e]; o[0][n][e] = x1 * cs[e] - x2 * sn[e]; o[1][n][e] = x2 * cs[e] + x1 * sn[e]; } }
                bf16_t* qp = Q + (size_t)row * NQUP + hd * 192 + 128 + 8 * fq;
#pragma unroll
                for (int bj = 0; bj < 2; ++bj) *(gu32x4*)(qp + 32 * bj) = pack8(o[bj][0], o[bj][1]); }
        }
    }
};

struct EpiKvup {
    static constexpr bool PERM = true, AFTER_DRAIN = false;
    bf16_t* KV; const ssq_t* ssq_kv; const float* gkn; lfloat* xch;
    __device__ __forceinline__ void operator()(const f32x4 (&acc)[2][2][4][2], const Unit& u, int wr, int wc, int fr, int fq) const {
        { int l_ = (int)__builtin_amdgcn_mbcnt_hi(~0u, __builtin_amdgcn_mbcnt_lo(~0u, 0u)); asm volatile("" : "+v"(l_)); fr = l_ & 15; fq = l_ >> 4; }
        const int row0 = u.pm * BM + wr * 64 + fr, rl0 = wr * 64 + fr;
        float rs[2][4];
#pragma unroll
        PG8_FOR_ROWS rs[ai][m] = ssq_kv ? rsqrtf(ssq_val(ssq_kv, row0 + ai * HALF + m * 16) * (1.0f / 512) + 1e-6f) : 1.0f;
#pragma unroll
        PG8_FOR_ROWS { const f32x4 a = acc[ai][0][m][0], b = acc[ai][0][m][1];
            float ss = a[0] * a[0] + a[1] * a[1] + a[2] * a[2] + a[3] * a[3] + b[0] * b[0] + b[1] * b[1] + b[2] * b[2] + b[3] * b[3];
            ss = fq_sum(ss) * rs[ai][m] * rs[ai][m]; if (fq == 0) xch[(rl0 + ai * HALF + m * 16) * 4 + wc] = ss; }
        wg_bar();
        const f32x4 g0 = *(const gf32x4*)(gkn + wc * 32 + 8 * fq), g1 = *(const gf32x4*)(gkn + wc * 32 + 8 * fq + 4);
#pragma unroll
        PG8_FOR_ROWS { const int row = row0 + ai * HALF + m * 16; const int orow = ssq_kv ? latrow_of(row) : NPR + (row >> 10) * KVPB + (row & 1023);
            const f32x4 t = *(const lf32x4*)(xch + (rl0 + ai * HALF + m * 16) * 4);
            const float r2 = rsqrtf((t[0] + t[1] + t[2] + t[3]) * (1.0f / 128) + 1e-6f) * rs[ai][m];
            bf16_t* kp = KV + (size_t)orow * NKVUP + u.pn * 256 + wc * 32 + 8 * fq;
            *(gu32x4*)kp = pack8(acc[ai][0][m][0] * r2 * g0, acc[ai][0][m][1] * r2 * g1);
            *(gu32x4*)(kp + HALF) = pack8(acc[ai][1][m][0] * rs[ai][m], acc[ai][1][m][1] * rs[ai][m]); }
    }
};

struct EpiSwaQkv {
    static constexpr bool PERM = true, AFTER_DRAIN = false;
    bf16_t* SQ; bf16_t* SK; bf16_t* SV; float* out; int j; const ssq_t* ssq_h; const float* gq; const float* gk; const float* ts;
    __device__ __forceinline__ float* state_out(int row, bool isk) const {
        if (row < NPR) { const int b = row >> 12, t = row & 4095; if (t < SEQ - 128) return nullptr; return out + (isk ? O_SKP : O_SVP) + (((size_t)j * 4 + b) * 128 + (t - (SEQ - 128))) * 256; }
        const int b = (row - NPR) >> 4, t = (row - NPR) & 15; return out + (isk ? O_SKS : O_SVS) + (((size_t)j * 16 + b) * 128 + 112 + t) * 256;
    }
    __device__ __forceinline__ void operator()(const f32x4 (&acc)[2][2][4][2], const Unit& u, int wr, int wc, int fr, int fq) const {
        { int l_ = (int)__builtin_amdgcn_mbcnt_hi(~0u, __builtin_amdgcn_mbcnt_lo(~0u, 0u)); asm volatile("" : "+v"(l_)); fr = l_ & 15; fq = l_ >> 4; }
        const int row0 = u.pm * BM + wr * 64 + fr;
        if (u.pn < 9) {
            const bool isk = u.pn == 8; const float* gg = isk ? gk : gq;
            typedef float f32x2_ __attribute__((ext_vector_type(2))); typedef PG8_GAS f32x2_ gf32x2_;
            f32x4 g[2][2];
#pragma unroll
            for (int bj = 0; bj < 2; ++bj) { const f32x2_ gr = *(const gf32x2_*)(gg + 8 * bj + 2 * fq); const float* gn = gg + 16 + 24 * bj + 6 * fq;
                const f32x2_ g0 = *(const gf32x2_*)gn, g1 = *(const gf32x2_*)(gn + 2), g2 = *(const gf32x2_*)(gn + 4);
                g[bj][0] = (f32x4){gr[0], gr[1], g0[0], g0[1]}; g[bj][1] = (f32x4){g1[0], g1[1], g2[0], g2[1]}; }
            f32x4 tb[2][4];
#pragma unroll
            PG8_FOR_ROWS tb[ai][m] = *(const gf32x4*)(ts + (size_t)pos_of_row(row0 + ai * HALF + m * 16) * 16 + 4 * fq);
#pragma unroll
            PG8_FOR_ROWS { const int row = row0 + ai * HALF + m * 16; const float rs = rstd_of(ssq_h, row); f32x4 x[2][2]; float ss = 0.f;
#pragma unroll
                for (int bj = 0; bj < 2; ++bj)
#pragma unroll
                    for (int n = 0; n < 2; ++n) { x[bj][n] = acc[ai][bj][m][n] * rs; ss += x[bj][n][0] * x[bj][n][0] + x[bj][n][1] * x[bj][n][1] + x[bj][n][2] * x[bj][n][2] + x[bj][n][3] * x[bj][n][3]; }
                const float r2 = rsqrtf(fq_sum(ss) * (1.0f / 64) + 1e-6f);
#pragma unroll
                for (int bj = 0; bj < 2; ++bj)
#pragma unroll
                    for (int n = 0; n < 2; ++n) x[bj][n] = x[bj][n] * r2 * g[bj][n];
                { const f32x4 t = tb[ai][m];
#pragma unroll
                    for (int e = 0; e < 2; ++e) { const float cs = t[2 * e], sn = t[2 * e + 1], x1 = x[0][0][e], x2 = x[1][0][e]; x[0][0][e] = x1 * cs - x2 * sn; x[1][0][e] = x2 * cs + x1 * sn; } }
                if (!isk) {
#pragma unroll
                    for (int bj = 0; bj < 2; ++bj) *(gu32x4*)(SQ + (size_t)row * DM + (4 * u.pn + wc) * 64 + 32 * bj + 8 * fq) = pack8(x[bj][0], x[bj][1]);
                } else { float* so = state_out(row, true);
#pragma unroll
                    for (int bj = 0; bj < 2; ++bj) { *(gu32x4*)(SK + (size_t)skrow_of(row) * 256 + wc * 64 + 32 * bj + 8 * fq) = pack8(x[bj][0], x[bj][1]);
                        if (so) { float* sr_ = so + wc * 64 + 8 * bj + 2 * fq; float* sn_ = so + wc * 64 + 16 + 24 * bj + 6 * fq;
                            *(gf32x2_*)sr_ = (f32x2_){x[bj][0][0], x[bj][0][1]}; *(gf32x2_*)sn_ = (f32x2_){x[bj][0][2], x[bj][0][3]};
                            *(gf32x2_*)(sn_ + 2) = (f32x2_){x[bj][1][0], x[bj][1][1]}; *(gf32x2_*)(sn_ + 4) = (f32x2_){x[bj][1][2], x[bj][1][3]}; } } }
            }
        } else {
#pragma unroll
            PG8_FOR_ROWS { const int row = row0 + ai * HALF + m * 16; const float rs = rstd_of(ssq_h, row); float* so = state_out(row, false);
#pragma unroll
                for (int bj = 0; bj < 2; ++bj) { const f32x4 a = acc[ai][bj][m][0] * rs, b = acc[ai][bj][m][1] * rs; const int c = bj * HALF + wc * 32 + 8 * fq;
                    *(gu32x4*)(SV + (size_t)skrow_of(row) * 256 + c) = pack8(a, b);
                    if (so) { *(gf32x4*)(so + c) = a; *(gf32x4*)(so + c + 4) = b; } } }
        }
    }
};
#undef PG8_FOR_ROWS

template <class Epi, class Sched, bool ALIGN_EPI = false, bool SP2 = false>
__device__ __forceinline__ void gemm_phase(int wv, PG8_LAS unsigned char* lds, const Gemm g, const Sched& S, const Epi& E) {
    const int tid = ltid(wv), wid = __builtin_amdgcn_readfirstlane(tid >> 6), lane = tid & 63, wr = wid >> 2, wc = wid & 3, fr = lane & 15, fq = lane >> 4;
    const int K = g.K, nt = K / BK;
    unsigned voffA[2], voffB[2];
#pragma unroll
    for (int i = 0; i < 2; ++i) { int R, C; stage_rc(tid * 16 + i * 8192, R, C); const int Rb = Epi::PERM ? ((R & ~31) + perm32(R & 31)) : R;
        voffA[i] = (unsigned)(R * K + C) * 2u; voffB[i] = (unsigned)(Rb * K + C) * 2u; }
    const size_t kstep = (size_t)(BK * 2);
    const size_t hstep = (size_t)HALF * K * 2;
    const size_t tstep = 2 * hstep;
    const unsigned ldsw = (unsigned)wid * 1024u;
    const int aoff = lds_byte(wr * 64 + fr, fq * 8), boff = lds_byte(wc * 32 + fr, fq * 8);
#define PG8_SA(b, h) (((b) * 2 + (h)) * HTB)
#define PG8_SB(b, h) ((4 + (b) * 2 + (h)) * HTB)
#define PG8_STAGE(bufoff, gbase, voff) do { _Pragma("unroll") for (int _i = 0; _i < 2; ++_i) \
        __builtin_amdgcn_global_load_lds((const unsigned*)((const char*)(gbase) + (voff)[_i]), (PG8_LAS unsigned*)(lds + (bufoff) + ldsw + _i * 8192), 16, 0, 0); } while (0)
#define PG8_LDA(dst, b, h) do { _Pragma("unroll") for (int m = 0; m < 4; ++m) _Pragma("unroll") for (int k = 0; k < 2; ++k) dst[m][k] = *(const PG8_LAS bf16x8*)(lds + PG8_SA(b, h) + aoff + m * 2048 + k * 1024); } while (0)
#define PG8_LDB(dst, b, h) do { _Pragma("unroll") for (int n = 0; n < 2; ++n) _Pragma("unroll") for (int k = 0; k < 2; ++k) dst[n][k] = *(const PG8_LAS bf16x8*)(lds + PG8_SB(b, h) + boff + n * 2048 + k * 1024); } while (0)
#define PG8_MMA(ai, bj, At, Bt) do { __builtin_amdgcn_s_setprio(1); _Pragma("unroll") for (int m = 0; m < 4; ++m) _Pragma("unroll") for (int n = 0; n < 2; ++n) _Pragma("unroll") for (int k = 0; k < 2; ++k) \
        acc[ai][bj][m][n] = __builtin_amdgcn_mfma_f32_16x16x32_bf16(Bt[n][k], At[m][k], acc[ai][bj][m][n], 0, 0, 0); __builtin_amdgcn_s_setprio(0); } while (0)
#define PG8_WAIT_V(n) asm volatile("s_waitcnt vmcnt(" #n ")" ::: "memory")
#define PG8_WAIT_L(n) asm volatile("s_waitcnt lgkmcnt(" #n ")" ::: "memory")
#define PG8_BAR __builtin_amdgcn_s_barrier()
#define PG8_SCHED __builtin_amdgcn_sched_barrier(0)
    Unit cur, nxt; int ui = 0;
    if (!S.next(0, cur)) return;
    f32x4 acc[2][2][4][2];
#pragma unroll
    for (int a = 0; a < 2; ++a)
#pragma unroll
        for (int b = 0; b < 2; ++b)
#pragma unroll
            for (int m = 0; m < 4; ++m)
#pragma unroll
                for (int n = 0; n < 2; ++n) acc[a][b][m][n] = (f32x4){0.f, 0.f, 0.f, 0.f};
    bf16x8 At[4][2], B0[2][2], B1[2][2];
    const char* cA = (const char*)g.A + (size_t)cur.pm * tstep; const char* cB = (const char*)g.Bt + (size_t)cur.pn * tstep;
    S.a_ready(cur);
    if constexpr (SP2) {
        PG8_STAGE(PG8_SB(0, 0), cB, voffB); PG8_STAGE(PG8_SB(0, 1), cB + hstep, voffB); PG8_STAGE(PG8_SA(0, 0), cA, voffA); PG8_STAGE(PG8_SA(0, 1), cA + hstep, voffA);
        if (wr == 1) PG8_BAR;
        PG8_WAIT_V(2); PG8_BAR;
        PG8_STAGE(PG8_SB(1, 0), cB + kstep, voffB); PG8_STAGE(PG8_SA(1, 0), cA + kstep, voffA); PG8_STAGE(PG8_SB(1, 1), cB + hstep + kstep, voffB);
        PG8_WAIT_V(6); PG8_BAR;
    } else {
        PG8_STAGE(PG8_SB(0, 0), cB, voffB); PG8_STAGE(PG8_SA(0, 0), cA, voffA); PG8_STAGE(PG8_SB(0, 1), cB + hstep, voffB); PG8_STAGE(PG8_SA(0, 1), cA + hstep, voffA);
        if (wr == 1) PG8_BAR;
        PG8_WAIT_V(4); PG8_BAR;
        PG8_STAGE(PG8_SB(1, 0), cB + kstep, voffB); PG8_STAGE(PG8_SA(1, 0), cA + kstep, voffA); PG8_STAGE(PG8_SB(1, 1), cB + hstep + kstep, voffB);
        PG8_WAIT_V(6); PG8_BAR;
    }
    for (;;) {
        const bool has_next = S.next(ui + 1, nxt);
        const char* nA = has_next ? (const char*)g.A + (size_t)nxt.pm * tstep : cA; const char* nB = has_next ? (const char*)g.Bt + (size_t)nxt.pn * tstep : cB;
        for (int t = 0; t < nt; t += 2) {
            const bool last = (t == nt - 2);
            const char* a1 = cA + (size_t)(t + 1) * kstep;
            const char* a2 = last ? nA : cA + (size_t)(t + 2) * kstep; const char* b2 = last ? nB : cB + (size_t)(t + 2) * kstep;
            const char* a3 = a2 + kstep; const char* b3 = b2 + kstep;
            if (last && has_next) S.a_ready(nxt);
            if constexpr (SP2) {
            PG8_LDB(B0, 0, 0); PG8_LDB(B1, 0, 1); PG8_SCHED; PG8_LDA(At, 0, 0); PG8_STAGE(PG8_SA(1, 1), a1 + hstep, voffA);
            PG8_WAIT_V(8); PG8_WAIT_L(0); PG8_BAR; PG8_MMA(0, 0, At, B0); PG8_MMA(0, 1, At, B1); PG8_BAR; PG8_SCHED;
            PG8_LDA(At, 0, 1); PG8_STAGE(PG8_SB(0, 0), b2, voffB); PG8_STAGE(PG8_SB(0, 1), b2 + hstep, voffB); PG8_STAGE(PG8_SA(0, 0), a2, voffA);
            PG8_WAIT_V(8); PG8_WAIT_L(0); PG8_BAR; PG8_MMA(1, 0, At, B0); PG8_MMA(1, 1, At, B1); PG8_BAR; PG8_SCHED;
            PG8_LDB(B0, 1, 0); PG8_LDB(B1, 1, 1); PG8_SCHED; PG8_LDA(At, 1, 0); PG8_STAGE(PG8_SA(0, 1), a2 + hstep, voffA);
            PG8_WAIT_V(8); PG8_WAIT_L(0); PG8_BAR; PG8_MMA(0, 0, At, B0); PG8_MMA(0, 1, At, B1); PG8_BAR; PG8_SCHED;
            PG8_LDA(At, 1, 1); PG8_STAGE(PG8_SB(1, 0), b3, voffB); PG8_STAGE(PG8_SB(1, 1), b3 + hstep, voffB); PG8_STAGE(PG8_SA(1, 0), a3, voffA);
            PG8_WAIT_V(8); PG8_WAIT_L(0); PG8_BAR; PG8_MMA(1, 0, At, B0); PG8_MMA(1, 1, At, B1); PG8_BAR; PG8_SCHED;
            } else {
            PG8_LDB(B0, 0, 0); PG8_SCHED; PG8_LDA(At, 0, 0); PG8_STAGE(PG8_SA(1, 1), a1 + hstep, voffA);
            PG8_WAIT_L(8); PG8_BAR; PG8_WAIT_L(0); PG8_MMA(0, 0, At, B0); PG8_BAR; PG8_SCHED;
            PG8_LDB(B1, 0, 1); PG8_STAGE(PG8_SB(0, 0), b2, voffB);
            PG8_BAR; PG8_WAIT_L(0); PG8_MMA(0, 1, At, B1); PG8_BAR;
            PG8_LDA(At, 0, 1); PG8_STAGE(PG8_SA(0, 0), a2, voffA);
            PG8_BAR; PG8_WAIT_L(0); PG8_MMA(1, 0, At, B0); PG8_BAR; PG8_SCHED;
            PG8_STAGE(PG8_SB(0, 1), b2 + hstep, voffB);
            PG8_WAIT_V(6); PG8_BAR; PG8_MMA(1, 1, At, B1); PG8_BAR;
            PG8_LDB(B0, 1, 0); PG8_SCHED; PG8_LDA(At, 1, 0); PG8_STAGE(PG8_SA(0, 1), a2 + hstep, voffA);
            PG8_WAIT_L(8); PG8_BAR; PG8_WAIT_L(0); PG8_MMA(0, 0, At, B0); PG8_BAR; PG8_SCHED;
            PG8_LDB(B1, 1, 1); PG8_STAGE(PG8_SB(1, 0), b3, voffB);
            PG8_BAR; PG8_WAIT_L(0); PG8_MMA(0, 1, At, B1); PG8_BAR;
            PG8_LDA(At, 1, 1); PG8_STAGE(PG8_SA(1, 0), a3, voffA);
            PG8_BAR; PG8_WAIT_L(0); PG8_MMA(1, 0, At, B0); PG8_BAR; PG8_SCHED;
            PG8_STAGE(PG8_SB(1, 1), b3 + hstep, voffB);
            PG8_WAIT_V(6); PG8_BAR; PG8_MMA(1, 1, At, B1); PG8_BAR;
            }
        }
        if constexpr (ALIGN_EPI) { if (wr == 0) PG8_BAR; }
        if constexpr (!Epi::AFTER_DRAIN) { E(acc, cur, wr, wc, fr, fq); S.done(cur); }
        if (!has_next) break;
#pragma unroll
        for (int a = 0; a < 2; ++a)
#pragma unroll
            for (int b = 0; b < 2; ++b)
#pragma unroll
                for (int m = 0; m < 4; ++m)
#pragma unroll
                    for (int n = 0; n < 2; ++n) acc[a][b][m][n] = (f32x4){0.f, 0.f, 0.f, 0.f};
        cur = nxt; cA = nA; cB = nB; ++ui;
        if constexpr (ALIGN_EPI) { if (wr == 1) PG8_BAR; }
    }
    PG8_WAIT_V(0);
    if constexpr (!ALIGN_EPI) { if (wr == 0) PG8_BAR; }
    PG8_BAR;
    if constexpr (Epi::AFTER_DRAIN) { E.fused(acc, cur, wr, wc, fr, fq, lds, wid, lane); S.done(cur); }
#undef PG8_SA
#undef PG8_SB
#undef PG8_STAGE
#undef PG8_LDA
#undef PG8_LDB
#undef PG8_MMA
#undef PG8_WAIT_V
#undef PG8_WAIT_L
#undef PG8_BAR
#undef PG8_SCHED
}
}

#define DPPF(v, ctrl) __uint_as_float((unsigned)__builtin_amdgcn_update_dpp(0, (int)__float_as_uint(v), (ctrl), 0xF, 0xF, true))
__device__ __forceinline__ float g16_sum(float v) { v += DPPF(v, 0xB1); v += DPPF(v, 0x4E); v += DPPF(v, 0x141); v += DPPF(v, 0x140); return v; }
__device__ __forceinline__ float x8_16(float v) { return DPPF(v, 0x128); }
template <int NB> struct SgB { const bf16_t* p[NB]; };
template <int NB, int U, class F>
__device__ __forceinline__ void sg_item(int wv, char* lds, const bf16_t* A  , int K, const SgB<NB>& B, const F& f) {
    constexpr int NBC = NB * 32, NV = NBC / 16;
    const int tid = ltid(wv), lane = tid & 63, r32 = lane & 31, hi = lane >> 5;
    LAS float* L = (LAS float*)lds;
    const int k0 = wv * (K >> 3), nst = K >> 7;
    const size_t lo = (size_t)r32 * K + k0 + hi * 8;
    typedef __attribute__((address_space(1))) bf16x8 gbf8;
    const gbf8* ap = (const gbf8*)(A + lo);
    const gbf8* bp[NB];
#pragma unroll
    for (int cb = 0; cb < NB; ++cb) bp[cb] = (const gbf8*)(B.p[cb] + lo);
    f32x16 acc[NB];
#pragma unroll
    for (int cb = 0; cb < NB; ++cb) acc[cb] = (f32x16){};
    for (int s0 = 0; s0 < nst; s0 += U) {
        bf16x8 a[U], b[NB][U];
#pragma unroll
        for (int u = 0; u < U; ++u) { a[u] = ap[(s0 + u) * 2];
#pragma unroll
            for (int cb = 0; cb < NB; ++cb) b[cb][u] = bp[cb][(s0 + u) * 2]; }
        SBAR();
#pragma unroll
        for (int u = 0; u < U; ++u)
#pragma unroll
            for (int cb = 0; cb < NB; ++cb) acc[cb] = __builtin_amdgcn_mfma_f32_32x32x16_bf16(a[u], b[cb][u], acc[cb], 0, 0, 0);
    }
#pragma unroll
    for (int cb = 0; cb < NB; ++cb)
#pragma unroll
        for (int r = 0; r < 16; ++r) L[(wv * 32 + crow(r, hi)) * NBC + cb * 32 + r32] = acc[cb][r];
    __syncthreads();
    const int row = 4 * wv + (lane >> 4), c0 = (lane & 15) * NV;
    float v[NV];
#pragma unroll
    for (int e = 0; e < NV; ++e) v[e] = 0.f;
#pragma unroll
    for (int q = 0; q < 8; ++q)
#pragma unroll
        for (int e4 = 0; e4 < NV / 4; ++e4) { const f32x4 t = *(const LAS f32x4*)(L + (q * 32 + row) * NBC + c0 + e4 * 4); v[e4 * 4] += t[0]; v[e4 * 4 + 1] += t[1]; v[e4 * 4 + 2] += t[2]; v[e4 * 4 + 3] += t[3]; }
    f(row, c0, lane & 15, v);
    __syncthreads();
}
template <int NB16, int U>
__device__ __forceinline__ void sg16_batch(f32x4 (&acc)[2][NB16], const __attribute__((address_space(1))) bf16x8* const (&ap)[2], const __attribute__((address_space(1))) bf16x8* const (&bp)[NB16], int s0) {
    bf16x8 a[U][2], b[U][NB16];
#pragma unroll
    for (int u = 0; u < U; ++u) {
#pragma unroll
        for (int ra = 0; ra < 2; ++ra) a[u][ra] = ap[ra][(s0 + u) * 4];
#pragma unroll
        for (int cb = 0; cb < NB16; ++cb) b[u][cb] = bp[cb][(s0 + u) * 4]; }
    SBAR();
#pragma unroll
    for (int u = 0; u < U; ++u)
#pragma unroll
        for (int ra = 0; ra < 2; ++ra)
#pragma unroll
            for (int cb = 0; cb < NB16; ++cb) acc[ra][cb] = __builtin_amdgcn_mfma_f32_16x16x32_bf16(a[u][ra], b[u][cb], acc[ra][cb], 0, 0, 0);
    SBAR();
}
template <int NB, class F>
__device__ __forceinline__ void sg_item16(int wv, char* lds, const bf16_t* A  , int K, const SgB<NB>& B, const F& f) {
    constexpr int NB16 = 2 * NB, NBC = NB * 32, NV = NBC / 16;
    const int tid = ltid(wv), lane = tid & 63, c16 = lane & 15, q = lane >> 4;
    LAS float* L = (LAS float*)lds;
    const int k0 = wv * (K >> 3), nst = K >> 8;
    typedef __attribute__((address_space(1))) bf16x8 gbf8;
    const size_t lo = (size_t)c16 * K + k0 + q * 8;
    const gbf8* ap[2]; const gbf8* bp[NB16];
#pragma unroll
    for (int ra = 0; ra < 2; ++ra) ap[ra] = (const gbf8*)(A + (size_t)(ra * 16) * K + lo);
#pragma unroll
    for (int cb = 0; cb < NB16; ++cb) bp[cb] = (const gbf8*)(B.p[cb >> 1] + (size_t)((cb & 1) * 16) * K + lo);
    f32x4 acc[2][NB16];
#pragma unroll
    for (int ra = 0; ra < 2; ++ra)
#pragma unroll
        for (int cb = 0; cb < NB16; ++cb) acc[ra][cb] = (f32x4){0.f, 0.f, 0.f, 0.f};
    bf16x8 aA[2][2], bA[2][NB16], aB[2][2], bB[2][NB16];
#define SG16_LOAD(a_, b_, s_) do { _Pragma("unroll") for (int u = 0; u < 2; ++u) { _Pragma("unroll") for (int ra = 0; ra < 2; ++ra) a_[u][ra] = ap[ra][((s_) + u) * 4]; \
        _Pragma("unroll") for (int cb = 0; cb < NB16; ++cb) b_[u][cb] = bp[cb][((s_) + u) * 4]; } } while (0)
#define SG16_MMA(a_, b_) do { _Pragma("unroll") for (int u = 0; u < 2; ++u) _Pragma("unroll") for (int ra = 0; ra < 2; ++ra) _Pragma("unroll") for (int cb = 0; cb < NB16; ++cb) \
        acc[ra][cb] = __builtin_amdgcn_mfma_f32_16x16x32_bf16(a_[u][ra], b_[u][cb], acc[ra][cb], 0, 0, 0); } while (0)
    SG16_LOAD(aA, bA, 0);
    int s0 = 0;
    for (; s0 + 4 <= nst; s0 += 4) {
        SG16_LOAD(aB, bB, s0 + 2); SBAR(); SG16_MMA(aA, bA); SBAR();
        if (s0 + 4 < nst) SG16_LOAD(aA, bA, s0 + 4);
        SBAR(); SG16_MMA(aB, bB); SBAR();
    }
    if (nst & 2) SG16_MMA(aA, bA);
#undef SG16_LOAD
#undef SG16_MMA
#pragma unroll
    for (int ra = 0; ra < 2; ++ra)
#pragma unroll
        for (int cb = 0; cb < NB16; ++cb)
#pragma unroll
            for (int r = 0; r < 4; ++r) L[(wv * 32 + ra * 16 + 4 * q + r) * NBC + cb * 16 + c16] = acc[ra][cb][r];
    __syncthreads();
    const int row = 4 * wv + (lane >> 4), c0 = (lane & 15) * NV;
    float v[NV];
#pragma unroll
    for (int e = 0; e < NV; ++e) v[e] = 0.f;
#pragma unroll
    for (int w = 0; w < 8; ++w)
#pragma unroll
        for (int e4 = 0; e4 < NV / 4; ++e4) { const f32x4 t = *(const LAS f32x4*)(L + (w * 32 + row) * NBC + c0 + e4 * 4); v[e4 * 4] += t[0]; v[e4 * 4 + 1] += t[1]; v[e4 * 4 + 2] += t[2]; v[e4 * 4 + 3] += t[3]; }
    f(row, c0, lane & 15, v);
    __syncthreads();
}
typedef __attribute__((address_space(1))) f32x4 gf4; typedef __attribute__((address_space(1))) u32x4 gu4; typedef __attribute__((address_space(1))) u32x2 gu2; typedef __attribute__((address_space(1))) float gf1;
__device__ __forceinline__ unsigned pkbf(float lo, float hi) { return cvtpk(lo, hi); }
#define SG_ROWS(it) const int rb = (it) & 7, cbk = (it) >> 3
__device__ __forceinline__ int sg_vb() { const int b = lbid(), G = (int)gridDim.x; return (G & 7) ? b : (b & 7) * (G >> 3) + (b >> 3); }
__device__ __forceinline__ void sg_rope64(float (&y)[4], int c0, int l16, const float* tab_row  ) {
#pragma unroll
    for (int e = 0; e < 4; ++e) { const float pr = x8_16(y[e]); const int i = (c0 + e) & 31; const float c = tab_row[2 * i], s = tab_row[2 * i + 1]; y[e] = l16 < 8 ? y[e] * c - pr * s : y[e] * c + pr * s; }
}

__device__ __forceinline__ void sg_mla_in(const Params& p, int wv, char* lds, const bf16_t* A, const bf16_t* Bt, int j, const ssq_t* ssq_h) {
    bf16_t* CQ = (bf16_t*)(wsp(p) + WS_CQ); bf16_t* CKV = (bf16_t*)(wsp(p) + WS_CKV); bf16_t* KRB = (bf16_t*)(wsp(p) + WS_KRB + (size_t)j * KRB_STRIDE);
    ssq_t* ssq_q = (ssq_t*)(wsp(p) + WS_SSQQ) + (size_t)j * MR; ssq_t* ssq_kv = (ssq_t*)(wsp(p) + WS_SSQKV) + (size_t)j * MR; float* out = outp(p);
    const float* gkr = inp(p, 17) + j * 64; const float* tm = (const float*)(wsp(p) + WS_TABM);
    for (int it = sg_vb(); it < 8 * 17; it += gridDim.x) { SG_ROWS(it); const int K = DM;
        SgB<2> B; if (cbk < 16) { B.p[0] = Bt + (size_t)(cbk * 64) * K; B.p[1] = B.p[0] + (size_t)32 * K; } else { B.p[0] = Bt + (size_t)1024 * K; B.p[1] = Bt + (size_t)1152 * K; }
        sg_item<2, 8>(wv, lds, A + (size_t)(rb * 32) * K, K, B, [&](int row, int c0, int l16, const float (&v)[4]) {
            const int m = NPR + rb * 32 + row; const float rs = rsqrtf(ssq_val(ssq_h, m) * (1.0f / DM) + EPS); float x[4];
#pragma unroll
            for (int e = 0; e < 4; ++e) x[e] = v[e] * rs;
            if (cbk < 16) { const bool iskv = cbk >= 8; const int c = (cbk & 7) * 64 + c0; const float ss = g16_sum(x[0] * x[0] + x[1] * x[1] + x[2] * x[2] + x[3] * x[3]);
                u32x2 w; w.x = pkbf(x[0], x[1]); w.y = pkbf(x[2], x[3]); *(gu2*)((iskv ? CKV : CQ) + (size_t)m * 512 + c) = w;
                if (iskv) *(gf4*)(out + O_LATS + ((size_t)j * NSR + (m - NPR)) * 512 + c) = (f32x4){x[0], x[1], x[2], x[3]};
                if (l16 == 0) ssq_add(iskv ? ssq_kv : ssq_q, m, ss);
            } else { const float r2 = rsqrtf(g16_sum(x[0] * x[0] + x[1] * x[1] + x[2] * x[2] + x[3] * x[3]) * (1.0f / 64) + EPS); float y[4];
#pragma unroll
                for (int e = 0; e < 4; ++e) y[e] = x[e] * r2 * gkr[c0 + e];
                sg_rope64(y, c0, l16, tm + (size_t)pos_of_row(m) * 64);
                *(gf4*)(out + O_KRS + ((size_t)j * NSR + (m - NPR)) * 64 + c0) = (f32x4){y[0], y[1], y[2], y[3]};
                u32x2 w; w.x = pkbf(y[0], y[1]); w.y = pkbf(y[2], y[3]); *(gu2*)(KRB + (size_t)latrow_of(m) * 64 + c0) = w; }
        });
    }
}
__device__ __forceinline__ void sg_mla_up(const Params& p, int wv, char* lds, const bf16_t* Wq, const bf16_t* Wkvf, int j) {
    const bf16_t* CQ = (const bf16_t*)(wsp(p) + WS_CQ) + (size_t)NPR * 512; const bf16_t* CKV = (const bf16_t*)(wsp(p) + WS_CKV) + (size_t)NPR * 512;
    bf16_t* Q = (bf16_t*)(wsp(p) + WS_Q); bf16_t* KV = (bf16_t*)(wsp(p) + WS_KV);
    const ssq_t* ssq_q = (const ssq_t*)(wsp(p) + WS_SSQQ) + (size_t)j * MR; const ssq_t* ssq_kv = (const ssq_t*)(wsp(p) + WS_SSQKV) + (size_t)j * MR;
    const float* gqn = inp(p, 14) + j * 128; const float* gqr = inp(p, 15) + j * 64; const float* gkn = inp(p, 16) + j * 128; const float* tm = (const float*)(wsp(p) + WS_TABM);
    const int K = 512;
    for (int it = sg_vb(); it < 8 * 64; it += gridDim.x) { SG_ROWS(it);
        if (cbk < 16 || cbk >= 32) {
            const int kind = cbk < 16 ? 0 : (cbk < 48 ? 1 : 2), hd = cbk & 15;
            const bf16_t* W0 = kind == 0 ? Wq + (size_t)(128 * hd) * K : Wkvf + (size_t)(256 * hd + (kind == 2 ? 128 : 0)) * K;
            SgB<4> B;
#pragma unroll
            for (int q = 0; q < 4; ++q) B.p[q] = W0 + (size_t)(32 * q) * K;
            sg_item<4, 4>(wv, lds, (kind == 0 ? CQ : CKV) + (size_t)(rb * 32) * K, K, B, [&](int row, int c0, int l16, const float (&v)[8]) {
                const int m = NPR + rb * 32 + row; const float rs = rsqrtf(ssq_val(kind == 0 ? ssq_q : ssq_kv, m) * (1.0f / 512) + EPS); float x[8], ss = 0.f;
#pragma unroll
                for (int e = 0; e < 8; ++e) { x[e] = v[e] * rs; ss += x[e] * x[e]; }
                if (kind != 2) { const float r2 = rsqrtf(g16_sum(ss) * (1.0f / 128) + EPS); const float* g = kind == 0 ? gqn : gkn;
#pragma unroll
                    for (int e = 0; e < 8; ++e) x[e] *= r2 * g[c0 + e]; }
                u32x4 w; w.x = pkbf(x[0], x[1]); w.y = pkbf(x[2], x[3]); w.z = pkbf(x[4], x[5]); w.w = pkbf(x[6], x[7]);
                bf16_t* dst = kind == 0 ? Q + (size_t)m * NQUP + hd * 192 + c0 : KV + (size_t)latrow_of(m) * NKVUP + hd * 256 + (kind == 2 ? 128 : 0) + c0;
                *(gu4*)dst = w;
            });
        } else {
            const int hd = cbk - 16, t = hd >> 2, wc = hd & 3; SgB<2> B; B.p[0] = Wq + (size_t)(2048 + 256 * t + 32 * wc) * K; B.p[1] = B.p[0] + (size_t)128 * K;
            sg_item<2, 4>(wv, lds, CQ + (size_t)(rb * 32) * K, K, B, [&](int row, int c0, int l16, const float (&v)[4]) {
                const int m = NPR + rb * 32 + row; const float rs = rsqrtf(ssq_val(ssq_q, m) * (1.0f / 512) + EPS); float y[4], ss = 0.f;
#pragma unroll
                for (int e = 0; e < 4; ++e) { y[e] = v[e] * rs; ss += y[e] * y[e]; }
                const float r2 = rsqrtf(g16_sum(ss) * (1.0f / 64) + EPS);
#pragma unroll
                for (int e = 0; e < 4; ++e) y[e] *= r2 * gqr[c0 + e];
                sg_rope64(y, c0, l16, tm + (size_t)pos_of_row(m) * 64);
                u32x2 w; w.x = pkbf(y[0], y[1]); w.y = pkbf(y[2], y[3]); *(gu2*)(Q + (size_t)m * NQUP + hd * 192 + 128 + c0) = w;
            });
        }
    }
}
template <int U>
__device__ __forceinline__ void sg_resid(const Params& p, int wv, char* lds, const bf16_t* A, int K, const bf16_t* Bt, const bf16_t* hin, bf16_t* hout, ssq_t* ssq_out, const bf16_t* t, const ssq_t* ssq_in) {
    for (int it = sg_vb(); it < 8 * 32; it += gridDim.x) { SG_ROWS(it);
        SgB<2> B; B.p[0] = Bt + (size_t)(cbk * 64) * K; B.p[1] = B.p[0] + (size_t)32 * K;
        u32x2 hw_, tw_ = {0u, 0u}; float rs_ = 0.f;
        { const int l_ = ltid(wv) & 63, m_ = NPR + rb * 32 + 4 * wv + (l_ >> 4); const size_t off_ = (size_t)m_ * DM + cbk * 64 + (l_ & 15) * 4;
          hw_ = *(const gu2*)(hin + off_); if (t) { tw_ = *(const gu2*)(t + off_); rs_ = rsqrtf(ssq_val(ssq_in, m_) * (1.0f / DM) + EPS); } }
        sg_item16<2>(wv, lds, A + (size_t)(rb * 32) * K, K, B, [&](int row, int c0, int l16, const float (&v)[4]) {
            const int m = NPR + rb * 32 + row; const size_t off = (size_t)m * DM + cbk * 64 + c0; const u32x2 hw = hw_; float o[4];
            const float hv[4] = {__uint_as_float(hw.x << 16), __uint_as_float(hw.x & 0xffff0000u), __uint_as_float(hw.y << 16), __uint_as_float(hw.y & 0xffff0000u)};
            if (t) { const float rs = rs_; const u32x2 tw = tw_;
                const float tf[4] = {__uint_as_float(tw.x << 16), __uint_as_float(tw.x & 0xffff0000u), __uint_as_float(tw.y << 16), __uint_as_float(tw.y & 0xffff0000u)};
#pragma unroll
                for (int e = 0; e < 4; ++e) o[e] = hv[e] + tf[e] * __builtin_amdgcn_rcpf(1.0f + __expf(-v[e] * rs));
            } else {
#pragma unroll
                for (int e = 0; e < 4; ++e) o[e] = hv[e] + v[e]; }
            u32x2 w; w.x = pkbf(o[0], o[1]); w.y = pkbf(o[2], o[3]); *(gu2*)(hout + off) = w;
            const float ss = g16_sum(o[0] * o[0] + o[1] * o[1] + o[2] * o[2] + o[3] * o[3]);
            if (l16 == 0) ssq_add(ssq_out, m, ss);
        });
    }
}
__device__ __forceinline__ void sg_ffn_up(const Params& p, int wv, char* lds, const bf16_t* A, const bf16_t* Wgu, const ssq_t* ssq_in) {
    bf16_t* act = (bf16_t*)(wsp(p) + WS_ACT); const int K = DM;
    for (int it = sg_vb(); it < 8 * (DFF / 64); it += gridDim.x) { SG_ROWS(it); const int tl = cbk >> 1, hf = (cbk & 1) * 64;
        SgB<4> B; B.p[0] = Wgu + (size_t)(256 * tl + hf) * K; B.p[1] = B.p[0] + (size_t)32 * K; B.p[2] = B.p[0] + (size_t)128 * K; B.p[3] = B.p[2] + (size_t)32 * K;
        sg_item<4, 4>(wv, lds, A + (size_t)(rb * 32) * K, K, B, [&](int row, int c0, int l16, const float (&v)[8]) {
            const int m = NPR + rb * 32 + row; const float rs = rsqrtf(ssq_val(ssq_in, m) * (1.0f / DM) + EPS); float o[8];
#pragma unroll
            for (int e = 0; e < 8; ++e) { const float mine = v[e] * rs, other = x8_16(mine); o[e] = mine * __builtin_amdgcn_rcpf(1.0f + __expf(-mine)) * other; }
            if (l16 < 8) { u32x4 w; w.x = pkbf(o[0], o[1]); w.y = pkbf(o[2], o[3]); w.z = pkbf(o[4], o[5]); w.w = pkbf(o[6], o[7]);
                *(gu4*)(act + (size_t)m * DFF + 128 * tl + hf + c0) = w; }
        });
    }
}
__device__ __forceinline__ void sg_store_bf16(const Params& p, int wv, char* lds, const bf16_t* A, int K, const bf16_t* Bt, bf16_t* C, int ldc, int ncb) {
    for (int it = sg_vb(); it < 8 * ncb; it += gridDim.x) { SG_ROWS(it);
        SgB<2> B; B.p[0] = Bt + (size_t)(cbk * 64) * K; B.p[1] = B.p[0] + (size_t)32 * K;
        sg_item<2, 2>(wv, lds, A + (size_t)(rb * 32) * K, K, B, [&](int row, int c0, int l16, const float (&v)[4]) {
            const int m = NPR + rb * 32 + row; u32x2 w; w.x = pkbf(v[0], v[1]); w.y = pkbf(v[2], v[3]); *(gu2*)(C + (size_t)m * ldc + cbk * 64 + c0) = w; });
    }
}
__device__ __forceinline__ void sg_swa_qkv(const Params& p, int wv, char* lds, const bf16_t* A, const bf16_t* Bt, int j, const ssq_t* ssq_h) {
    bf16_t* SQ = (bf16_t*)(wsp(p) + WS_SQ); bf16_t* SK = (bf16_t*)(wsp(p) + WS_SKB + (size_t)j * SKB_STRIDE); bf16_t* SV = (bf16_t*)(wsp(p) + WS_SVB + (size_t)j * SKB_STRIDE);
    const float* gq = inp(p, 20) + j * 64; const float* gk = inp(p, 21) + j * 64; const float* ts = (const float*)(wsp(p) + WS_TABS); float* out = outp(p); const int K = DM;
    for (int it = sg_vb(); it < 8 * 40; it += gridDim.x) { SG_ROWS(it);
        SgB<2> B;
        if (cbk < 36) { const int t = cbk >> 2, wc = cbk & 3; B.p[0] = Bt + (size_t)(256 * t + 32 * wc) * K; B.p[1] = B.p[0] + (size_t)128 * K; }
        else { B.p[0] = Bt + (size_t)(2304 + 64 * (cbk - 36)) * K; B.p[1] = B.p[0] + (size_t)32 * K; }
        sg_item<2, 8>(wv, lds, A + (size_t)(rb * 32) * K, K, B, [&](int row, int c0, int l16, const float (&v)[4]) {
            const int m = NPR + rb * 32 + row, b = (m - NPR) >> 4, tt = (m - NPR) & 15; const float rs = rsqrtf(ssq_val(ssq_h, m) * (1.0f / DM) + EPS); float x[4];
#pragma unroll
            for (int e = 0; e < 4; ++e) x[e] = v[e] * rs;
            const size_t so = (((size_t)j * 16 + b) * 128 + 112 + tt) * 256;
            if (cbk < 36) { const bool isk = cbk >= 32; const int bj = c0 >> 5, i0 = c0 & 31, d0 = swa_dim(bj, i0);
                const float r2 = rsqrtf(g16_sum(x[0] * x[0] + x[1] * x[1] + x[2] * x[2] + x[3] * x[3]) * (1.0f / 64) + EPS); const float* g = isk ? gk : gq;
#pragma unroll
                for (int e = 0; e < 4; ++e) x[e] *= r2 * g[d0 + e];
                const float* tp = ts + (size_t)pos_of_row(m) * 16;
#pragma unroll
                for (int e = 0; e < 4; ++e) { const float pr = x8_16(x[e]); const int d = (i0 + e) & 7; const float c = tp[2 * d], s = tp[2 * d + 1];
                    if (i0 < 8) x[e] = bj == 0 ? x[e] * c - pr * s : x[e] * c + pr * s; }
                u32x2 w; w.x = pkbf(x[0], x[1]); w.y = pkbf(x[2], x[3]);
                if (!isk) *(gu2*)(SQ + (size_t)m * DM + cbk * 64 + c0) = w;
                else { const int g4 = cbk - 32; *(gu2*)(SK + (size_t)skrow_of(m) * 256 + g4 * 64 + c0) = w; *(gf4*)(out + O_SKS + so + g4 * 64 + d0) = (f32x4){x[0], x[1], x[2], x[3]}; }
            } else { const int c = (cbk - 36) * 64 + c0; u32x2 w; w.x = pkbf(x[0], x[1]); w.y = pkbf(x[2], x[3]);
                *(gu2*)(SV + (size_t)skrow_of(m) * 256 + c) = w; *(gf4*)(out + O_SVS + so + c) = (f32x4){x[0], x[1], x[2], x[3]}; }
        });
    }
}

#define XB_TMO      128
#define XB_XCNT(j)  (256  + 64 * (j))
#define XB_XSUB(j)  (1280 + 64 * (j))
#define XB_XGEN(j)  (2304 + 64 * (j))
#define XB_TOP      3328
#define XB_TOPGEN   3392
#define XCD_BAR_WORDS 3456
#define XB_SPIN_CAP (1u << 18)

__device__ __forceinline__ unsigned xb_ld(unsigned* p)              { return __hip_atomic_load(p, __ATOMIC_RELAXED, __HIP_MEMORY_SCOPE_AGENT); }
__device__ __forceinline__ unsigned xb_add(unsigned* p, unsigned v) { return __hip_atomic_fetch_add(p, v, __ATOMIC_RELAXED, __HIP_MEMORY_SCOPE_AGENT); }
__device__ __forceinline__ unsigned xb_xcc_id() { return (unsigned)__builtin_amdgcn_s_getreg((3 << 11) | 20) & 0xFu; }
#define XB_SPIN(cond, bar) do { unsigned _sp = 0; while (cond) { __builtin_amdgcn_s_sleep(1); \
    if ((++_sp & 255u) == 0u) { if (xb_ld(&(bar)[XB_TMO])) break; if (_sp > XB_SPIN_CAP) { atomicAdd(&(bar)[XB_TMO], 1u); break; } } } } while (0)

struct XcdBarrier {
    unsigned* bar; unsigned x;
    volatile LAS unsigned* st;
};

__device__ __forceinline__ XcdBarrier xcd_barrier_post(unsigned* bar, volatile LAS unsigned* st, bool leader  ) {
    XcdBarrier b; b.bar = bar; b.x = xb_xcc_id(); b.st = st;
    if (leader) (void)xb_add(&bar[XB_XCNT(b.x)], 1u);
    return b;
}
__device__ __forceinline__ void xcd_barrier_complete(unsigned* bar, unsigned x, unsigned& nloc, unsigned& nx) {
    const unsigned G = gridDim.x * gridDim.y * gridDim.z;
    unsigned sum, cnt, mine, sp = 0u;
    for (;;) {
        sum = 0u; cnt = 0u; mine = 0u;
#pragma unroll
        for (unsigned j = 0; j < 16; ++j) { const unsigned c = xb_ld(&bar[XB_XCNT(j)]); sum += c; cnt += (c > 0u) ? 1u : 0u; }
        mine = xb_ld(&bar[XB_XCNT(x)]);
        if (sum == G) { mine = xb_ld(&bar[XB_XCNT(x)]); break; }
        __builtin_amdgcn_s_sleep(1);
        if ((++sp & 255u) == 0u) { if (xb_ld(&bar[XB_TMO])) break; if (sp > XB_SPIN_CAP) { atomicAdd(&bar[XB_TMO], 1u); break; } }
    }
    nloc = mine > 0u ? mine : 1u; nx = cnt > 0u ? cnt : 1u;
}

__device__ __forceinline__ void xcd_barrier(const XcdBarrier& b, bool leader) {
    asm volatile("s_waitcnt vmcnt(0)" ::: "memory");
    __syncthreads();
    if (leader) {
        unsigned* bar = b.bar;
        __builtin_amdgcn_s_waitcnt(0);
        unsigned nloc = b.st[0], nx = b.st[1];
        if (nloc == 0u) { xcd_barrier_complete(bar, b.x, nloc, nx); b.st[0] = nloc; b.st[1] = nx; }
        const unsigned old = xb_add(&bar[XB_XSUB(b.x)], 1u);
        const unsigned gen = old / nloc;
        if (old + 1u == (gen + 1u) * nloc) {
            __builtin_amdgcn_fence(__ATOMIC_RELEASE, "agent");
            asm volatile("s_waitcnt vmcnt(0)" ::: "memory");
            const unsigned og = xb_add(&bar[XB_TOP], 1u);
            const unsigned tg = og / nx;
            if (og + 1u == (tg + 1u) * nx) xb_add(&bar[XB_TOPGEN], 1u);
            else XB_SPIN(xb_ld(&bar[XB_TOPGEN]) == tg, bar);
            __builtin_amdgcn_fence(__ATOMIC_ACQUIRE, "agent");
            xb_add(&bar[XB_XGEN(b.x)], 1u);
            asm volatile("s_waitcnt vmcnt(0)" ::: "memory");
        } else {
            XB_SPIN(xb_ld(&bar[XB_XGEN(b.x)]) == gen, bar);
            __builtin_amdgcn_fence(__ATOMIC_ACQUIRE, "agent");
            asm volatile("s_waitcnt vmcnt(0)" ::: "memory");
        }
    }
    __syncthreads();
}

constexpr int LDS_BYTES = 147456;
constexpr int LDS_MISC = 141312 + 320;
constexpr int LDS_XCH = 131072 + 2048;
constexpr int CW_BAR = 4096;
__global__ void __launch_bounds__(512, 2) mega_fwd(Params p) {
    extern __shared__ __attribute__((aligned(16))) char lds[];
    volatile LAS unsigned* MISC = (volatile LAS unsigned*)((LAS char*)lds + LDS_MISC);
    for (int u = threadIdx.x; u < (LDS_BYTES - 131072) / 4; u += 512) ((LAS unsigned*)((LAS char*)lds + 131072))[u] = 0u;
    __syncthreads();
    PG8_LAS unsigned char* GL = (PG8_LAS unsigned char*)lds;
    const int WV = __builtin_amdgcn_readfirstlane((int)threadIdx.x >> 6);
    XcdBarrier bar = xcd_barrier_post((unsigned*)(p.ws + WS_CTL) + CW_BAR, MISC + 8, ltid(WV) == 0);
#define GRID_BAR() do { XcdBarrier b2_ = bar; b2_.bar = (unsigned*)(wsp(p) + WS_CTL) + CW_BAR; b2_.x = xb_xcc_id(); xcd_barrier(b2_, ltid(WV) == 0); } while (0)
#define HBX ((bf16_t*)(wsp(p) + ((i & 1) ? WS_HB1 : WS_HB0)))
#define OB ((bf16_t*)outp(p))
#define HBY ((bf16_t*)(wsp(p) + ((i & 1) ? WS_HB0 : WS_HB1)))
#define SSQ(k) ((ssq_t*)(wsp(p) + WS_SSQ) + (size_t)(k) * MR)
#define WB(off) ((const bf16_t*)(wsp(p) + WS_W) + (off))
#define XCH ((pg8::lfloat*)(GL + LDS_XCH))
#define RUN_GEMM4(EPI, A_, B_, M_, N_, K_, ...) do { pg8::Gemm g_{A_, B_, M_, N_, K_}; pg8::StaticOrder S_; S_.init(M_, N_, gridDim.x, lbid(), 4); pg8::EPI E_{__VA_ARGS__}; \
        pg8::gemm_phase<pg8::EPI, pg8::StaticOrder, true, true>(WV, GL, g_, S_, E_); } while (0)
#define RUN_GEMM(EPI, A_, B_, M_, N_, K_, ...) do { pg8::Gemm g_{A_, B_, M_, N_, K_}; pg8::StaticOrder S_; S_.init(M_, N_, gridDim.x, lbid()); pg8::EPI E_{__VA_ARGS__}; \
        pg8::gemm_phase<pg8::EPI, pg8::StaticOrder, true, true>(WV, GL, g_, S_, E_); } while (0)
    ph_tables(p, WV); ph_convert_w(p, WV, lds); ph_init_h(p, WV); ph_caches(p, WV);
    GRID_BAR();
    for (int i = 0; i < 4; ++i) {
        const int j = i >> 1;
        if ((i & 1) == 0) {
            const size_t wm = (size_t)j * WE_MLA;
            RUN_GEMM(EpiMlaIn, HBX, WB(wm + WO_IN), MR, 1280, DM,
                     (bf16_t*)(wsp(p) + WS_CQ), (bf16_t*)(wsp(p) + WS_CKV), (bf16_t*)(wsp(p) + WS_KRB + (size_t)j * KRB_STRIDE), outp(p), j, SSQ(3 * i),
                     (ssq_t*)(wsp(p) + WS_SSQQ) + (size_t)j * MR, (ssq_t*)(wsp(p) + WS_SSQKV) + (size_t)j * MR, inp(p, 17) + j * 64, (const float*)(wsp(p) + WS_TABM));
            GRID_BAR();
            RUN_GEMM(EpiQup, (const bf16_t*)(wsp(p) + WS_CQ), WB(wm + WO_QUP), MR, NQUP, 512,
                     (bf16_t*)(wsp(p) + WS_Q), (const ssq_t*)(wsp(p) + WS_SSQQ) + (size_t)j * MR, inp(p, 14) + j * 128, inp(p, 15) + j * 64, (const float*)(wsp(p) + WS_TABM), XCH);
            { const int G_ = (int)gridDim.x, b_ = lbid(); pg8::Gemm g_{(const bf16_t*)(wsp(p) + WS_CKV), WB(wm + WO_KVF), MR, NKVUP, 512}; pg8::StaticOrder S_; S_.init(MR, NKVUP, G_, (b_ + G_ - (G_ >= 32 ? 16 : 0)) % G_);
              pg8::EpiKvup E_{(bf16_t*)(wsp(p) + WS_KV), (const ssq_t*)(wsp(p) + WS_SSQKV) + (size_t)j * MR, inp(p, 16) + j * 128, XCH}; pg8::gemm_phase<pg8::EpiKvup, pg8::StaticOrder, true, true>(WV, GL, g_, S_, E_); }
            RUN_GEMM(EpiKvup, (const bf16_t*)(wsp(p) + WS_LATC) + (size_t)j * 16384 * 512, WB(wm + WO_KVP), 16384, NKVUP, 512,
                     (bf16_t*)(wsp(p) + WS_KV), nullptr, inp(p, 16) + j * 128, XCH);
            { const int G_ = (int)gridDim.x, b_ = lbid(), lo_ = G_ >= 64 ? 32 : 0; if (b_ >= lo_) ph_lat_fix(p, WV, j, b_ - lo_, G_ - lo_); }
            GRID_BAR();
            ph_mla_attn(p, WV, (const bf16_t*)(wsp(p) + WS_KRB + (size_t)j * KRB_STRIDE), OB, lds);
            GRID_BAR();
            ph_ple_prep(p, WV, i);
            RUN_GEMM4(EpiResidF32, OB, WB(wm + WO_MOUT), NPR, DM, DM, HBX, HBY, SSQ(3 * i + 1));
            sg_resid<8>(p, WV, lds, OB + (size_t)NPR * DM, DM, WB(wm + WO_MOUT), HBX, HBY, SSQ(3 * i + 1), nullptr, nullptr);
            GRID_BAR();
        } else {
            const size_t wsw = WE_SWA0 + (size_t)j * WE_SWA;
            RUN_GEMM(EpiSwaQkv, HBX, WB(wsw + WO_QKV), MR, NQKV, DM,
                     (bf16_t*)(wsp(p) + WS_SQ), (bf16_t*)(wsp(p) + WS_SKB + (size_t)j * SKB_STRIDE), (bf16_t*)(wsp(p) + WS_SVB + (size_t)j * SKB_STRIDE), outp(p), j, SSQ(3 * i),
                     inp(p, 20) + j * 64, inp(p, 21) + j * 64, (const float*)(wsp(p) + WS_TABS));
            GRID_BAR();
            ph_swa_attn(p, WV, j, (const bf16_t*)(wsp(p) + WS_SKB + (size_t)j * SKB_STRIDE), (const bf16_t*)(wsp(p) + WS_SVB + (size_t)j * SKB_STRIDE), OB, lds);
            GRID_BAR();
            ph_ple_prep(p, WV, i);
            RUN_GEMM4(EpiResidF32, OB, WB(wsw + WO_SOUT), NPR, DM, DM, HBX, HBY, SSQ(3 * i + 1));
            sg_resid<8>(p, WV, lds, OB + (size_t)NPR * DM, DM, WB(wsw + WO_SOUT), HBX, HBY, SSQ(3 * i + 1), nullptr, nullptr);
            GRID_BAR();
        }
        const size_t wl = WE_L0 + (size_t)i * WE_L;
        RUN_GEMM(EpiSwigluBf16, HBY, WB(wl + WO_G), MR, 2 * DFF, DM, (bf16_t*)(wsp(p) + WS_ACT), DFF, SSQ(3 * i + 1));
        {
          const int G_ = (int)gridDim.x, nbusy_ = (65 * 44) % G_, b_ = lbid();
          if (b_ >= nbusy_) { pg8::Gemm g_{(const bf16_t*)(wsp(p) + WS_PB), WB(wl + WO_PP), MR, DM, PLE}; pg8::StaticOrder S_; S_.init(MR, DM, G_ - nbusy_, b_ - nbusy_);
              pg8::EpiStoreBf16 E_{(bf16_t*)(wsp(p) + WS_T32), DM}; pg8::gemm_phase<pg8::EpiStoreBf16, pg8::StaticOrder, true, true>(WV, GL, g_, S_, E_); } }
        GRID_BAR();
        { pg8::Gemm g_{(const bf16_t*)(wsp(p) + WS_ACT), WB(wl + WO_D), NPR, DM, DFF}; pg8::StaticOrder S_; S_.init(NPR, DM, gridDim.x, lbid(), 4);
          pg8::EpiResidF32 E_{HBY, HBX, SSQ(3 * i + 2)}; pg8::gemm_phase<pg8::EpiResidF32, pg8::StaticOrder, true, true>(WV, GL, g_, S_, E_); }
        sg_resid<11>(p, WV, lds, (const bf16_t*)(wsp(p) + WS_ACT) + (size_t)NPR * DFF, DFF, WB(wl + WO_D), HBY, HBX, SSQ(3 * i + 2), nullptr, nullptr);
        GRID_BAR();
        RUN_GEMM4(EpiPleF32, HBX, WB(wl + WO_PG), NPR, DM, DM, HBX, (const bf16_t*)(wsp(p) + WS_T32), HBY, SSQ(3 * i + 2), SSQ(3 * i + 3));
        sg_resid<8>(p, WV, lds, HBX + (size_t)NPR * DM, DM, WB(wl + WO_PG), HBX, HBY, SSQ(3 * i + 3), (const bf16_t*)(wsp(p) + WS_T32), SSQ(3 * i + 2));
        GRID_BAR();
    }
    ph_final(p, WV);
#undef GRID_BAR
#undef HBX
#undef OB
#undef HBY
#undef SSQ
#undef WB
#undef XCH
#undef RUN_GEMM
#undef RUN_GEMM4
}

__global__ void k_report(float* out, float v) { if (threadIdx.x == 0 && blockIdx.x == 0) out[0] = v; }

extern "C" void kernel_launch(void* const* d_in, const int* in_sizes, int n_in, void* d_out, int out_size, void* d_ws, size_t ws_size, hipStream_t stream) {
    if (n_in != 32 || (size_t)out_size != O_END || ws_size < WS_END) {
        fprintf(stderr, "kernel_launch: unexpected sizes n_in %d out %d ws %zu (need %zu)\n", n_in, out_size, ws_size, (size_t)WS_END);
        hipLaunchKernelGGL(k_report, dim3(1), dim3(64), 0, stream, (float*)d_out, (float)(ws_size >> 20));
        return;
    }
    Params p{};
    for (int k = 0; k < 32; ++k) p.in[k] = (const float*)d_in[k];
    p.out = (float*)d_out; p.ws = (unsigned char*)d_ws;
    static int grid = 0;
    if (grid == 0) {
        int dev = 0, cus = 0, per_cu = 0;
        if (hipGetDevice(&dev) != hipSuccess || hipDeviceGetAttribute(&cus, hipDeviceAttributeMultiprocessorCount, dev) != hipSuccess) { fprintf(stderr, "kernel_launch: device query failed\n"); grid = -1; return; }
        if (hipFuncSetAttribute((const void*)mega_fwd, hipFuncAttributeMaxDynamicSharedMemorySize, LDS_BYTES) != hipSuccess) { fprintf(stderr, "kernel_launch: hipFuncSetAttribute failed\n"); grid = -1; return; }
        if (hipOccupancyMaxActiveBlocksPerMultiprocessor(&per_cu, (const void*)mega_fwd, 512, LDS_BYTES) != hipSuccess || per_cu < 1) fprintf(stderr, "kernel_launch: occupancy query says %d\n", per_cu);
        (void)hipGetLastError();
        grid = cus;
    }
    if (grid < 0) return;
    (void)hipMemsetAsync((char*)d_ws + WS_CTL, 0, CTL_BYTES, stream);
    hipLaunchKernelGGL(mega_fwd, dim3(grid), dim3(512), LDS_BYTES, stream, p);
}
```
